# Optimizing an MI355X kernel written in HIP

```python
import math
import jax, jax.numpy as jnp
from jax import lax
import numpy as np

D_MODEL = 1024
BATCH = 16
SEQ = 2048
DEPTH = 2

D_MIX = D_MODEL
C_CONV = D_MIX // 4
C_POOL = D_MIX // 4
C_ATTN = D_MIX - C_CONV - C_POOL
DIFF_HEADS = 4
DIFF_HEAD_DIM = C_ATTN // (2 * DIFF_HEADS)
CONV_WIDTH = 31
POOL_WINDOWS = (2, 4, 8, 16)
POOL_GROUP = C_POOL // len(POOL_WINDOWS)
N_IN = 2 * C_CONV + C_POOL + 3 * C_ATTN
N_EXPERT_GROUPS = 4
EXPERTS_PER_GROUP = 4
N_EXPERTS = N_EXPERT_GROUPS * EXPERTS_PER_GROUP
D_EXPERT = D_MODEL // 4
MOE_TOP_K = 2
ATTN_BLOCK = 128
NORM_EPS = 1e-6

kernel_name = "hymba_conv_pool_diffattn_hmoe"


def rms_norm(x, g):
    xf = x.astype(jnp.float32)
    y = xf * lax.rsqrt(jnp.mean(xf * xf, axis=-1, keepdims=True) + NORM_EPS)
    return (y * g.astype(jnp.float32)).astype(x.dtype)


def layer_norm(x, g, b):
    xf = x.astype(jnp.float32)
    mu = jnp.mean(xf, axis=-1, keepdims=True)
    xc = xf - mu
    y = xc * lax.rsqrt(jnp.mean(xc * xc, axis=-1, keepdims=True) + NORM_EPS)
    return (y * g.astype(jnp.float32) + b.astype(jnp.float32)).astype(x.dtype)


def alibi_slopes(n_heads):
    start = 2.0 ** (-8.0 / n_heads)
    return jnp.asarray(np.array([start ** (i + 1) for i in range(n_heads)], dtype=np.float32))


def conv_mixer(a_val, a_gate, w_dw, b_dw, ln_g, ln_b, w_pw, b_pw):
    u = a_val * jax.nn.sigmoid(a_gate)
    y = lax.conv_general_dilated(
        u, w_dw[:, None, :].astype(u.dtype), window_strides=(1,),
        padding=[(CONV_WIDTH - 1, 0)],
        dimension_numbers=("NWC", "WIO", "NWC"),
        feature_group_count=C_CONV) + b_dw
    y = jax.nn.silu(layer_norm(y, ln_g, ln_b))
    return y @ w_pw + b_pw


def pool_mixer(u, w_pool, scale):
    s_len = u.shape[1]
    uf = u.astype(jnp.float32)
    c0 = jnp.pad(lax.cumsum(uf, axis=1), ((0, 0), (1, 0), (0, 0)))
    t = jnp.arange(s_len)
    outs = []
    for gi, win in enumerate(POOL_WINDOWS):
        sl = slice(gi * POOL_GROUP, (gi + 1) * POOL_GROUP)
        lo = jnp.maximum(t + 1 - win, 0)
        window_sum = c0[:, 1:, sl] - c0[:, lo, sl]
        count = jnp.minimum(t + 1, win).astype(jnp.float32)[None, :, None]
        d = (window_sum / count - uf[:, :, sl]).astype(u.dtype)
        outs.append(jnp.einsum("bsc,cd->bsd", d, w_pool[gi]))
    return jnp.concatenate(outs, axis=-1) * scale


def diff_attention(q, k, v, lam, slopes):
    s_len = q.shape[1]
    q = q.transpose(0, 2, 3, 1, 4)
    k = k.transpose(0, 2, 3, 1, 4)
    v = v.transpose(0, 2, 1, 3)
    scale = DIFF_HEAD_DIM ** -0.5
    outs = []
    for blk in range(s_len // ATTN_BLOCK):
        q0 = blk * ATTN_BLOCK
        end = q0 + ATTN_BLOCK
        qb = q[:, :, :, q0:end]
        kb = k[:, :, :, :end]
        vb = v[:, :, :end]
        s = jnp.einsum("bhmqd,bhmkd->bhmqk", qb, kb,
                       preferred_element_type=jnp.float32) * scale
        tq = jnp.arange(q0, end)[:, None]
        tk = jnp.arange(end)[None, :]
        dist = (tq - tk).astype(jnp.float32)
        s = s - slopes[None, :, None, None, None] * dist
        s = jnp.where(tk <= tq, s, -jnp.inf)
        p = jax.nn.softmax(s, axis=-1)
        a = p[:, :, 0] - lam * p[:, :, 1]
        outs.append(jnp.einsum("bhqk,bhkd->bhqd", a.astype(vb.dtype), vb))
    o = jnp.concatenate(outs, axis=2)
    return o.transpose(0, 2, 1, 3)


def hier_moe(h, wg, bg, we, be, w_gate, w_up, w_down):
    b_, s_, d_ = h.shape
    t = h.reshape(-1, d_)
    pg = jax.nn.softmax((t @ wg).astype(jnp.float32) + bg.astype(jnp.float32), axis=-1)
    g_idx = jnp.argmax(pg, axis=-1)
    g_p = jnp.take_along_axis(pg, g_idx[:, None], axis=1)[:, 0]
    le = ((t @ we).astype(jnp.float32) + be.astype(jnp.float32)).reshape(-1, N_EXPERT_GROUPS, EXPERTS_PER_GROUP)
    le = jnp.take_along_axis(le, g_idx[:, None, None], axis=1)[:, 0]
    pe = jax.nn.softmax(le, axis=-1)
    top_p, top_i = lax.top_k(pe, MOE_TOP_K)
    top_p = top_p / jnp.sum(top_p, axis=-1, keepdims=True)
    weights = g_p[:, None] * top_p
    eid = g_idx[:, None] * EXPERTS_PER_GROUP + top_i
    gates = jnp.sum(jax.nn.one_hot(eid, N_EXPERTS, dtype=jnp.float32) * weights[..., None], axis=1)
    gates = gates.astype(t.dtype)
    y = jnp.zeros_like(t)
    for e in range(N_EXPERTS):
        act = jax.nn.silu(t @ w_gate[e]) * (t @ w_up[e]) * gates[:, e:e + 1]
        y = y + act @ w_down[e]
    return y.reshape(b_, s_, d_)


def setup_inputs(seed: int = 0) -> dict:
    key = jax.random.key(seed)
    ks = iter(jax.random.split(key, 40))
    L = DEPTH

    def nrm(shape, scale):
        return jax.random.normal(next(ks), shape, jnp.float32) * scale

    def gain(shape):
        return 1.0 + nrm(shape, 0.02)

    return {
        "x": nrm((BATCH, SEQ, D_MODEL), 1.0),
        "attn_norm_g": gain((L, D_MODEL)),
        "w_in": nrm((L, D_MODEL, N_IN), D_MODEL ** -0.5),
        "conv_w": nrm((L, CONV_WIDTH, C_CONV), CONV_WIDTH ** -0.5),
        "conv_b": nrm((L, C_CONV), 0.02),
        "conv_ln_g": gain((L, C_CONV)),
        "conv_ln_b": nrm((L, C_CONV), 0.02),
        "conv_pw_w": nrm((L, C_CONV, C_CONV), C_CONV ** -0.5),
        "conv_pw_b": nrm((L, C_CONV), 0.02),
        "pool_w": nrm((L, len(POOL_WINDOWS), POOL_GROUP, POOL_GROUP), POOL_GROUP ** -0.5),
        "pool_scale": gain((L, C_POOL)),
        "q_norm_g": gain((L, DIFF_HEAD_DIM)),
        "k_norm_g": gain((L, DIFF_HEAD_DIM)),
        "lambda_q1": nrm((L, DIFF_HEAD_DIM), 0.1),
        "lambda_k1": nrm((L, DIFF_HEAD_DIM), 0.1),
        "lambda_q2": nrm((L, DIFF_HEAD_DIM), 0.1),
        "lambda_k2": nrm((L, DIFF_HEAD_DIM), 0.1),
        "attn_sub_norm_g": gain((L, 2 * DIFF_HEAD_DIM)),
        "w_out": nrm((L, D_MIX, D_MODEL), D_MIX ** -0.5),
        "ffn_norm_g": gain((L, D_MODEL)),
        "router_g_w": nrm((L, D_MODEL, N_EXPERT_GROUPS), D_MODEL ** -0.5),
        "router_g_b": nrm((L, N_EXPERT_GROUPS), 0.01),
        "router_e_w": nrm((L, D_MODEL, N_EXPERTS), D_MODEL ** -0.5),
        "router_e_b": nrm((L, N_EXPERTS), 0.01),
        "w_gate": nrm((L, N_EXPERTS, D_MODEL, D_EXPERT), D_MODEL ** -0.5),
        "w_up": nrm((L, N_EXPERTS, D_MODEL, D_EXPERT), D_MODEL ** -0.5),
        "w_down": nrm((L, N_EXPERTS, D_EXPERT, D_MODEL), D_EXPERT ** -0.5),
    }


def reference(x, attn_norm_g, w_in, conv_w, conv_b, conv_ln_g, conv_ln_b, conv_pw_w, conv_pw_b,
              pool_w, pool_scale, q_norm_g, k_norm_g, lambda_q1, lambda_k1, lambda_q2, lambda_k2,
              attn_sub_norm_g, w_out, ffn_norm_g, router_g_w, router_g_b, router_e_w, router_e_b,
              w_gate, w_up, w_down):
    b_, s_, _ = x.shape
    slopes = alibi_slopes(DIFF_HEADS)
    splits = [C_CONV, 2 * C_CONV, 2 * C_CONV + C_POOL,
              2 * C_CONV + C_POOL + C_ATTN, 2 * C_CONV + C_POOL + 2 * C_ATTN]
    for l in range(DEPTH):
        h = rms_norm(x, attn_norm_g[l])
        z = h @ w_in[l]
        a_val, a_gate, p_in, q, k, v = jnp.split(z, splits, axis=-1)

        y_conv = conv_mixer(a_val, a_gate, conv_w[l], conv_b[l], conv_ln_g[l], conv_ln_b[l],
                            conv_pw_w[l], conv_pw_b[l])
        y_pool = pool_mixer(p_in, pool_w[l], pool_scale[l])

        q = rms_norm(q.reshape(b_, s_, DIFF_HEADS, 2, DIFF_HEAD_DIM), q_norm_g[l])
        k = rms_norm(k.reshape(b_, s_, DIFF_HEADS, 2, DIFF_HEAD_DIM), k_norm_g[l])
        v = v.reshape(b_, s_, DIFF_HEADS, 2 * DIFF_HEAD_DIM)
        lam_init = 0.8 - 0.6 * math.exp(-0.3 * l)
        lam = (jnp.exp(jnp.sum(lambda_q1[l].astype(jnp.float32) * lambda_k1[l].astype(jnp.float32)))
               - jnp.exp(jnp.sum(lambda_q2[l].astype(jnp.float32) * lambda_k2[l].astype(jnp.float32)))
               + lam_init)
        o = diff_attention(q, k, v, lam, slopes)
        o = rms_norm(o, attn_sub_norm_g[l]) * (1.0 - lam_init)
        y_attn = o.reshape(b_, s_, C_ATTN)

        mix = jnp.concatenate([y_conv, y_pool, y_attn], axis=-1)
        x = x + mix @ w_out[l]

        hf = rms_norm(x, ffn_norm_g[l])
        x = x + hier_moe(hf, router_g_w[l], router_g_b[l], router_e_w[l], router_e_b[l],
                         w_gate[l], w_up[l], w_down[l])
    return x
```

```cpp
#include <hip/hip_runtime.h>
#include <cstdio>
#include <cstdint>

#define GAS __attribute__((address_space(1)))
#define LAS __attribute__((address_space(3)))
typedef unsigned short bf16_t;
typedef short bf16x8 __attribute__((ext_vector_type(8)));
typedef short s16x4 __attribute__((ext_vector_type(4)));
typedef float f32x4 __attribute__((ext_vector_type(4)));
typedef float f32x2 __attribute__((ext_vector_type(2)));
typedef float f32x16 __attribute__((ext_vector_type(16)));
typedef unsigned u32x4 __attribute__((ext_vector_type(4)));
typedef unsigned u32x2 __attribute__((ext_vector_type(2)));

__device__ __forceinline__ float bf2f(unsigned v) { return __uint_as_float(v << 16); }
__device__ __forceinline__ unsigned f2bf(float f) { unsigned u = __float_as_uint(f); return (u + 0x7fffu + ((u >> 16) & 1u)) >> 16; }
__device__ __forceinline__ unsigned pk2(float lo, float hi) { return f2bf(lo) | (f2bf(hi) << 16); }
__device__ __forceinline__ float wave_sum(float v) {
#pragma unroll
    for (int o = 1; o < 64; o <<= 1) v += __shfl_xor(v, o);
    return v;
}

namespace pg8 {
constexpr int BM = 256, BK = 64, HALF = 128, HTB = HALF * BK * 2, STAGE_BYTES = 8 * HTB;
__host__ __device__ __forceinline__ int lds_byte(int r, int c) { const int st = (r >> 4) * 2 + (c >> 5), rr = r & 15, cc = c & 31, ob = rr * 64 + cc * 2; return st * 1024 + (ob ^ (((ob >> 9) & 1) << 5)); }
__host__ __device__ __forceinline__ void stage_rc(int b, int& R, int& C) { const int st = b / 1024, sb = b % 1024, swz = sb ^ (((sb >> 9) & 1) << 5); R = (st >> 1) * 16 + swz / 64; C = (st & 1) * 32 + (swz % 64) / 2; }
__host__ __device__ __forceinline__ int perm32(int rho) { const int n = rho >> 4, i = rho & 15; return 8 * (i >> 2) + 4 * n + (i & 3); }

struct Unit { int pm, pn; const char* bb; long bjump; int arow0; int acount; int aux; };
struct Gemm { const char* A; int lda; const int* gather; int ldb; int K; int bsplit; };

__device__ __forceinline__ unsigned cvt_pk_bf16(float lo, float hi) { unsigned r; asm volatile("v_cvt_pk_bf16_f32 %0, %1, %2" : "=v"(r) : "v"(lo), "v"(hi)); return r; }

template <class Epi, class Sched, bool ALIGN_EPI>
__device__ __forceinline__ void gemm_phase(LAS unsigned char* lds, const Gemm g, const Sched& S, const Epi& E, const int tid) {
    const int wid = __builtin_amdgcn_readfirstlane(tid >> 6), lane = tid & 63, wr = wid >> 2, wc = wid & 3, fr = lane & 15, fq = lane >> 4;
    const int K = g.K, nt = K / BK;
    unsigned voffB[2];
#pragma unroll
    for (int i = 0; i < 2; ++i) { int R, C; stage_rc(tid * 16 + i * 8192, R, C); const int Rb = Epi::PERM ? ((R & ~31) + perm32(R & 31)) : R; voffB[i] = (unsigned)(Rb * g.ldb + C) * 2u; }
    const size_t kstep = (size_t)(BK * 2);
    const size_t bh = (size_t)HALF * g.ldb * 2;
    const unsigned ldsw = (unsigned)wid * 1024u;
    const int aoff = lds_byte(wr * 64 + fr, fq * 8), boff = lds_byte(wc * 32 + fr, fq * 8);
    const char* const Ab = g.A;
#define PG8_SA(b, h) (((b) * 2 + (h)) * HTB)
#define PG8_SB(b, h) ((4 + (b) * 2 + (h)) * HTB)
#define PG8_STAGE(bufoff, gbase, voff) do { _Pragma("unroll") for (int _i = 0; _i < 2; ++_i) \
        __builtin_amdgcn_global_load_lds((const unsigned*)((const char*)(gbase) + (voff)[_i]), (LAS unsigned*)(lds + (bufoff) + ldsw + _i * 8192), 16, 0, 0); } while (0)
#define PG8_LDA(dst, b, h) do { _Pragma("unroll") for (int m = 0; m < 4; ++m) _Pragma("unroll") for (int k = 0; k < 2; ++k) dst[m][k] = *(const LAS bf16x8*)(lds + PG8_SA(b, h) + aoff + m * 2048 + k * 1024); } while (0)
#define PG8_LDB(dst, b, h) do { _Pragma("unroll") for (int n = 0; n < 2; ++n) _Pragma("unroll") for (int k = 0; k < 2; ++k) dst[n][k] = *(const LAS bf16x8*)(lds + PG8_SB(b, h) + boff + n * 2048 + k * 1024); } while (0)
#define PG8_MMA(ai, bj, At, Bt) do { __builtin_amdgcn_s_setprio(1); _Pragma("unroll") for (int m = 0; m < 4; ++m) _Pragma("unroll") for (int n = 0; n < 2; ++n) _Pragma("unroll") for (int k = 0; k < 2; ++k) \
        acc[ai][bj][m][n] = __builtin_amdgcn_mfma_f32_16x16x32_bf16(Bt[n][k], At[m][k], acc[ai][bj][m][n], 0, 0, 0); __builtin_amdgcn_s_setprio(0); } while (0)
#define PG8_WAIT_V(n) asm volatile("s_waitcnt vmcnt(" #n ")" ::: "memory")
#define PG8_WAIT_L(n) asm volatile("s_waitcnt lgkmcnt(" #n ")" ::: "memory")
#define PG8_BAR __builtin_amdgcn_s_barrier()
#define PG8_SCHED __builtin_amdgcn_sched_barrier(0)
#define PG8_AOFFS(u, o) do { _Pragma("unroll") for (int _h = 0; _h < 2; ++_h) _Pragma("unroll") for (int _i = 0; _i < 2; ++_i) { int _R, _C; stage_rc(tid * 16 + _i * 8192, _R, _C); const int _r = _h * HALF + _R; \
        int _row; if (g.gather) { _row = (_r < (u).acount) ? g.gather[(u).arow0 + _r] : 0; } else { _row = (u).arow0 + _r; } (o)[_h][_i] = (unsigned)(_row * g.lda + _C) * 2u; } } while (0)
#define PG8_BKO(u, tt) ((size_t)(tt) * kstep + (((tt) >= g.bsplit) ? (size_t)(u).bjump : (size_t)0))
    Unit cur, nxt; int ui = 0;
    if (!S.next(0, cur)) return;
    f32x4 acc[2][2][4][2];
#pragma unroll
    for (int a = 0; a < 2; ++a)
#pragma unroll
        for (int b = 0; b < 2; ++b)
#pragma unroll
            for (int m = 0; m < 4; ++m)
#pragma unroll
                for (int n = 0; n < 2; ++n) acc[a][b][m][n] = (f32x4){0.f, 0.f, 0.f, 0.f};
    bf16x8 At[4][2], B0[2][2], B1[2][2];
    unsigned cao[2][2];
    LAS u32x4* const naol = (LAS u32x4*)(lds + STAGE_BYTES + 1024) + tid;
    PG8_AOFFS(cur, cao);
    const char* cB = cur.bb;
    PG8_STAGE(PG8_SB(0, 0), cB, voffB); PG8_STAGE(PG8_SB(0, 1), cB + bh, voffB); PG8_STAGE(PG8_SA(0, 0), Ab, cao[0]); PG8_STAGE(PG8_SA(0, 1), Ab, cao[1]);
    if (wr == 1) PG8_BAR;
    PG8_WAIT_V(2); PG8_BAR;
    PG8_STAGE(PG8_SB(1, 0), cB + kstep, voffB); PG8_STAGE(PG8_SA(1, 0), Ab + kstep, cao[0]); PG8_STAGE(PG8_SB(1, 1), cB + bh + kstep, voffB);
    PG8_WAIT_V(6); PG8_BAR;
    for (;;) {
        const bool has_next = S.next(ui + 1, nxt);
        const char* nB = cB;
        { unsigned nao[2][2];
          if (has_next) { PG8_AOFFS(nxt, nao); nB = nxt.bb; }
          else {
#pragma unroll
            for (int h = 0; h < 2; ++h)
#pragma unroll
                for (int i = 0; i < 2; ++i) nao[h][i] = cao[h][i];
          }
          *naol = (u32x4){nao[0][0], nao[0][1], nao[1][0], nao[1][1]}; }
#pragma unroll 1
        for (int t = 0; t < nt; t += 2) {
            const bool last = (t == nt - 2);
            const char* a1 = Ab + (size_t)(t + 1) * kstep;
            const char* a2 = last ? Ab : Ab + (size_t)(t + 2) * kstep;
            const char* a3 = a2 + kstep;
            const char* b2 = last ? nB : cB + PG8_BKO(cur, t + 2);
            const char* b3 = last ? nB + kstep : cB + PG8_BKO(cur, t + 3);
            unsigned ao2[2][2];
#pragma unroll
            for (int h = 0; h < 2; ++h)
#pragma unroll
                for (int i = 0; i < 2; ++i) ao2[h][i] = cao[h][i];
            if (last) { const u32x4 v = *naol; ao2[0][0] = v.x; ao2[0][1] = v.y; ao2[1][0] = v.z; ao2[1][1] = v.w; }
            PG8_LDB(B0, 0, 0); PG8_LDB(B1, 0, 1); PG8_SCHED; PG8_LDA(At, 0, 0); PG8_STAGE(PG8_SA(1, 1), a1, cao[1]);
            PG8_WAIT_V(8); PG8_WAIT_L(0); PG8_BAR; PG8_MMA(0, 0, At, B0); PG8_MMA(0, 1, At, B1); PG8_BAR; PG8_SCHED;
            PG8_LDA(At, 0, 1); PG8_STAGE(PG8_SB(0, 0), b2, voffB); PG8_STAGE(PG8_SB(0, 1), b2 + bh, voffB); PG8_STAGE(PG8_SA(0, 0), a2, ao2[0]);
            PG8_WAIT_V(8); PG8_WAIT_L(0); PG8_BAR; PG8_MMA(1, 0, At, B0); PG8_MMA(1, 1, At, B1); PG8_BAR; PG8_SCHED;
            PG8_LDB(B0, 1, 0); PG8_LDB(B1, 1, 1); PG8_SCHED; PG8_LDA(At, 1, 0); PG8_STAGE(PG8_SA(0, 1), a2, ao2[1]);
            PG8_WAIT_V(8); PG8_WAIT_L(0); PG8_BAR; PG8_MMA(0, 0, At, B0); PG8_MMA(0, 1, At, B1); PG8_BAR; PG8_SCHED;
            PG8_LDA(At, 1, 1); PG8_STAGE(PG8_SB(1, 0), b3, voffB); PG8_STAGE(PG8_SB(1, 1), b3 + bh, voffB); PG8_STAGE(PG8_SA(1, 0), a3, ao2[0]);
            PG8_WAIT_V(8); PG8_WAIT_L(0); PG8_BAR; PG8_MMA(1, 0, At, B0); PG8_MMA(1, 1, At, B1); PG8_BAR; PG8_SCHED;
        }
        if constexpr (ALIGN_EPI) { if (wr == 0) PG8_BAR; }
        { int t2_ = tid; asm volatile("" : "+v"(t2_)); const int l2_ = t2_ & 63; E(acc, cur, wr, wc, l2_ & 15, l2_ >> 4); }
        if (!has_next) break;
#pragma unroll
        for (int a = 0; a < 2; ++a)
#pragma unroll
            for (int b = 0; b < 2; ++b)
#pragma unroll
                for (int m = 0; m < 4; ++m)
#pragma unroll
                    for (int n = 0; n < 2; ++n) acc[a][b][m][n] = (f32x4){0.f, 0.f, 0.f, 0.f};
        cur = nxt; cB = nB; ++ui;
        { const u32x4 v = *naol; cao[0][0] = v.x; cao[0][1] = v.y; cao[1][0] = v.z; cao[1][1] = v.w; }
        if constexpr (ALIGN_EPI) { if (wr == 1) PG8_BAR; }
    }
    PG8_WAIT_V(0);
    if constexpr (!ALIGN_EPI) { if (wr == 0) PG8_BAR; }
    PG8_BAR;
#undef PG8_SA
#undef PG8_SB
#undef PG8_STAGE
#undef PG8_LDA
#undef PG8_LDB
#undef PG8_MMA
#undef PG8_WAIT_V
#undef PG8_WAIT_L
#undef PG8_BAR
#undef PG8_SCHED
#undef PG8_AOFFS
#undef PG8_BKO
}
}

constexpr int BATCH = 16, SEQ = 2048, T = BATCH * SEQ, D = 1024, NIN = 2304, NL = 2;
constexpr int CC = 256, CP = 256, CA = 512, NH = 4, DH = 64, DV = 128, CW = 31;
constexpr int NE = 16, DE = 256, NBKT = 24;
constexpr float EPS = 1e-6f;
constexpr float QSCALE = 0.125f * 1.4426950408889634f;
constexpr int NWAVES = 8, NTHREADS = 512;

constexpr size_t MiB = 1u << 20, KiB = 1u << 10;
constexpr size_t WS_CTL = 0, CTL_ZERO_BYTES = 1 * MiB;
constexpr size_t WS_SS = 2 * MiB;
constexpr size_t WS_SS1 = 4 * MiB;
constexpr size_t WS_RS1 = 6 * MiB;
constexpr size_t WS_WTS = 6 * MiB + 256 * KiB;
constexpr size_t WS_TOKB = 6 * MiB + 512 * KiB;
constexpr size_t WS_LIST = 7 * MiB;
constexpr size_t WS_WR = 10 * MiB;
constexpr size_t WS_WPW = 10 * MiB + 512 * KiB;
constexpr size_t WS_WPOOL = 10 * MiB + 768 * KiB;
constexpr size_t WS_ERR = 11 * MiB;
constexpr size_t WS_WIN = 16 * MiB;
constexpr size_t WS_WOUT = 25 * MiB;
constexpr size_t WS_WGU = 29 * MiB;
constexpr size_t WS_WD = 61 * MiB;
constexpr size_t WS_XB = 80 * MiB;
constexpr size_t WS_X1B = 144 * MiB;
constexpr size_t WS_MIX = 208 * MiB;
constexpr size_t WS_U = 272 * MiB;
constexpr size_t WS_PIN = 288 * MiB;
constexpr size_t WS_Q = 304 * MiB;
constexpr size_t WS_K = 336 * MiB;
constexpr size_t WS_V = 368 * MiB;
constexpr size_t WS_ACT = 400 * MiB;
constexpr size_t WS_DBG = 440 * MiB;
constexpr size_t WS_END = 512 * MiB;
constexpr int CW_BAR = 4096;
constexpr int CW_CNT = 16384;
constexpr int RING_BYTES = 131072;
constexpr int MISC_OFF = RING_BYTES;
constexpr int LDS_EXTRA = RING_BYTES + 1024;
constexpr int LDS_BYTES = 163840;

#define LDS_WAIT() asm volatile("s_waitcnt lgkmcnt(0)" ::: "memory")
#define VM_WAIT() asm volatile("s_waitcnt vmcnt(0)" ::: "memory")

#define XB_TMO      128
#define XB_XCNT(j)  (256  + 64 * (j))
#define XB_XSUB(j)  (1280 + 64 * (j))
#define XB_XGEN(j)  (2304 + 64 * (j))
#define XB_TOP      3328
#define XB_TOPGEN   3392
#define XCD_BAR_WORDS 3456
#define XB_SPIN_CAP (1u << 22)
__device__ __forceinline__ unsigned xb_ld(unsigned* p)              { return __hip_atomic_load(p, __ATOMIC_RELAXED, __HIP_MEMORY_SCOPE_AGENT); }
__device__ __forceinline__ unsigned xb_add(unsigned* p, unsigned v) { return __hip_atomic_fetch_add(p, v, __ATOMIC_RELAXED, __HIP_MEMORY_SCOPE_AGENT); }
__device__ __forceinline__ unsigned xb_xcc_id() { return (unsigned)__builtin_amdgcn_s_getreg((3 << 11) | 20) & 0xFu; }
#define XB_SPIN(cond, bar) do { unsigned _sp = 0; while (cond) { __builtin_amdgcn_s_sleep(1); \
    if ((++_sp & 255u) == 0u) { if (xb_ld(&(bar)[XB_TMO])) break; if (_sp > XB_SPIN_CAP) { atomicAdd(&(bar)[XB_TMO], 1u); break; } } } } while (0)
struct XcdBarrier { unsigned* bar; unsigned x; volatile LAS unsigned* st; };
__device__ __forceinline__ XcdBarrier xcd_barrier_post(unsigned* bar, volatile LAS unsigned* st) {
    XcdBarrier b; b.bar = bar; b.x = xb_xcc_id(); b.st = st;
    if (threadIdx.x == 0) (void)xb_add(&bar[XB_XCNT(b.x)], 1u);
    return b;
}
__device__ __forceinline__ void xcd_barrier_complete(unsigned* bar, unsigned x, unsigned& nloc, unsigned& nx) {
    const unsigned G = gridDim.x * gridDim.y * gridDim.z;
    unsigned sum, cnt, mine, sp = 0u;
    for (;;) {
        sum = 0u; cnt = 0u; mine = 0u;
#pragma unroll
        for (unsigned j = 0; j < 16; ++j) { const unsigned c = xb_ld(&bar[XB_XCNT(j)]); sum += c; cnt += (c > 0u) ? 1u : 0u; mine = (j == x) ? c : mine; }
        if (sum == G) break;
        __builtin_amdgcn_s_sleep(1);
        if ((++sp & 255u) == 0u) { if (xb_ld(&bar[XB_TMO])) break; if (sp > XB_SPIN_CAP) { atomicAdd(&bar[XB_TMO], 1u); break; } }
    }
    nloc = mine > 0u ? mine : 1u; nx = cnt > 0u ? cnt : 1u;
}
__device__ __forceinline__ void xcd_barrier(const XcdBarrier& b) {
    asm volatile("s_waitcnt vmcnt(0)" ::: "memory");
    __syncthreads();
    if (threadIdx.x == 0) {
        unsigned* bar = b.bar;
        __builtin_amdgcn_s_waitcnt(0);
        unsigned nloc = b.st[0], nx = b.st[1];
        if (nloc == 0u) { xcd_barrier_complete(bar, b.x, nloc, nx); b.st[0] = nloc; b.st[1] = nx; }
        const unsigned old = xb_add(&bar[XB_XSUB(b.x)], 1u);
        const unsigned gen = old / nloc;
        if (old + 1u == (gen + 1u) * nloc) {
            __builtin_amdgcn_fence(__ATOMIC_RELEASE, "agent");
            asm volatile("s_waitcnt vmcnt(0)" ::: "memory");
            const unsigned og = xb_add(&bar[XB_TOP], 1u);
            const unsigned tg = og / nx;
            if (og + 1u == (tg + 1u) * nx) xb_add(&bar[XB_TOPGEN], 1u);
            else XB_SPIN(xb_ld(&bar[XB_TOPGEN]) == tg, bar);
            __builtin_amdgcn_fence(__ATOMIC_ACQUIRE, "agent");
            xb_add(&bar[XB_XGEN(b.x)], 1u);
            asm volatile("s_waitcnt vmcnt(0)" ::: "memory");
        } else {
            XB_SPIN(xb_ld(&bar[XB_XGEN(b.x)]) == gen, bar);
            __builtin_amdgcn_fence(__ATOMIC_ACQUIRE, "agent");
            asm volatile("s_waitcnt vmcnt(0)" ::: "memory");
        }
    }
    __syncthreads();
}

struct Args { const float* in[27]; float* out; unsigned char* ws; int ph_lo, ph_hi; };
enum { I_X = 0, I_ANG, I_WIN, I_CW, I_CB, I_CLG, I_CLB, I_CPW, I_CPB, I_PW, I_PS, I_QG, I_KG, I_LQ1, I_LK1, I_LQ2, I_LK2, I_ASG, I_WOUT, I_FNG, I_RGW, I_RGB, I_REW, I_REB, I_WG, I_WU, I_WDN };

struct Frame {
    LAS unsigned char* lds;
    int tid, lane, wave, vcu, G;
};

__device__ __forceinline__ void tr_item(const float* S, int ldS, int sc0, int k0, const float* gk, bf16_t* Dst, int ldD, int p0, LAS float* scr, int lane) {
#pragma unroll 8
    for (int i = 0; i < 32; ++i) { const int kk = 2 * i + (lane >> 5); float v = S[(size_t)(k0 + kk) * ldS + sc0 + (lane & 31)]; if (gk) v *= gk[k0 + kk]; scr[kk * 33 + (lane & 31)] = v; }
    LDS_WAIT(); asm volatile("" ::: "memory");
    const int c = lane & 7;
#pragma unroll
    for (int j = 0; j < 4; ++j) { const int n = (lane >> 3) + 8 * j; const LAS float* s = scr + (8 * c) * 33 + n;
        u32x4 o; o.x = pk2(s[0 * 33], s[1 * 33]); o.y = pk2(s[2 * 33], s[3 * 33]); o.z = pk2(s[4 * 33], s[5 * 33]); o.w = pk2(s[6 * 33], s[7 * 33]);
        *(u32x4*)(Dst + (size_t)(p0 + n) * ldD + k0 + 8 * c) = o; }
    LDS_WAIT(); asm volatile("" ::: "memory");
}
__device__ __forceinline__ int win_logical(int p0) {
    const int pn = p0 >> 8, c = p0 & 255;
    if (pn < 2) return (c < 128) ? (pn * 128 + c) : (256 + pn * 128 + (c - 128));
    if (pn == 2) return 512 + c;
    if (pn < 7) { const int bj = c >> 7, wc = (c >> 5) & 3; return 768 + (pn - 3) * 256 + 64 * wc + 32 * bj; }
    return 1792 + (pn - 7) * 256 + c;
}
__device__ __forceinline__ void p0_prologue(const Args& args, Frame& F) {
    unsigned char* ws = args.ws;
    LAS float* scr = (LAS float*)(F.lds + F.wave * 16384);
    const int gw = F.vcu * NWAVES + F.wave, NGW = F.G * NWAVES, lane = F.lane;
    constexpr int I_IN = 16 * 72, I_OUT = 16 * 32, I_GU = 16 * 16 * 16, I_DN = 4 * 32 * 16, I_PWI = 4 * 8, I_PL = 8;
    constexpr int PER_L = I_IN + I_OUT + I_GU + I_DN + I_PWI + I_PL;
    for (int it = gw; it < NL * PER_L; it += NGW) {
        const int l = it / PER_L; int r = it % PER_L;
        if (r < I_IN) { const int kb = r / 72, pb = r % 72; const int p0 = pb * 32;
            tr_item(args.in[I_WIN] + (size_t)l * D * NIN, NIN, win_logical(p0), kb * 64, args.in[I_ANG] + l * D, (bf16_t*)(ws + WS_WIN) + (size_t)l * NIN * D, D, p0, scr, lane); continue; }
        r -= I_IN;
        if (r < I_OUT) { const int kb = r / 32, pb = r % 32;
            tr_item(args.in[I_WOUT] + (size_t)l * D * D, D, pb * 32, kb * 64, nullptr, (bf16_t*)(ws + WS_WOUT) + (size_t)l * D * D, D, pb * 32, scr, lane); continue; }
        r -= I_OUT;
        if (r < I_GU) { const int e = r / 256, q = r % 256, kb = q / 16, pb = q % 16; const int p0 = pb * 32;
            const int half = p0 >> 8, gu = (p0 >> 7) & 1, i0 = p0 & 127; const float* src = (gu ? args.in[I_WU] : args.in[I_WG]) + (size_t)(l * NE + e) * D * DE;
            tr_item(src, DE, half * 128 + i0, kb * 64, args.in[I_FNG] + l * D, (bf16_t*)(ws + WS_WGU) + (size_t)(l * NE + e) * 512 * D, D, p0, scr, lane); continue; }
        r -= I_GU;
        if (r < I_DN) { const int e = r / 128, q = r % 128, kb = q / 32, pb = q % 32;
            tr_item(args.in[I_WDN] + (size_t)(l * NE + e) * DE * D, D, pb * 32, kb * 64, nullptr, (bf16_t*)(ws + WS_WD) + (size_t)(l * NE + e) * D * DE, DE, pb * 32, scr, lane); continue; }
        r -= I_DN;
        if (r < I_PWI) { const int kb = r / 8, pb = r % 8;
            tr_item(args.in[I_CPW] + (size_t)l * CC * CC, CC, pb * 32, kb * 64, nullptr, (bf16_t*)(ws + WS_WPW) + (size_t)l * CC * CC, CC, pb * 32, scr, lane); continue; }
        r -= I_PWI;
        { const int gi = r / 2, pb = r % 2;
            tr_item(args.in[I_PW] + (size_t)(l * 4 + gi) * 64 * 64, 64, pb * 32, 0, nullptr, (bf16_t*)(ws + WS_WPOOL) + (size_t)(l * 4 + gi) * 64 * 64, 64, pb * 32, scr, lane); }
    }
    for (int i = (F.vcu * NTHREADS + F.tid); i < NL * 20 * D; i += F.G * NTHREADS) {
        const int l = i / (20 * D), j = (i / D) % 20, k = i % D;
        const float w = (j < 4) ? args.in[I_RGW][(size_t)(l * D + k) * 4 + j] : args.in[I_REW][(size_t)(l * D + k) * 16 + (j - 4)];
        ((float*)(ws + WS_WR))[i] = w * args.in[I_FNG][l * D + k];
    }
    for (int m = gw; m < T; m += NGW) {
        const GAS f32x4* xr = (const GAS f32x4*)(args.in[I_X] + (size_t)m * D) + lane;
        GAS unsigned long long* o8 = (GAS unsigned long long*)((bf16_t*)(ws + WS_XB) + (size_t)m * D) + lane;
        float s = 0.f;
#pragma unroll
        for (int j = 0; j < 4; ++j) { const f32x4 v = xr[64 * j]; s += (v.x * v.x + v.y * v.y) + (v.z * v.z + v.w * v.w);
            o8[64 * j] = (unsigned long long)pk2(v.x, v.y) | ((unsigned long long)pk2(v.z, v.w) << 32); }
        s = wave_sum(s);
        if (lane < 16) ((float*)(ws + WS_SS))[(size_t)m * 16 + lane] = (lane == 0) ? s : 0.f;
    }
}

struct DenseOrder {
    int nM, nN, nwg, G, c; const char* Bt; size_t btile;
    __device__ void init(int M, int N, int G_, int c_, const void* Bt_, int ldb) { nM = M / 256; nN = N / 256; nwg = nM * nN; G = G_; c = c_; Bt = (const char*)Bt_; btile = (size_t)256 * ldb * 2; }
    __device__ __forceinline__ bool next(int i, pg8::Unit& u) const {
        const long L = (long)i * G + c; if (L >= nwg) return false;
        int wgid = (int)L; { const int q = nwg / 8, r = nwg % 8, xcd = wgid % 8, off = wgid / 8; wgid = (xcd < r ? xcd * (q + 1) : r * (q + 1) + (xcd - r) * q) + off; }
        const int nig = 8 * nN, gid = wgid / nig, fm = gid * 8, gsz = (nM - fm) < 8 ? (nM - fm) : 8;
        u.pm = fm + ((wgid % nig) % gsz); u.pn = (wgid % nig) / gsz;
        u.bb = Bt + (size_t)u.pn * btile; u.bjump = 0; u.arow0 = u.pm * 256; u.acount = 256; u.aux = 0; return true;
    }
};
struct MoeOrder {
    const LAS int* ti; int G, c, l, mode; const char* W;
    __device__ __forceinline__ bool next(int i, pg8::Unit& u) const {
        const int NT = __builtin_amdgcn_readfirstlane(ti[0]); const int nwg = NT * 4;
        const long L = (long)i * G + c; if (L >= nwg) return false;
        int wgid = (int)L; { const int q = nwg / 8, r = nwg % 8, xcd = wgid % 8, off = wgid / 8; wgid = (xcd < r ? xcd * (q + 1) : r * (q + 1) + (xcd - r) * q) + off; }
        const int rt = wgid >> 2, pn = wgid & 3;
        const int inf = __builtin_amdgcn_readfirstlane(ti[2 + 2 * rt]); const int b = inf & 255, lt = inf >> 8;
        const int grp = b / 6, pi = b % 6;
        const int lo = (pi < 3) ? 0 : (pi < 5 ? 1 : 2), hi = (pi < 3) ? pi + 1 : (pi < 5 ? pi - 1 : 3);
        const int e0 = grp * 4 + lo, e1 = grp * 4 + hi;
        u.pm = rt; u.pn = pn; u.acount = __builtin_amdgcn_readfirstlane(ti[3 + 2 * rt]);
        if (mode == 1) { const int e = (pn < 2) ? e0 : e1; u.bb = W + ((size_t)(l * NE + e) * 512 + (size_t)(pn & 1) * 256) * D * 2; u.bjump = 0; u.arow0 = b * T + lt * 256; u.aux = b; }
        else { u.bb = W + ((size_t)(l * NE + e0) * D + (size_t)pn * 256) * DE * 2; u.bjump = (long)(e1 - e0) * D * DE * 2 - 4 * 128; u.arow0 = rt * 256; u.aux = b * T + lt * 256; }
        return true;
    }
};

__device__ __forceinline__ float sigmoidf_(float x) { return __frcp_rn(1.f + __expf(-x)); }
__device__ __forceinline__ float row_rstd16(const float* p) {
    const f32x4 a = ((const f32x4*)p)[0], b = ((const f32x4*)p)[1], c = ((const f32x4*)p)[2], d = ((const f32x4*)p)[3];
    const float s = ((a.x + a.y) + (a.z + a.w)) + ((b.x + b.y) + (b.z + b.w)) + ((c.x + c.y) + (c.z + c.w)) + ((d.x + d.y) + (d.z + d.w));
    return rsqrtf(s * (1.f / D) + EPS);
}
__device__ __forceinline__ u32x4 pack8(const f32x4 a, const f32x4 b) { u32x4 w; w.x = pg8::cvt_pk_bf16(a[0], a[1]); w.y = pg8::cvt_pk_bf16(a[2], a[3]); w.z = pg8::cvt_pk_bf16(b[0], b[1]); w.w = pg8::cvt_pk_bf16(b[2], b[3]); return w; }

struct EpiInProj {
    static constexpr bool PERM = true;
    const float* SS; bf16_t *U, *PIN, *Q, *Kb, *V; const float *qg, *kg;
    __device__ __forceinline__ void operator()(const f32x4 (&acc)[2][2][4][2], const pg8::Unit& u, int wr, int wc, int fr, int fq) const {
        const int row0 = u.pm * 256 + wr * 64 + fr, pn = u.pn;
        if (pn < 2) {
#pragma unroll
            for (int ai = 0; ai < 2; ++ai)
#pragma unroll
                for (int m = 0; m < 4; ++m) { const int row = row0 + ai * 128 + m * 16; const float rs = row_rstd16(SS + (size_t)row * 16);
                    f32x4 o[2];
#pragma unroll
                    for (int n = 0; n < 2; ++n) { const f32x4 v = acc[ai][0][m][n] * rs, g = acc[ai][1][m][n] * rs;
                        o[n] = (f32x4){v[0] * sigmoidf_(g[0]), v[1] * sigmoidf_(g[1]), v[2] * sigmoidf_(g[2]), v[3] * sigmoidf_(g[3])}; }
                    *(u32x4*)(U + (size_t)row * CC + pn * 128 + wc * 32 + 8 * fq) = pack8(o[0], o[1]); }
        } else if (pn == 2 || pn >= 7) {
            bf16_t* dst = (pn == 2) ? PIN : V; const int ld = (pn == 2) ? CP : CA; const int cb = (pn == 2) ? 0 : (pn - 7) * 256;
#pragma unroll
            for (int ai = 0; ai < 2; ++ai)
#pragma unroll
                for (int m = 0; m < 4; ++m) { const int row = row0 + ai * 128 + m * 16; const float rs = row_rstd16(SS + (size_t)row * 16);
#pragma unroll
                    for (int bj = 0; bj < 2; ++bj) *(u32x4*)(dst + (size_t)row * ld + cb + bj * 128 + wc * 32 + 8 * fq) = pack8(acc[ai][bj][m][0] * rs, acc[ai][bj][m][1] * rs); }
        } else {
            const bool isq = pn < 5; bf16_t* dst = isq ? Q : Kb; const float* gn = isq ? qg : kg; const int hs = (isq ? (pn - 3) : (pn - 5)) * 4 + wc;
            f32x4 gv[2][2];
#pragma unroll
            for (int bj = 0; bj < 2; ++bj)
#pragma unroll
                for (int n = 0; n < 2; ++n) gv[bj][n] = *(const f32x4*)(gn + 32 * bj + 8 * fq + 4 * n);
#pragma unroll
            for (int ai = 0; ai < 2; ++ai)
#pragma unroll
                for (int m = 0; m < 4; ++m) { const int row = row0 + ai * 128 + m * 16; const float rs = row_rstd16(SS + (size_t)row * 16);
                    f32x4 z[2][2]; float ss = 0.f;
#pragma unroll
                    for (int bj = 0; bj < 2; ++bj)
#pragma unroll
                        for (int n = 0; n < 2; ++n) { z[bj][n] = acc[ai][bj][m][n] * rs; const f32x4 q = z[bj][n] * z[bj][n]; ss += (q[0] + q[1]) + (q[2] + q[3]); }
                    ss += __shfl_xor(ss, 16); ss += __shfl_xor(ss, 32);
                    const float r = rsqrtf(ss * (1.f / DH) + EPS) * (isq ? QSCALE : 1.f);
#pragma unroll
                    for (int bj = 0; bj < 2; ++bj) *(u32x4*)(dst + (size_t)row * CA + hs * 64 + 32 * bj + 8 * fq) = pack8(z[bj][0] * r * gv[bj][0], z[bj][1] * r * gv[bj][1]); }
        }
    }
};

struct EpiOutProj {
    static constexpr bool PERM = false;
    const float* xin; float* out; bf16_t* X1B; float* SS1;
    __device__ __forceinline__ void operator()(const f32x4 (&acc)[2][2][4][2], const pg8::Unit& u, int wr, int wc, int fr, int fq) const {
        const int row0 = u.pm * 256 + wr * 64 + fr, col0 = u.pn * 256 + wc * 32 + 4 * fq;
#pragma unroll
        for (int ai = 0; ai < 2; ++ai)
#pragma unroll
            for (int m = 0; m < 4; ++m) { const int row = row0 + ai * 128 + m * 16; float ss = 0.f;
#pragma unroll
                for (int bj = 0; bj < 2; ++bj)
#pragma unroll
                    for (int n = 0; n < 2; ++n) { const size_t off = (size_t)row * D + col0 + bj * 128 + n * 16; const f32x4 x = *(const f32x4*)(xin + off) + acc[ai][bj][m][n];
                        *(f32x4*)(out + off) = x; const f32x4 q = x * x; ss += (q[0] + q[1]) + (q[2] + q[3]);
                        u32x2 w; w.x = pg8::cvt_pk_bf16(x[0], x[1]); w.y = pg8::cvt_pk_bf16(x[2], x[3]); *(u32x2*)(X1B + off) = w; }
                ss += __shfl_xor(ss, 16); ss += __shfl_xor(ss, 32);
                if (fq == 0) SS1[(size_t)row * 16 + u.pn * 4 + wc] = ss; }
    }
};

struct EpiMoe1 {
    static constexpr bool PERM = true;
    const int* LIST; const float* RS1; const float* WTS; bf16_t* ACT;
    __device__ __forceinline__ void operator()(const f32x4 (&acc)[2][2][4][2], const pg8::Unit& u, int wr, int wc, int fr, int fq) const {
        const int pn = u.pn;
#pragma unroll
        for (int ai = 0; ai < 2; ++ai)
#pragma unroll
            for (int m = 0; m < 4; ++m) { const int r = ai * 128 + wr * 64 + m * 16 + fr; const int tok = (r < u.acount) ? LIST[u.arow0 + r] : 0;
                const float rs = RS1[tok], w = WTS[tok * 2 + (pn >> 1)];
                f32x4 o[2];
#pragma unroll
                for (int n = 0; n < 2; ++n) { const f32x4 g = acc[ai][0][m][n] * rs, uu = acc[ai][1][m][n] * (rs * w);
                    o[n] = (f32x4){g[0] * sigmoidf_(g[0]) * uu[0], g[1] * sigmoidf_(g[1]) * uu[1], g[2] * sigmoidf_(g[2]) * uu[2], g[3] * sigmoidf_(g[3]) * uu[3]}; }
                *(u32x4*)(ACT + (size_t)(u.pm * 256 + r) * 512 + (pn >> 1) * 256 + (pn & 1) * 128 + wc * 32 + 8 * fq) = pack8(o[0], o[1]); }
    }
};

struct EpiMoe2 {
    static constexpr bool PERM = false;
    const int* LIST; float* out; bf16_t* XB; float* SS; int last;
    __device__ __forceinline__ void operator()(const f32x4 (&acc)[2][2][4][2], const pg8::Unit& u, int wr, int wc, int fr, int fq) const {
        const int col0 = u.pn * 256 + wc * 32 + 4 * fq;
#pragma unroll
        for (int ai = 0; ai < 2; ++ai)
#pragma unroll
            for (int m = 0; m < 4; ++m) { const int r = ai * 128 + wr * 64 + m * 16 + fr; const bool valid = r < u.acount; float ss = 0.f; int tok = 0;
                if (valid) { tok = LIST[u.aux + r];
#pragma unroll
                    for (int bj = 0; bj < 2; ++bj)
#pragma unroll
                        for (int n = 0; n < 2; ++n) { const size_t off = (size_t)tok * D + col0 + bj * 128 + n * 16; const f32x4 x = *(const f32x4*)(out + off) + acc[ai][bj][m][n];
                            *(f32x4*)(out + off) = x; const f32x4 q = x * x; ss += (q[0] + q[1]) + (q[2] + q[3]);
                            if (!last) { u32x2 w; w.x = pg8::cvt_pk_bf16(x[0], x[1]); w.y = pg8::cvt_pk_bf16(x[2], x[3]); *(u32x2*)(XB + off) = w; } } }
                ss += __shfl_xor(ss, 16); ss += __shfl_xor(ss, 32);
                if (valid && fq == 0 && !last) SS[(size_t)tok * 16 + u.pn * 4 + wc] = ss;
                asm volatile("" ::: "memory"); }
    }
};

__device__ __forceinline__ int crow(int r, int hi) { return (r & 3) + 8 * (r >> 2) + 4 * hi; }
typedef short v4i16_t __attribute__((ext_vector_type(4)));
__device__ __forceinline__ s16x4 vtr(const LAS unsigned char* p) { return __builtin_bit_cast(s16x4, __builtin_amdgcn_ds_read_tr16_b64_v4i16((LAS v4i16_t*)p)); }
constexpr int AT_K = 0, AT_V = 32768;

__device__ __forceinline__ void attn_unit(const Args& args, Frame& F, int l, int b, int h, int qb, float lam, float lam_init) {
    int tid = F.tid; asm volatile("" : "+v"(tid)); const int lane = tid & 63, wave = F.wave, r32 = lane & 31, hi = lane >> 5;
    const int mp = wave >> 2, rg = wave & 3;
    LAS unsigned char* lds = F.lds;
    const bf16_t* Qg = (const bf16_t*)(args.ws + WS_Q); const bf16_t* Kg = (const bf16_t*)(args.ws + WS_K); const bf16_t* Vg = (const bf16_t*)(args.ws + WS_V);
    bf16_t* MIX = (bf16_t*)(args.ws + WS_MIX);
    const int q0 = qb * 128, nt = 2 * qb + 2;
    const int qpos = q0 + 32 * rg + r32;
    const size_t rowb = (size_t)b * SEQ;
    const float slope = (h == 0) ? 0.25f : (h == 1) ? 0.0625f : (h == 2) ? 0.015625f : 0.00390625f;
    const float sl2 = slope * 1.4426950408889634f;
    int srow[2], sch[2]; unsigned kdst[2], vdst[2];
#pragma unroll
    for (int i = 0; i < 2; ++i) { const int c = tid + 512 * i; srow[i] = c >> 4; sch[i] = c & 15; const int row = srow[i], ch = sch[i];
        kdst[i] = (unsigned)(AT_K + (ch >> 3) * 8192 + row * 128 + (((ch & 7) ^ ((row >> 1) & 7)) << 4));
        vdst[i] = (unsigned)(AT_V + 256 * row + 16 * (ch ^ (((row & 3) << 2) | ((row >> 2) & 3)))); }
    u32x4 kst[2], vst[2];
#define AT_LOAD(j) do { _Pragma("unroll") for (int i = 0; i < 2; ++i) { const size_t g_ = ((rowb + (size_t)(j) * 64 + srow[i]) * CA + h * 128) * 2 + sch[i] * 16; \
        kst[i] = *(const u32x4*)((const char*)Kg + g_); vst[i] = *(const u32x4*)((const char*)Vg + g_); } } while (0)
#define AT_STORE(buf) do { _Pragma("unroll") for (int i = 0; i < 2; ++i) { *(LAS u32x4*)(lds + (buf) * 16384 + kdst[i]) = kst[i]; *(LAS u32x4*)(lds + (buf) * 16384 + vdst[i]) = vst[i]; } } while (0)
    AT_LOAD(0);
    bf16x8 qr[4];
    { const bf16_t* qp = Qg + (rowb + qpos) * CA + h * 128 + mp * 64 + 8 * hi;
#pragma unroll
      for (int ks = 0; ks < 4; ++ks) qr[ks] = *(const bf16x8*)(qp + 16 * ks); }
    f32x16 o[4];
#pragma unroll
    for (int d = 0; d < 4; ++d) o[d] = f32x16{};
    float m_run = -INFINITY, l_run = 0.f;
    unsigned vaddr[4][2];
#pragma unroll
    for (int db = 0; db < 4; ++db)
#pragma unroll
        for (int sub = 0; sub < 2; ++sub) { const int rb = 4 * hi + 8 * sub + ((lane & 15) >> 2); const int ch = 4 * db + 2 * ((lane >> 4) & 1) + ((lane >> 1) & 1); const int x = ((rb & 3) << 2) | ((rb >> 2) & 3);
            vaddr[db][sub] = (unsigned)(AT_V + 256 * rb + 16 * (ch ^ x) + 8 * (lane & 1)); }
    AT_STORE(0);
    __syncthreads();
    for (int j = 0; j < nt; ++j) {
        const int buf = j & 1;
        if (j + 1 < nt) AT_LOAD(j + 1);
        if (64 * j <= q0 + 32 * rg + 31) {
            const LAS unsigned char* KB = lds + buf * 16384 + AT_K + mp * 8192;
            f32x16 p0, p1;
            { const float base = sl2 * (float)(64 * j - qpos + 4 * hi);
#pragma unroll
              for (int r = 0; r < 16; ++r) { p0[r] = __builtin_fmaf(sl2, (float)((r & 3) + 8 * (r >> 2)), base); p1[r] = p0[r] + 32.f * sl2; } }
#pragma unroll
            for (int ks = 0; ks < 4; ++ks) { const int cc = 2 * ks + hi;
                const bf16x8 k0 = *(const LAS bf16x8*)(KB + r32 * 128 + ((cc ^ ((r32 >> 1) & 7)) << 4));
                const bf16x8 k1 = *(const LAS bf16x8*)(KB + (r32 + 32) * 128 + ((cc ^ (((r32 + 32) >> 1) & 7)) << 4));
                p0 = __builtin_amdgcn_mfma_f32_32x32x16_bf16(k0, qr[ks], p0, 0, 0, 0);
                p1 = __builtin_amdgcn_mfma_f32_32x32x16_bf16(k1, qr[ks], p1, 0, 0, 0); }
            if (64 * j + 63 > q0 + 32 * rg) {
#pragma unroll
                for (int r = 0; r < 16; ++r) { const int kv = 64 * j + crow(r, hi); if (kv > qpos) p0[r] = -INFINITY; if (kv + 32 > qpos) p1[r] = -INFINITY; }
            }
            float mx = fmaxf(p0[0], p1[0]);
#pragma unroll
            for (int r = 1; r < 16; ++r) mx = fmaxf(mx, fmaxf(p0[r], p1[r]));
            mx = fmaxf(mx, __shfl_xor(mx, 32));
            const float m_new = fmaxf(m_run, mx);
            const float alpha = __builtin_amdgcn_exp2f(m_run - m_new);
            m_run = m_new;
            float rsum = 0.f;
#pragma unroll
            for (int r = 0; r < 16; ++r) { p0[r] = __builtin_amdgcn_exp2f(p0[r] - m_new); p1[r] = __builtin_amdgcn_exp2f(p1[r] - m_new); rsum += p0[r] + p1[r]; }
            l_run = l_run * alpha + rsum;
#pragma unroll
            for (int d = 0; d < 4; ++d)
#pragma unroll
                for (int r = 0; r < 16; ++r) o[d][r] *= alpha;
            bf16x8 pb[4];
            { u32x4 w;
              w.x = pg8::cvt_pk_bf16(p0[0], p0[1]); w.y = pg8::cvt_pk_bf16(p0[2], p0[3]); w.z = pg8::cvt_pk_bf16(p0[4], p0[5]); w.w = pg8::cvt_pk_bf16(p0[6], p0[7]); pb[0] = __builtin_bit_cast(bf16x8, w);
              w.x = pg8::cvt_pk_bf16(p0[8], p0[9]); w.y = pg8::cvt_pk_bf16(p0[10], p0[11]); w.z = pg8::cvt_pk_bf16(p0[12], p0[13]); w.w = pg8::cvt_pk_bf16(p0[14], p0[15]); pb[1] = __builtin_bit_cast(bf16x8, w);
              w.x = pg8::cvt_pk_bf16(p1[0], p1[1]); w.y = pg8::cvt_pk_bf16(p1[2], p1[3]); w.z = pg8::cvt_pk_bf16(p1[4], p1[5]); w.w = pg8::cvt_pk_bf16(p1[6], p1[7]); pb[2] = __builtin_bit_cast(bf16x8, w);
              w.x = pg8::cvt_pk_bf16(p1[8], p1[9]); w.y = pg8::cvt_pk_bf16(p1[10], p1[11]); w.z = pg8::cvt_pk_bf16(p1[12], p1[13]); w.w = pg8::cvt_pk_bf16(p1[14], p1[15]); pb[3] = __builtin_bit_cast(bf16x8, w); }
            const LAS unsigned char* VB = lds + buf * 16384;
#pragma unroll
            for (int db = 0; db < 4; ++db)
#pragma unroll
                for (int ks = 0; ks < 4; ++ks) { const s16x4 lo = vtr(VB + vaddr[db][0] + ks * 4096), h4 = vtr(VB + vaddr[db][1] + ks * 4096);
                    const bf16x8 vf = (bf16x8){lo[0], lo[1], lo[2], lo[3], h4[0], h4[1], h4[2], h4[3]};
                    o[db] = __builtin_amdgcn_mfma_f32_32x32x16_bf16(vf, pb[ks], o[db], 0, 0, 0); }
        }
        if (j + 1 < nt) AT_STORE(buf ^ 1);
        __syncthreads();
    }
#undef AT_LOAD
#undef AT_STORE
    l_run += __shfl_xor(l_run, 32);
    const float inv = 1.f / l_run;
    LAS float* X = (LAS float*)lds + rg * 4096;
    if (mp == 1) { const float f = lam * inv;
#pragma unroll
        for (int db = 0; db < 4; ++db)
#pragma unroll
            for (int r = 0; r < 16; ++r) X[(32 * db + crow(r, hi)) * 32 + r32] = o[db][r] * f; }
    __syncthreads();
    if (mp == 0) { float ss = 0.f;
#pragma unroll
        for (int db = 0; db < 4; ++db)
#pragma unroll
            for (int r = 0; r < 16; ++r) { const float v = o[db][r] * inv - X[(32 * db + crow(r, hi)) * 32 + r32]; o[db][r] = v; ss += v * v; }
        ss += __shfl_xor(ss, 32);
        const float rn = rsqrtf(ss * (1.f / DV) + EPS) * (1.f - lam_init);
        const float* gs = args.in[I_ASG] + l * DV;
        bf16_t* orow = MIX + (rowb + qpos) * D + 512 + h * 128;
#pragma unroll
        for (int db = 0; db < 4; ++db)
#pragma unroll
            for (int rr = 0; rr < 4; ++rr) { const int d0 = 32 * db + 8 * rr + 4 * hi; const f32x4 g = *(const f32x4*)(gs + d0);
                u32x2 w; w.x = pg8::cvt_pk_bf16(o[db][4 * rr] * rn * g[0], o[db][4 * rr + 1] * rn * g[1]); w.y = pg8::cvt_pk_bf16(o[db][4 * rr + 2] * rn * g[2], o[db][4 * rr + 3] * rn * g[3]);
                *(u32x2*)(orow + d0) = w; } }
    __syncthreads();
}

constexpr int LM_UH = 0, LM_Y = 49152, LM_A = 0, LM_PH = 49152, LM_D = 0;
__device__ __forceinline__ void local_unit(const Args& args, Frame& F, int l, int tile) {
    int tid = F.tid; asm volatile("" : "+v"(tid)); int lane = tid & 63; const int wave = F.wave;
#define LM_RELAUNDER() do { asm volatile("" : "+v"(tid)); lane = tid & 63; } while (0)
    LAS unsigned char* lds = F.lds;
    const int b = tile / 32, t0 = (tile % 32) * 64; const size_t row0 = (size_t)b * SEQ + t0;
    const bf16_t* U = (const bf16_t*)(args.ws + WS_U); const bf16_t* PIN = (const bf16_t*)(args.ws + WS_PIN); bf16_t* MIX = (bf16_t*)(args.ws + WS_MIX);
    for (int c = tid; c < 94 * 32; c += NTHREADS) { const int i = c >> 5, ch = c & 31; const int t = t0 - 30 + i;
        u32x4 v = (u32x4){0u, 0u, 0u, 0u}; if (t >= 0) v = *(const u32x4*)(U + ((size_t)b * SEQ + t) * CC + ch * 8);
        *(LAS u32x4*)(lds + LM_UH + i * 512 + ch * 16) = v; }
    LM_RELAUNDER();
    int c2 = tid & 127, tg = tid >> 7;
    float w0[CW], w1[CW];
#pragma unroll
    for (int j = 0; j < CW; ++j) { const f32x2 w = *(const f32x2*)(args.in[I_CW] + (size_t)(l * CW + j) * CC + 2 * c2); w0[j] = w.x; w1[j] = w.y; }
    float y0[16], y1[16];
    { const f32x2 bb = *(const f32x2*)(args.in[I_CB] + l * CC + 2 * c2);
#pragma unroll
      for (int k = 0; k < 16; ++k) { y0[k] = bb.x; y1[k] = bb.y; } }
    __syncthreads();
#pragma unroll
    for (int ii = 0; ii < 46; ++ii) { const unsigned uu = *(const LAS unsigned*)(lds + LM_UH + (16 * tg + ii) * 512 + c2 * 4); const float u0 = bf2f(uu & 0xffffu), u1 = bf2f(uu >> 16);
#pragma unroll
        for (int k = 0; k < 16; ++k) if (ii - k >= 0 && ii - k <= 30) { y0[k] += w0[ii - k] * u0; y1[k] += w1[ii - k] * u1; } }
#pragma unroll
    for (int k = 0; k < 16; ++k) *(LAS f32x2*)(lds + LM_Y + ((16 * tg + k) * 256 + 2 * c2) * 4) = (f32x2){y0[k], y1[k]};
    __syncthreads();
    LM_RELAUNDER();
    { const f32x4 lg = *(const f32x4*)(args.in[I_CLG] + l * CC + 4 * lane), lb = *(const f32x4*)(args.in[I_CLB] + l * CC + 4 * lane);
#pragma unroll 2
      for (int i = 0; i < 8; ++i) { const int row = wave * 8 + i; const f32x4 x = *(const LAS f32x4*)(lds + LM_Y + (row * 256 + 4 * lane) * 4);
        const float mean = wave_sum((x[0] + x[1]) + (x[2] + x[3])) * (1.f / CC); const f32x4 dx = x - mean;
        const float var = wave_sum((dx[0] * dx[0] + dx[1] * dx[1]) + (dx[2] * dx[2] + dx[3] * dx[3])) * (1.f / CC); const float rstd = rsqrtf(var + EPS);
        f32x4 yv = dx * rstd * lg + lb; yv = (f32x4){yv[0] * sigmoidf_(yv[0]), yv[1] * sigmoidf_(yv[1]), yv[2] * sigmoidf_(yv[2]), yv[3] * sigmoidf_(yv[3])};
        u32x2 w; w.x = pg8::cvt_pk_bf16(yv[0], yv[1]); w.y = pg8::cvt_pk_bf16(yv[2], yv[3]);
        *(LAS u32x2*)(lds + LM_A + row * 512 + (((lane >> 1) ^ (row & 15)) << 4) + 8 * (lane & 1)) = w; } }
    __syncthreads();
    LM_RELAUNDER();
    { const int mf = wave & 3, nh = wave >> 2, fr = lane & 15, fq = lane >> 4; const int arow = 16 * mf + fr;
      bf16x8 af[8];
#pragma unroll
      for (int ks = 0; ks < 8; ++ks) af[ks] = *(const LAS bf16x8*)(lds + LM_A + arow * 512 + (((4 * ks + fq) ^ (arow & 15)) << 4));
      const bf16_t* Wp = (const bf16_t*)(args.ws + WS_WPW) + (size_t)l * CC * CC;
      const float* bp = args.in[I_CPB] + l * CC;
#pragma unroll 2
      for (int nf = 0; nf < 8; ++nf) { f32x4 acc = (f32x4){0.f, 0.f, 0.f, 0.f}; const bf16_t* wr_ = Wp + (size_t)(128 * nh + 16 * nf + fr) * CC + 8 * fq;
#pragma unroll
        for (int ks = 0; ks < 8; ++ks) { const bf16x8 bfr = *(const bf16x8*)(wr_ + 32 * ks); acc = __builtin_amdgcn_mfma_f32_16x16x32_bf16(bfr, af[ks], acc, 0, 0, 0); }
        const int n0 = 128 * nh + 16 * nf + 4 * fq; const f32x4 bv = *(const f32x4*)(bp + n0); acc = acc + bv;
        u32x2 w; w.x = pg8::cvt_pk_bf16(acc[0], acc[1]); w.y = pg8::cvt_pk_bf16(acc[2], acc[3]);
        *(u32x2*)(MIX + (row0 + arow) * D + n0) = w; } }
    LM_RELAUNDER();
    for (int c = tid; c < 79 * 32; c += NTHREADS) { const int i = c >> 5, ch = c & 31; const int t = t0 - 15 + i;
        u32x4 v = (u32x4){0u, 0u, 0u, 0u}; if (t >= 0) v = *(const u32x4*)(PIN + ((size_t)b * SEQ + t) * CP + ch * 8);
        *(LAS u32x4*)(lds + LM_PH + i * 512 + ch * 16) = v; }
    __syncthreads();
    LM_RELAUNDER(); c2 = tid & 127; tg = tid >> 7;
    { const int gi = c2 >> 5, win = 2 << gi; const int r0 = 15 + 16 * tg;
      float s0 = 0.f, s1 = 0.f;
      for (int i = r0 - win + 1; i < r0; ++i) { const unsigned uu = *(const LAS unsigned*)(lds + LM_PH + i * 512 + c2 * 4); s0 += bf2f(uu & 0xffffu); s1 += bf2f(uu >> 16); }
#pragma unroll
      for (int k = 0; k < 16; ++k) { const unsigned uu = *(const LAS unsigned*)(lds + LM_PH + (r0 + k) * 512 + c2 * 4); const float u0 = bf2f(uu & 0xffffu), u1 = bf2f(uu >> 16);
        s0 += u0; s1 += u1; const int tpos = t0 + 16 * tg + k; const float cnt = (float)((tpos + 1 < win) ? (tpos + 1) : win); const float ic = 1.f / cnt;
        const int row = 16 * tg + k;
        *(LAS unsigned*)(lds + LM_D + row * 512 + (((c2 >> 2) ^ (row & 15)) << 4) + 4 * (c2 & 3)) = pg8::cvt_pk_bf16(s0 * ic - u0, s1 * ic - u1);
        const unsigned ul = *(const LAS unsigned*)(lds + LM_PH + (r0 + k - win + 1) * 512 + c2 * 4); s0 -= bf2f(ul & 0xffffu); s1 -= bf2f(ul >> 16); } }
    __syncthreads();
    LM_RELAUNDER();
    { const int gi = wave >> 1, fr = lane & 15, fq = lane >> 4;
      const bf16_t* Wp = (const bf16_t*)(args.ws + WS_WPOOL) + (size_t)(l * 4 + gi) * 64 * 64; const float* sc = args.in[I_PS] + l * CP + 64 * gi;
#pragma unroll
      for (int mf = 0; mf < 2; ++mf) { const int arow = 32 * (wave & 1) + 16 * mf + fr;
        bf16x8 af[2];
#pragma unroll
        for (int ks = 0; ks < 2; ++ks) af[ks] = *(const LAS bf16x8*)(lds + LM_D + arow * 512 + (((8 * gi + 4 * ks + fq) ^ (arow & 15)) << 4));
#pragma unroll
        for (int nf = 0; nf < 4; ++nf) { f32x4 acc = (f32x4){0.f, 0.f, 0.f, 0.f};
#pragma unroll
            for (int ks = 0; ks < 2; ++ks) { const bf16x8 bfr = *(const bf16x8*)(Wp + (size_t)(16 * nf + fr) * 64 + 32 * ks + 8 * fq); acc = __builtin_amdgcn_mfma_f32_16x16x32_bf16(bfr, af[ks], acc, 0, 0, 0); }
            const int d0 = 16 * nf + 4 * fq; const f32x4 sv = *(const f32x4*)(sc + d0); acc = acc * sv;
            u32x2 w; w.x = pg8::cvt_pk_bf16(acc[0], acc[1]); w.y = pg8::cvt_pk_bf16(acc[2], acc[3]);
            *(u32x2*)(MIX + (row0 + arow) * D + 256 + 64 * gi + d0) = w; } } }
    __syncthreads();
#undef LM_RELAUNDER
}

__device__ __forceinline__ void router_phase(const Args& args, Frame& F, int l) {
    const int tid = F.tid, lane = F.lane, wave = F.wave;
    LAS unsigned char* lds = F.lds;
    LAS float* WRl = (LAS float*)lds;
    LAS int* bk = (LAS int*)(lds + 81920);
    LAS int* base = (LAS int*)(lds + 81920 + 512);
    const float* WR = (const float*)(args.ws + WS_WR) + (size_t)l * 20 * D;
    for (int i = tid; i < 20 * D / 4; i += NTHREADS) ((LAS f32x4*)WRl)[i] = ((const f32x4*)WR)[i];
    __syncthreads();
    const float* X1 = args.out; const float* SS1 = (const float*)(args.ws + WS_SS1);
    float* RS1 = (float*)(args.ws + WS_RS1); float* WTS = (float*)(args.ws + WS_WTS); int* TOKB = (int*)(args.ws + WS_TOKB); int* LIST = (int*)(args.ws + WS_LIST);
    unsigned* gcnt = (unsigned*)(args.ws + WS_CTL) + CW_CNT + l * 64;
    const float* bgp = args.in[I_RGB] + l * 4; const float* bep = args.in[I_REB] + l * 16;
    for (int blk = F.vcu; blk < T / 128; blk += F.G) {
        for (int i = 0; i < 16; ++i) { const int lr = wave * 16 + i; const int row = blk * 128 + lr;
            const float rstd = row_rstd16(SS1 + (size_t)row * 16);
            f32x4 x[4];
#pragma unroll
            for (int j = 0; j < 4; ++j) x[j] = ((const f32x4*)(X1 + (size_t)row * D))[lane + 64 * j];
            float lg[20];
#pragma unroll
            for (int jj = 0; jj < 20; ++jj) { float a = 0.f;
#pragma unroll
                for (int j = 0; j < 4; ++j) { const f32x4 w = ((const LAS f32x4*)(WRl + jj * D))[lane + 64 * j]; a += (x[j][0] * w[0] + x[j][1] * w[1]) + (x[j][2] * w[2] + x[j][3] * w[3]); }
                lg[jj] = wave_sum(a) * rstd; }
            float g4[4];
#pragma unroll
            for (int j = 0; j < 4; ++j) g4[j] = lg[j] + bgp[j];
            int gidx = 0; float gm = g4[0];
#pragma unroll
            for (int j = 1; j < 4; ++j) if (g4[j] > gm) { gm = g4[j]; gidx = j; }
            float gs = 0.f;
#pragma unroll
            for (int j = 0; j < 4; ++j) gs += __expf(g4[j] - gm);
            const float gp = 1.f / gs;
            float le[4];
#pragma unroll
            for (int j = 0; j < 4; ++j) { const float v = (gidx == 0) ? lg[4 + j] : (gidx == 1) ? lg[8 + j] : (gidx == 2) ? lg[12 + j] : lg[16 + j];
                const float bb = (gidx == 0) ? bep[j] : (gidx == 1) ? bep[4 + j] : (gidx == 2) ? bep[8 + j] : bep[12 + j]; le[j] = v + bb; }
            int ia = 0; float la = le[0];
#pragma unroll
            for (int j = 1; j < 4; ++j) if (le[j] > la) { la = le[j]; ia = j; }
            int ib = -1; float lb = -INFINITY;
#pragma unroll
            for (int j = 0; j < 4; ++j) if (j != ia && le[j] > lb) { lb = le[j]; ib = j; }
            const float pa = 1.f / (1.f + __expf(lb - la)), pbv = 1.f - pa;
            const float wa = gp * pa, wb = gp * pbv;
            const int lo = ia < ib ? ia : ib, hi2 = ia < ib ? ib : ia; const float wlo = ia < ib ? wa : wb, whi = ia < ib ? wb : wa;
            const int pi = (lo == 0) ? (hi2 - 1) : (lo == 1) ? (hi2 + 1) : 5;
            const int bkt = gidx * 6 + pi;
            if (lane == 0) { RS1[row] = rstd; WTS[row * 2] = wlo; WTS[row * 2 + 1] = whi; bk[lr] = bkt; }
        }
        __syncthreads();
        int mybk = 0, lpos = 0;
        if (tid < 128) { mybk = bk[tid]; for (int r = 0; r < tid; ++r) lpos += (bk[r] == mybk) ? 1 : 0; }
        if (tid >= 128 && tid < 128 + NBKT) { const int bq = tid - 128; int c = 0; for (int r = 0; r < 128; ++r) c += (bk[r] == bq) ? 1 : 0;
            base[bq] = (int)__hip_atomic_fetch_add(gcnt + bq, (unsigned)c, __ATOMIC_RELAXED, __HIP_MEMORY_SCOPE_AGENT); }
        __syncthreads();
        if (tid < 128) { const int row = blk * 128 + tid; const int pos = base[mybk] + lpos; LIST[(size_t)mybk * T + pos] = row; TOKB[row * 2] = mybk; TOKB[row * 2 + 1] = pos; }
        __syncthreads();
    }
}

constexpr int N_PHASES = 1 + 6 * NL;
__global__ void __launch_bounds__(NTHREADS, 2) mega_fwd(Args args) {
    extern __shared__ __attribute__((aligned(16))) unsigned char lds_[];
    Frame F;
    F.lds = (LAS unsigned char*)lds_;
    F.tid = threadIdx.x; F.lane = F.tid & 63; F.wave = __builtin_amdgcn_readfirstlane(F.tid >> 6);
    F.G = gridDim.x; { const int bx = blockIdx.x; F.vcu = (F.G % 8 == 0) ? (bx % 8) * (F.G / 8) + bx / 8 : bx; }
    volatile LAS unsigned* MISC = (volatile LAS unsigned*)(F.lds + MISC_OFF);
    for (int u = F.tid; u < 256; u += NTHREADS) MISC[u] = 0u;
    __syncthreads();
    unsigned char* ws = args.ws;
    unsigned* ctl = (unsigned*)(ws + WS_CTL);
    const int lo = args.ph_lo, hi = args.ph_hi;
    XcdBarrier bar; bar.bar = ctl + CW_BAR; bar.x = 0; bar.st = nullptr;
    if (hi - lo > 1) bar = xcd_barrier_post(ctl + CW_BAR, MISC + 8);
#ifdef ONLY_KIND
#define IN(k) ((((k)==0?0:(((k)-1)%6)+1))==ONLY_KIND && lo <= (k) && (k) < hi)
#else
#define IN(k) (lo <= (k) && (k) < hi)
#endif
#define SEAM(k) do { if (IN(k) && IN((k) + 1)) xcd_barrier(bar); } while (0)
#define RELAUNDER() do { int t_ = threadIdx.x; asm volatile("" : "+v"(t_)); F.tid = t_; F.lane = t_ & 63; } while (0)
    if (IN(0)) { p0_prologue(args, F); SEAM(0); }
    for (int l = 0; l < NL; ++l) {
        const int pb = 1 + 6 * l;
        const float* xin = (l == 0) ? args.in[I_X] : args.out;
        if (IN(pb)) { RELAUNDER();
            pg8::Gemm g{(const char*)(ws + WS_XB), D, nullptr, D, D, 1 << 30};
            DenseOrder S; S.init(T, NIN, F.G, (int)blockIdx.x, (const bf16_t*)(ws + WS_WIN) + (size_t)l * NIN * D, D);
            EpiInProj E{(const float*)(ws + WS_SS), (bf16_t*)(ws + WS_U), (bf16_t*)(ws + WS_PIN), (bf16_t*)(ws + WS_Q), (bf16_t*)(ws + WS_K), (bf16_t*)(ws + WS_V), args.in[I_QG] + l * DH, args.in[I_KG] + l * DH};
            pg8::gemm_phase<EpiInProj, DenseOrder, true>(F.lds, g, S, E, F.tid);
            SEAM(pb);
        }
        if (IN(pb + 1)) { RELAUNDER();
            const float lam_init = 0.8f - 0.6f * expf(-0.3f * (float)l);
            float lam;
            { const float a = args.in[I_LQ1][l * DH + F.lane] * args.in[I_LK1][l * DH + F.lane], b2 = args.in[I_LQ2][l * DH + F.lane] * args.in[I_LK2][l * DH + F.lane];
              lam = expf(wave_sum(a)) - expf(wave_sum(b2)) + lam_init; }
            for (int v = F.vcu; v < 256; v += F.G) {
                const int bh = v >> 2, s = v & 3;
                for (int i = 0; i < 4; ++i) { const int qb = (i == 0) ? (15 - s) : (i == 1) ? (8 + s) : (i == 2) ? (7 - s) : s;
                    attn_unit(args, F, l, bh >> 2, bh & 3, qb, lam, lam_init); }
            }
            for (int tl = F.vcu; tl < T / 64; tl += F.G) local_unit(args, F, l, tl);
            SEAM(pb + 1);
        }
        if (IN(pb + 2)) { RELAUNDER();
            pg8::Gemm g{(const char*)(ws + WS_MIX), D, nullptr, D, D, 1 << 30};
            DenseOrder S; S.init(T, D, F.G, (int)blockIdx.x, (const bf16_t*)(ws + WS_WOUT) + (size_t)l * D * D, D);
            EpiOutProj E{xin, args.out, (bf16_t*)(ws + WS_X1B), (float*)(ws + WS_SS1)};
            pg8::gemm_phase<EpiOutProj, DenseOrder, true>(F.lds, g, S, E, F.tid);
            SEAM(pb + 2);
        }
        if (IN(pb + 3)) { RELAUNDER(); router_phase(args, F, l); SEAM(pb + 3); }
        if (IN(pb + 4) || IN(pb + 5)) { RELAUNDER();
            LAS int* ti = (LAS int*)(F.lds + LDS_EXTRA + 8192);
            LAS int* tb = ti + 512;
            const unsigned* gc = ctl + CW_CNT + l * 64;
            if (F.tid == 0) { int a = 0; for (int b = 0; b < NBKT; ++b) { const int c = (int)__hip_atomic_load(gc + b, __ATOMIC_RELAXED, __HIP_MEMORY_SCOPE_AGENT); tb[b] = a; a += (c + 255) >> 8; } tb[NBKT] = a; ti[0] = a; }
            __syncthreads();
            if (F.tid < NBKT) { const int b = F.tid; const int c = (int)__hip_atomic_load(gc + b, __ATOMIC_RELAXED, __HIP_MEMORY_SCOPE_AGENT); const int t0 = tb[b], n = tb[b + 1] - t0;
                for (int lt = 0; lt < n; ++lt) { ti[2 + 2 * (t0 + lt)] = b | (lt << 8); ti[3 + 2 * (t0 + lt)] = (c - lt * 256) < 256 ? (c - lt * 256) : 256; } }
            __syncthreads();
            if (IN(pb + 4)) { RELAUNDER();
                pg8::Gemm g{(const char*)(ws + WS_X1B), D, (const int*)(ws + WS_LIST), D, D, 1 << 30};
                MoeOrder S{ti, F.G, (int)blockIdx.x, l, 1, (const char*)(ws + WS_WGU)};
                EpiMoe1 E{(const int*)(ws + WS_LIST), (const float*)(ws + WS_RS1), (const float*)(ws + WS_WTS), (bf16_t*)(ws + WS_ACT)};
                pg8::gemm_phase<EpiMoe1, MoeOrder, true>(F.lds, g, S, E, F.tid);
                SEAM(pb + 4);
            }
            if (IN(pb + 5)) { RELAUNDER();
                pg8::Gemm g{(const char*)(ws + WS_ACT), 512, nullptr, DE, 512, 4};
                MoeOrder S{ti, F.G, (int)blockIdx.x, l, 2, (const char*)(ws + WS_WD)};
                EpiMoe2 E{(const int*)(ws + WS_LIST), args.out, (bf16_t*)(ws + WS_XB), (float*)(ws + WS_SS), (l == NL - 1) ? 1 : 0};
                pg8::gemm_phase<EpiMoe2, MoeOrder, true>(F.lds, g, S, E, F.tid);
                SEAM(pb + 5);
            }
        }
    }
#undef IN
#undef SEAM
#undef RELAUNDER
}

#ifdef DBG_CHECK
__device__ __forceinline__ int sample_row(int s) {
    const int tbl[24] = {0, 1, 2, 14, 15, 16, 29, 30, 31, 32, 63, 64, 65, 127, 128, 2047, 2048, 2049, 2063, 2078, 2079, 4095, 4096, 32767};
    if (s < 24) return tbl[s];
    return (int)(((unsigned)s * 2654435761u) % (unsigned)T);
}
__device__ __forceinline__ void rec_err(float* errs, int idx, float e) { if (!(e == e)) e = 1e30f; atomicMax((int*)errs + idx, __float_as_int(e)); }
__device__ __forceinline__ float blk_max(float v, float* sh) {
    __syncthreads(); sh[threadIdx.x] = v; __syncthreads();
    for (int s = 128; s > 0; s >>= 1) { if ((int)threadIdx.x < s) sh[threadIdx.x] = fmaxf(sh[threadIdx.x], sh[threadIdx.x + s]); __syncthreads(); }
    const float r = sh[0]; __syncthreads(); return r;
}
__device__ __forceinline__ float blk_sum(float v, float* sh) {
    __syncthreads(); sh[threadIdx.x] = v; __syncthreads();
    for (int s = 128; s > 0; s >>= 1) { if ((int)threadIdx.x < s) sh[threadIdx.x] += sh[threadIdx.x + s]; __syncthreads(); }
    const float r = sh[0]; __syncthreads(); return r;
}
__global__ void chk_prologue(Args a, float* errs) {
    __shared__ float sh[256];
    const int r = sample_row(blockIdx.x); const float* x = a.in[I_X] + (size_t)r * D; const bf16_t* xb = (const bf16_t*)(a.ws + WS_XB) + (size_t)r * D;
    float e = 0.f, s = 0.f;
    for (int k = threadIdx.x; k < D; k += 256) { e = fmaxf(e, fabsf(bf2f(xb[k]) - x[k]) / (fabsf(x[k]) + 1.f)); s += x[k] * x[k]; }
    s = blk_sum(s, sh); const float* ss = (const float*)(a.ws + WS_SS) + (size_t)r * 16; float s2 = 0.f; for (int i = 0; i < 16; ++i) s2 += ss[i];
    e = fmaxf(e, fabsf(s2 - s) / (s + 1.f) * 10.f);
    for (int l = 0; l < NL; ++l) { const unsigned hsh = (blockIdx.x * 256u + threadIdx.x) * 2654435761u + l * 97u;
        { const int n = hsh % D, k = (hsh >> 10) % D; const float w = a.in[I_WOUT][(size_t)l * D * D + (size_t)k * D + n]; const float g = bf2f(((const bf16_t*)(a.ws + WS_WOUT))[(size_t)l * D * D + (size_t)n * D + k]); e = fmaxf(e, fabsf(g - w) * 20.f); }
        { const int ee = hsh % NE, n = (hsh >> 4) % D, k = (hsh >> 14) % DE; const float w = a.in[I_WDN][((size_t)(l * NE + ee) * DE + k) * D + n]; const float g = bf2f(((const bf16_t*)(a.ws + WS_WD))[((size_t)(l * NE + ee) * D + n) * DE + k]); e = fmaxf(e, fabsf(g - w) * 20.f); }
        { const int ee = hsh % NE, j = (hsh >> 4) % DE, k = (hsh >> 12) % D, gu = (hsh >> 22) & 1; const float w = (gu ? a.in[I_WU] : a.in[I_WG])[((size_t)(l * NE + ee) * D + k) * DE + j] * a.in[I_FNG][l * D + k];
          const int p = (j >> 7) * 256 + gu * 128 + (j & 127); const float g = bf2f(((const bf16_t*)(a.ws + WS_WGU))[((size_t)(l * NE + ee) * 512 + p) * D + k]); e = fmaxf(e, fabsf(g - w) * 20.f); }
        { const int j = hsh % 20, k = (hsh >> 5) % D; const float w = ((j < 4) ? a.in[I_RGW][(size_t)(l * D + k) * 4 + j] : a.in[I_REW][(size_t)(l * D + k) * 16 + j - 4]) * a.in[I_FNG][l * D + k];
          const float g = ((const float*)(a.ws + WS_WR))[(size_t)(l * 20 + j) * D + k]; e = fmaxf(e, fabsf(g - w) * 100.f); }
    }
    e = blk_max(e, sh); if (threadIdx.x == 0) rec_err(errs, 0, e);
}
__global__ void chk_inproj(Args a, int l, float* errs) {
    __shared__ float z[NIN]; __shared__ float sh[256];
    const int r = sample_row(blockIdx.x); const bf16_t* xb = (const bf16_t*)(a.ws + WS_XB) + (size_t)r * D;
    const float* ss = (const float*)(a.ws + WS_SS) + (size_t)r * 16; float s2 = 0.f; for (int i = 0; i < 16; ++i) s2 += ss[i];
    const float rstd = rsqrtf(s2 / D + EPS); const float* W = a.in[I_WIN] + (size_t)l * D * NIN; const float* g = a.in[I_ANG] + l * D;
    for (int c = threadIdx.x; c < NIN; c += 256) { float acc = 0.f; for (int k = 0; k < D; ++k) acc += bf2f(xb[k]) * g[k] * W[(size_t)k * NIN + c]; z[c] = acc * rstd; }
    __syncthreads();
    float e = 0.f; const int t = threadIdx.x;
    { const float ex = z[t] * (1.f / (1.f + expf(-z[256 + t]))); e = fmaxf(e, fabsf(ex - bf2f(((const bf16_t*)(a.ws + WS_U))[(size_t)r * CC + t]))); }
    { e = fmaxf(e, fabsf(z[512 + t] - bf2f(((const bf16_t*)(a.ws + WS_PIN))[(size_t)r * CP + t]))); }
    for (int c = t; c < CA; c += 256) {
        e = fmaxf(e, fabsf(z[1792 + c] - bf2f(((const bf16_t*)(a.ws + WS_V))[(size_t)r * CA + c])));
        const int hs = c >> 6, d = c & 63; float sq = 0.f, sk = 0.f; for (int i = 0; i < 64; ++i) { const float q = z[768 + hs * 64 + i], k = z[1280 + hs * 64 + i]; sq += q * q; sk += k * k; }
        const float eq = z[768 + c] * rsqrtf(sq / 64.f + EPS) * a.in[I_QG][l * DH + d] * QSCALE, ek = z[1280 + c] * rsqrtf(sk / 64.f + EPS) * a.in[I_KG][l * DH + d];
        e = fmaxf(e, fabsf(eq - bf2f(((const bf16_t*)(a.ws + WS_Q))[(size_t)r * CA + c])) * 4.f);
        e = fmaxf(e, fabsf(ek - bf2f(((const bf16_t*)(a.ws + WS_K))[(size_t)r * CA + c])));
    }
    e = blk_max(e, sh); if (t == 0) rec_err(errs, l * 8 + 1, e);
}
__global__ void chk_attn(Args a, int l, float* errs) {
    __shared__ float p[2][SEQ]; __shared__ float sh[256]; __shared__ float ov[DV];
    const int qt[16] = {0, 1, 31, 32, 63, 64, 65, 127, 128, 129, 191, 192, 500, 1023, 1024, 2047};
    const int q = qt[blockIdx.x & 15], h = (blockIdx.x >> 4) & 3, b = (blockIdx.x >> 6) ? 13 : 0; const int t = threadIdx.x;
    const bf16_t* Q = (const bf16_t*)(a.ws + WS_Q); const bf16_t* K = (const bf16_t*)(a.ws + WS_K); const bf16_t* V = (const bf16_t*)(a.ws + WS_V);
    const size_t rb = (size_t)b * SEQ; const float slope = exp2f(-2.f * (h + 1)); const float sl2 = slope * 1.4426950408889634f;
    const float lam_init = 0.8f - 0.6f * expf(-0.3f * (float)l); float s1 = 0.f, s2 = 0.f;
    for (int d = 0; d < DH; ++d) { s1 += a.in[I_LQ1][l * DH + d] * a.in[I_LK1][l * DH + d]; s2 += a.in[I_LQ2][l * DH + d] * a.in[I_LK2][l * DH + d]; }
    const float lam = expf(s1) - expf(s2) + lam_init;
    for (int m = 0; m < 2; ++m) {
        float mx = -INFINITY;
        for (int kv = t; kv <= q; kv += 256) { float s = 0.f; for (int d = 0; d < DH; ++d) s += bf2f(Q[(rb + q) * CA + h * 128 + m * 64 + d]) * bf2f(K[(rb + kv) * CA + h * 128 + m * 64 + d]); s -= sl2 * (float)(q - kv); p[m][kv] = s; mx = fmaxf(mx, s); }
        mx = blk_max(mx, sh); float sm = 0.f;
        for (int kv = t; kv <= q; kv += 256) { const float e_ = exp2f(p[m][kv] - mx); p[m][kv] = e_; sm += e_; }
        sm = blk_sum(sm, sh);
        for (int kv = t; kv <= q; kv += 256) p[m][kv] /= sm;
        __syncthreads();
    }
    float o = 0.f;
    if (t < DV) { for (int kv = 0; kv <= q; ++kv) o += (p[0][kv] - lam * p[1][kv]) * bf2f(V[(rb + kv) * CA + h * 128 + t]); }
    const float ssq = blk_sum(t < DV ? o * o : 0.f, sh);
    float e = 0.f;
    if (t < DV) { const float ex = o * rsqrtf(ssq / DV + EPS) * a.in[I_ASG][l * DV + t] * (1.f - lam_init); e = fabsf(ex - bf2f(((const bf16_t*)(a.ws + WS_MIX))[(rb + q) * D + 512 + h * 128 + t])); }
    e = blk_max(e, sh); if (t == 0) rec_err(errs, l * 8 + 2, e);
}
__global__ void chk_local(Args a, int l, float* errs) {
    __shared__ float sv[CC]; __shared__ float sh[256];
    const int r = sample_row(blockIdx.x); const int b = r / SEQ, tp = r % SEQ; const int t = threadIdx.x;
    const bf16_t* U = (const bf16_t*)(a.ws + WS_U); const bf16_t* PIN = (const bf16_t*)(a.ws + WS_PIN); const bf16_t* MIX = (const bf16_t*)(a.ws + WS_MIX);
    float y = a.in[I_CB][l * CC + t];
    for (int j = 0; j < CW; ++j) { const int tt = tp - 30 + j; if (tt >= 0) y += a.in[I_CW][(size_t)(l * CW + j) * CC + t] * bf2f(U[((size_t)b * SEQ + tt) * CC + t]); }
    const float mean = blk_sum(y, sh) / CC; const float dv = y - mean; const float var = blk_sum(dv * dv, sh) / CC;
    float yn = dv * rsqrtf(var + EPS) * a.in[I_CLG][l * CC + t] + a.in[I_CLB][l * CC + t]; yn = yn / (1.f + expf(-yn));
    sv[t] = yn; __syncthreads();
    float o = a.in[I_CPB][l * CC + t]; for (int c = 0; c < CC; ++c) o += sv[c] * a.in[I_CPW][(size_t)l * CC * CC + (size_t)c * CC + t];
    float e = fabsf(o - bf2f(MIX[(size_t)r * D + t]));
    __syncthreads();
    { const int gi = t >> 6, win = 2 << gi; float s = 0.f; for (int i = 0; i < win; ++i) { const int tt = tp - i; if (tt >= 0) s += bf2f(PIN[((size_t)b * SEQ + tt) * CP + t]); }
      const float cnt = (float)((tp + 1 < win) ? tp + 1 : win); sv[t] = s / cnt - bf2f(PIN[(size_t)r * CP + t]); }
    __syncthreads();
    { const int gi = t >> 6, dd = t & 63; float o2 = 0.f; for (int c = 0; c < 64; ++c) o2 += sv[gi * 64 + c] * a.in[I_PW][((size_t)(l * 4 + gi) * 64 + c) * 64 + dd];
      o2 *= a.in[I_PS][l * CP + t]; e = fmaxf(e, fabsf(o2 - bf2f(MIX[(size_t)r * D + 256 + t]))); }
    e = blk_max(e, sh); if (t == 0) rec_err(errs, l * 8 + 3, e);
}
__global__ void chk_outproj(Args a, int l, float* errs) {
    __shared__ float sh[256];
    const int r = sample_row(blockIdx.x); const int t = threadIdx.x; const bf16_t* MIX = (const bf16_t*)(a.ws + WS_MIX) + (size_t)r * D;
    float e = 0.f, ssq = 0.f;
    for (int n = t; n < D; n += 256) { float acc = 0.f; for (int k = 0; k < D; ++k) acc += bf2f(MIX[k]) * a.in[I_WOUT][(size_t)l * D * D + (size_t)k * D + n];
        const float xin = (l == 0) ? a.in[I_X][(size_t)r * D + n] : bf2f(((const bf16_t*)(a.ws + WS_XB))[(size_t)r * D + n]);
        const float got = a.out[(size_t)r * D + n]; e = fmaxf(e, fabsf(xin + acc - got)); ssq += got * got;
        e = fmaxf(e, fabsf(bf2f(((const bf16_t*)(a.ws + WS_X1B))[(size_t)r * D + n]) - got) / (fabsf(got) + 1.f) * 4.f); }
    ssq = blk_sum(ssq, sh); const float* ss = (const float*)(a.ws + WS_SS1) + (size_t)r * 16; float s2 = 0.f; for (int i = 0; i < 16; ++i) s2 += ss[i];
    e = fmaxf(e, fabsf(s2 - ssq) / (ssq + 1.f) * 10.f);
    e = blk_max(e, sh); if (t == 0) rec_err(errs, l * 8 + 4, e);
}
__global__ void chk_router_moe(Args a, int l, float* errs) {
    __shared__ float sh[256]; __shared__ float hf[D]; __shared__ float lgs[20]; __shared__ float act[2][DE]; __shared__ int eid[2]; __shared__ float wv[2];
    const int r = sample_row(blockIdx.x); const int t = threadIdx.x; const float* x1 = a.out + (size_t)r * D;
    float s = 0.f; for (int k = t; k < D; k += 256) s += x1[k] * x1[k];
    s = blk_sum(s, sh); const float rstd = rsqrtf(s / D + EPS);
    for (int k = t; k < D; k += 256) hf[k] = x1[k] * rstd * a.in[I_FNG][l * D + k];
    __syncthreads();
    if (t < 20) { double acc = 0.0; for (int k = 0; k < D; ++k) acc += (double)hf[k] * (double)((t < 4) ? a.in[I_RGW][(size_t)(l * D + k) * 4 + t] : a.in[I_REW][(size_t)(l * D + k) * 16 + t - 4]);
        lgs[t] = (float)acc + ((t < 4) ? a.in[I_RGB][l * 4 + t] : a.in[I_REB][l * 16 + t - 4]); }
    __syncthreads();
    float e = 0.f;
    if (t == 0) {
        int gi = 0; for (int j = 1; j < 4; ++j) if (lgs[j] > lgs[gi]) gi = j;
        float gs = 0.f; for (int j = 0; j < 4; ++j) gs += expf(lgs[j] - lgs[gi]); const float gp = 1.f / gs;
        const float* le = lgs + 4 + 4 * gi; int ia = 0; for (int j = 1; j < 4; ++j) if (le[j] > le[ia]) ia = j;
        int ib = -1; for (int j = 0; j < 4; ++j) if (j != ia && (ib < 0 || le[j] > le[ib])) ib = j;
        const float pa = 1.f / (1.f + expf(le[ib] - le[ia])); const float wa = gp * pa, wb = gp * (1.f - pa);
        const int lo = ia < ib ? ia : ib, hi = ia < ib ? ib : ia; const float wlo = ia < ib ? wa : wb, whi = ia < ib ? wb : wa;
        const int pi = (lo == 0) ? hi - 1 : (lo == 1) ? hi + 1 : 5; const int bkt = gi * 6 + pi;
        const int* TOKB = (const int*)(a.ws + WS_TOKB); const float* WTS = (const float*)(a.ws + WS_WTS); const int* LIST = (const int*)(a.ws + WS_LIST);
        if (TOKB[r * 2] != bkt) e = 1000.f;
        else { const int pos = TOKB[r * 2 + 1]; const unsigned cnt = ((const unsigned*)(a.ws + WS_CTL))[CW_CNT + l * 64 + bkt];
            if (pos < 0 || (unsigned)pos >= cnt || LIST[(size_t)bkt * T + pos] != r) e = 500.f; }
        e = fmaxf(e, fabsf(WTS[r * 2] - wlo) * 10.f); e = fmaxf(e, fabsf(WTS[r * 2 + 1] - whi) * 10.f);
        e = fmaxf(e, fabsf(((const float*)(a.ws + WS_RS1))[r] - rstd) * 10.f);
        eid[0] = gi * 4 + lo; eid[1] = gi * 4 + hi; wv[0] = wlo; wv[1] = whi;
    }
    __syncthreads();
    for (int s2 = 0; s2 < 2; ++s2) { const int ee = eid[s2]; const float* Wg = a.in[I_WG] + (size_t)(l * NE + ee) * D * DE; const float* Wu = a.in[I_WU] + (size_t)(l * NE + ee) * D * DE;
        float g = 0.f, u = 0.f; for (int k = 0; k < D; ++k) { g += hf[k] * Wg[(size_t)k * DE + t]; u += hf[k] * Wu[(size_t)k * DE + t]; }
        act[s2][t] = g / (1.f + expf(-g)) * u * wv[s2]; }
    __syncthreads();
    float* exp_out = (float*)(a.ws + WS_DBG) + (size_t)blockIdx.x * D;
    for (int n = t; n < D; n += 256) { float y = 0.f; for (int s2 = 0; s2 < 2; ++s2) { const float* Wd = a.in[I_WDN] + (size_t)(l * NE + eid[s2]) * DE * D; for (int j = 0; j < DE; ++j) y += act[s2][j] * Wd[(size_t)j * D + n]; }
        exp_out[n] = x1[n] + y; }
    e = blk_max(e, sh); if (t == 0) rec_err(errs, l * 8 + 5, e);
}
__global__ void chk_moe_post(Args a, int l, float* errs) {
    __shared__ float sh[256];
    const int r = sample_row(blockIdx.x); const int t = threadIdx.x; const float* exp_out = (const float*)(a.ws + WS_DBG) + (size_t)blockIdx.x * D;
    float e = 0.f, ssq = 0.f;
    for (int n = t; n < D; n += 256) { const float got = a.out[(size_t)r * D + n]; e = fmaxf(e, fabsf(got - exp_out[n])); ssq += got * got;
        if (l < NL - 1) e = fmaxf(e, fabsf(bf2f(((const bf16_t*)(a.ws + WS_XB))[(size_t)r * D + n]) - got) / (fabsf(got) + 1.f) * 4.f); }
    ssq = blk_sum(ssq, sh);
    if (l < NL - 1) { const float* ss = (const float*)(a.ws + WS_SS) + (size_t)r * 16; float s2 = 0.f; for (int i = 0; i < 16; ++i) s2 += ss[i]; e = fmaxf(e, fabsf(s2 - ssq) / (ssq + 1.f) * 10.f); }
    e = blk_max(e, sh); if (t == 0) rec_err(errs, l * 8 + 6, e);
}
#ifndef DBG_SHOW
#define DBG_SHOW -2
#endif
__global__ void chk_report(Args a, const float* errs) {
    const float tol[8] = {0.05f, 0.06f, 0.05f, 0.06f, 0.08f, 0.05f, 0.08f, 1e30f};
    int bad = -1; for (int i = 0; i < 16; ++i) if (errs[i] > tol[i & 7]) { bad = i; break; }
    float val = 0.f; bool over = false;
    if (DBG_SHOW == -1) { val = 16.f; over = true; }
    else if (DBG_SHOW >= 0) { val = 1000.f * errs[DBG_SHOW]; over = true; }
    else if (bad >= 0) { val = 8.f * exp2f((float)bad); over = true; }
    if (over) for (size_t i = (size_t)blockIdx.x * blockDim.x + threadIdx.x; i < (size_t)T * D; i += (size_t)gridDim.x * blockDim.x) a.out[i] = val;
}
#endif

extern "C" void kernel_launch(void* const* d_in, const int* in_sizes, int n_in, void* d_out, int out_size, void* d_ws, size_t ws_size, hipStream_t stream) {
    static int grid = 0;
    if (grid == 0) {
        if (n_in != 27 || out_size != T * D || ws_size < WS_END) { fprintf(stderr, "kernel_launch: unexpected shapes (n_in %d out %d ws %zu)\n", n_in, out_size, ws_size); grid = -1; return; }
        int dev = 0, cus = 0, per_cu = 0;
        if (hipGetDevice(&dev) != hipSuccess || hipDeviceGetAttribute(&cus, hipDeviceAttributeMultiprocessorCount, dev) != hipSuccess) { grid = -1; return; }
        if (hipFuncSetAttribute((const void*)mega_fwd, hipFuncAttributeMaxDynamicSharedMemorySize, LDS_BYTES) != hipSuccess) { fprintf(stderr, "kernel_launch: hipFuncSetAttribute failed\n"); grid = -1; return; }
        if (hipOccupancyMaxActiveBlocksPerMultiprocessor(&per_cu, (const void*)mega_fwd, NTHREADS, LDS_BYTES) != hipSuccess || per_cu < 1) fprintf(stderr, "kernel_launch: occupancy query reports %d\n", per_cu);
        (void)hipGetLastError();
        grid = cus;
    }
    if (grid < 0) return;
    (void)hipMemsetAsync((char*)d_ws + WS_CTL, 0, CTL_ZERO_BYTES, stream);
    Args a{};
    for (int i = 0; i < 27; ++i) a.in[i] = (const float*)d_in[i];
    a.out = (float*)d_out; a.ws = (unsigned char*)d_ws;
#ifdef DBG_CHECK
    float* errs = (float*)((char*)d_ws + WS_ERR);
    (void)hipMemsetAsync(errs, 0, 4096, stream);
    auto run = [&](int lo, int hi) { a.ph_lo = lo; a.ph_hi = hi; hipLaunchKernelGGL(mega_fwd, dim3(grid), dim3(NTHREADS), LDS_BYTES, stream, a); };
    run(0, 1); chk_prologue<<<48, 256, 0, stream>>>(a, errs);
    for (int l = 0; l < NL; ++l) { const int pb = 1 + 6 * l;
        run(pb, pb + 1); chk_inproj<<<48, 256, 0, stream>>>(a, l, errs);
        run(pb + 1, pb + 2); chk_attn<<<128, 256, 0, stream>>>(a, l, errs); chk_local<<<48, 256, 0, stream>>>(a, l, errs);
        run(pb + 2, pb + 3); chk_outproj<<<48, 256, 0, stream>>>(a, l, errs);
        run(pb + 3, pb + 4); chk_router_moe<<<48, 256, 0, stream>>>(a, l, errs);
        run(pb + 4, pb + 5); run(pb + 5, pb + 6); chk_moe_post<<<48, 256, 0, stream>>>(a, l, errs);
    }
    chk_report<<<1024, 256, 0, stream>>>(a, errs);
#else
#ifndef N_SPLIT
#define N_SPLIT 0
#endif
    if (N_SPLIT) { for (int p = 0; p < N_PHASES; ++p) { a.ph_lo = p; a.ph_hi = p + 1; hipLaunchKernelGGL(mega_fwd, dim3(grid), dim3(NTHREADS), LDS_BYTES, stream, a); } }
    else { a.ph_lo = 0; a.ph_hi = N_PHASES; hipLaunchKernelGGL(mega_fwd, dim3(grid), dim3(NTHREADS), LDS_BYTES, stream, a); }
#endif
}
```

```cpp
#include <hip/hip_runtime.h>
#include <cstdio>
#include <cstdint>

#define GAS __attribute__((address_space(1)))
#define LAS __attribute__((address_space(3)))
typedef unsigned short bf16_t;
typedef short bf16x8 __attribute__((ext_vector_type(8)));
typedef short s16x4 __attribute__((ext_vector_type(4)));
typedef float f32x4 __attribute__((ext_vector_type(4)));
typedef float f32x2 __attribute__((ext_vector_type(2)));
typedef float f32x16 __attribute__((ext_vector_type(16)));
typedef unsigned u32x4 __attribute__((ext_vector_type(4)));
typedef unsigned u32x2 __attribute__((ext_vector_type(2)));

__device__ __forceinline__ float bf2f(unsigned v) { return __uint_as_float(v << 16); }
__device__ __forceinline__ unsigned f2bf(float f) { unsigned u = __float_as_uint(f); return (u + 0x7fffu + ((u >> 16) & 1u)) >> 16; }
__device__ __forceinline__ unsigned pk2(float lo, float hi) { return f2bf(lo) | (f2bf(hi) << 16); }
__device__ __forceinline__ float wave_sum(float v) {
#pragma unroll
    for (int o = 1; o < 64; o <<= 1) v += __shfl_xor(v, o);
    return v;
}

namespace pg8 {
constexpr int BM = 256, BK = 64, HALF = 128, HTB = HALF * BK * 2, STAGE_BYTES = 8 * HTB;
__host__ __device__ __forceinline__ int lds_byte(int r, int c) { const int st = (r >> 4) * 2 + (c >> 5), rr = r & 15, cc = c & 31, ob = rr * 64 + cc * 2; return st * 1024 + (ob ^ (((ob >> 9) & 1) << 5)); }
__host__ __device__ __forceinline__ void stage_rc(int b, int& R, int& C) { const int st = b / 1024, sb = b % 1024, swz = sb ^ (((sb >> 9) & 1) << 5); R = (st >> 1) * 16 + swz / 64; C = (st & 1) * 32 + (swz % 64) / 2; }
__host__ __device__ __forceinline__ int perm32(int rho) { const int n = rho >> 4, i = rho & 15; return 8 * (i >> 2) + 4 * n + (i & 3); }

struct Unit { int pm, pn; const char* bb; long bjump; int arow0; int acount; int aux; };
struct Gemm { const char* A; int lda; const int* gather; int ldb; int K; int bsplit; };

__device__ __forceinline__ unsigned cvt_pk_bf16(float lo, float hi) { unsigned r; asm volatile("v_cvt_pk_bf16_f32 %0, %1, %2" : "=v"(r) : "v"(lo), "v"(hi)); return r; }

template <class Epi, class Sched, bool ALIGN_EPI>
__device__ __forceinline__ void gemm_phase(LAS unsigned char* lds, const Gemm g, const Sched& S, const Epi& E, const int tid) {
    const int wid = __builtin_amdgcn_readfirstlane(tid >> 6), lane = tid & 63, wr = wid >> 2, wc = wid & 3, fr = lane & 15, fq = lane >> 4;
    const int K = g.K, nt = K / BK;
    unsigned voffB[2];
#pragma unroll
    for (int i = 0; i < 2; ++i) { int R, C; stage_rc(tid * 16 + i * 8192, R, C); const int Rb = Epi::PERM ? ((R & ~31) + perm32(R & 31)) : R; voffB[i] = (unsigned)(Rb * g.ldb + C) * 2u; }
    const size_t kstep = (size_t)(BK * 2);
    const size_t bh = (size_t)HALF * g.ldb * 2;
    const unsigned ldsw = (unsigned)wid * 1024u;
    const int aoff = lds_byte(wr * 64 + fr, fq * 8), boff = lds_byte(wc * 32 + fr, fq * 8);
    const char* const Ab = g.A;
#define PG8_SA(b, h) (((b) * 2 + (h)) * HTB)
#define PG8_SB(b, h) ((4 + (b) * 2 + (h)) * HTB)
#define PG8_STAGE(bufoff, gbase, voff) do { _Pragma("unroll") for (int _i = 0; _i < 2; ++_i) \
        __builtin_amdgcn_global_load_lds((const unsigned*)((const char*)(gbase) + (voff)[_i]), (LAS unsigned*)(lds + (bufoff) + ldsw + _i * 8192), 16, 0, 0); } while (0)
#define PG8_LDA(dst, b, h) do { _Pragma("unroll") for (int m = 0; m < 4; ++m) _Pragma("unroll") for (int k = 0; k < 2; ++k) dst[m][k] = *(const LAS bf16x8*)(lds + PG8_SA(b, h) + aoff + m * 2048 + k * 1024); } while (0)
#define PG8_LDB(dst, b, h) do { _Pragma("unroll") for (int n = 0; n < 2; ++n) _Pragma("unroll") for (int k = 0; k < 2; ++k) dst[n][k] = *(const LAS bf16x8*)(lds + PG8_SB(b, h) + boff + n * 2048 + k * 1024); } while (0)
#define PG8_MMA(ai, bj, At, Bt) do { __builtin_amdgcn_s_setprio(1); _Pragma("unroll") for (int m = 0; m < 4; ++m) _Pragma("unroll") for (int n = 0; n < 2; ++n) _Pragma("unroll") for (int k = 0; k < 2; ++k) \
        acc[ai][bj][m][n] = __builtin_amdgcn_mfma_f32_16x16x32_bf16(Bt[n][k], At[m][k], acc[ai][bj][m][n], 0, 0, 0); __builtin_amdgcn_s_setprio(0); } while (0)
#define PG8_WAIT_V(n) asm volatile("s_waitcnt vmcnt(" #n ")" ::: "memory")
#define PG8_WAIT_L(n) asm volatile("s_waitcnt lgkmcnt(" #n ")" ::: "memory")
#define PG8_BAR __builtin_amdgcn_s_barrier()
#define PG8_SCHED __builtin_amdgcn_sched_barrier(0)
#define PG8_AOFFS(u, o) do { _Pragma("unroll") for (int _h = 0; _h < 2; ++_h) _Pragma("unroll") for (int _i = 0; _i < 2; ++_i) { int _R, _C; stage_rc(tid * 16 + _i * 8192, _R, _C); const int _r = _h * HALF + _R; \
        int _row; if (g.gather) { _row = (_r < (u).acount) ? g.gather[(u).arow0 + _r] : 0; } else { _row = (u).arow0 + _r; } (o)[_h][_i] = (unsigned)(_row * g.lda + _C) * 2u; } } while (0)
#define PG8_BKO(u, tt) ((size_t)(tt) * kstep + (((tt) >= g.bsplit) ? (size_t)(u).bjump : (size_t)0))
    Unit cur, nxt; int ui = 0;
    if (!S.next(0, cur)) return;
    f32x4 acc[2][2][4][2];
#pragma unroll
    for (int a = 0; a < 2; ++a)
#pragma unroll
        for (int b = 0; b < 2; ++b)
#pragma unroll
            for (int m = 0; m < 4; ++m)
#pragma unroll
                for (int n = 0; n < 2; ++n) acc[a][b][m][n] = (f32x4){0.f, 0.f, 0.f, 0.f};
    bf16x8 At[4][2], B0[2][2], B1[2][2];
    unsigned cao[2][2];
    LAS u32x4* const naol = (LAS u32x4*)(lds + STAGE_BYTES + 1024) + tid;
    PG8_AOFFS(cur, cao);
    const char* cB = cur.bb;
    PG8_STAGE(PG8_SB(0, 0), cB, voffB); PG8_STAGE(PG8_SB(0, 1), cB + bh, voffB); PG8_STAGE(PG8_SA(0, 0), Ab, cao[0]); PG8_STAGE(PG8_SA(0, 1), Ab, cao[1]);
    if (wr == 1) PG8_BAR;
    PG8_WAIT_V(2); PG8_BAR;
    PG8_STAGE(PG8_SB(1, 0), cB + kstep, voffB); PG8_STAGE(PG8_SA(1, 0), Ab + kstep, cao[0]); PG8_STAGE(PG8_SB(1, 1), cB + bh + kstep, voffB);
    PG8_WAIT_V(6); PG8_BAR;
    for (;;) {
        const bool has_next = S.next(ui + 1, nxt);
        const char* nB = cB;
        { unsigned nao[2][2];
          if (has_next) { PG8_AOFFS(nxt, nao); nB = nxt.bb; }
          else {
#pragma unroll
            for (int h = 0; h < 2; ++h)
#pragma unroll
                for (int i = 0; i < 2; ++i) nao[h][i] = cao[h][i];
          }
          *naol = (u32x4){nao[0][0], nao[0][1], nao[1][0], nao[1][1]}; }
#pragma unroll 1
        for (int t = 0; t < nt; t += 2) {
            const bool last = (t == nt - 2);
            const char* a1 = Ab + (size_t)(t + 1) * kstep;
            const char* a2 = last ? Ab : Ab + (size_t)(t + 2) * kstep;
            const char* a3 = a2 + kstep;
            const char* b2 = last ? nB : cB + PG8_BKO(cur, t + 2);
            const char* b3 = last ? nB + kstep : cB + PG8_BKO(cur, t + 3);
            unsigned ao2[2][2];
#pragma unroll
            for (int h = 0; h < 2; ++h)
#pragma unroll
                for (int i = 0; i < 2; ++i) ao2[h][i] = cao[h][i];
            if (last) { const u32x4 v = *naol; ao2[0][0] = v.x; ao2[0][1] = v.y; ao2[1][0] = v.z; ao2[1][1] = v.w; }
            PG8_LDB(B0, 0, 0); PG8_LDB(B1, 0, 1); PG8_SCHED; PG8_LDA(At, 0, 0); PG8_STAGE(PG8_SA(1, 1), a1, cao[1]);
            PG8_WAIT_V(8); PG8_WAIT_L(0); PG8_BAR; PG8_MMA(0, 0, At, B0); PG8_MMA(0, 1, At, B1); PG8_BAR; PG8_SCHED;
            PG8_LDA(At, 0, 1); PG8_STAGE(PG8_SB(0, 0), b2, voffB); PG8_STAGE(PG8_SB(0, 1), b2 + bh, voffB); PG8_STAGE(PG8_SA(0, 0), a2, ao2[0]);
            PG8_WAIT_V(8); PG8_WAIT_L(0); PG8_BAR; PG8_MMA(1, 0, At, B0); PG8_MMA(1, 1, At, B1); PG8_BAR; PG8_SCHED;
            PG8_LDB(B0, 1, 0); PG8_LDB(B1, 1, 1); PG8_SCHED; PG8_LDA(At, 1, 0); PG8_STAGE(PG8_SA(0, 1), a2, ao2[1]);
            PG8_WAIT_V(8); PG8_WAIT_L(0); PG8_BAR; PG8_MMA(0, 0, At, B0); PG8_MMA(0, 1, At, B1); PG8_BAR; PG8_SCHED;
            PG8_LDA(At, 1, 1); PG8_STAGE(PG8_SB(1, 0), b3, voffB); PG8_STAGE(PG8_SB(1, 1), b3 + bh, voffB); PG8_STAGE(PG8_SA(1, 0), a3, ao2[0]);
            PG8_WAIT_V(8); PG8_WAIT_L(0); PG8_BAR; PG8_MMA(1, 0, At, B0); PG8_MMA(1, 1, At, B1); PG8_BAR; PG8_SCHED;
        }
        if constexpr (ALIGN_EPI) { if (wr == 0) PG8_BAR; }
        { int t2_ = tid; asm volatile("" : "+v"(t2_)); const int l2_ = t2_ & 63; E(acc, cur, wr, wc, l2_ & 15, l2_ >> 4); }
        if (!has_next) break;
#pragma unroll
        for (int a = 0; a < 2; ++a)
#pragma unroll
            for (int b = 0; b < 2; ++b)
#pragma unroll
                for (int m = 0; m < 4; ++m)
#pragma unroll
                    for (int n = 0; n < 2; ++n) acc[a][b][m][n] = (f32x4){0.f, 0.f, 0.f, 0.f};
        cur = nxt; cB = nB; ++ui;
        { const u32x4 v = *naol; cao[0][0] = v.x; cao[0][1] = v.y; cao[1][0] = v.z; cao[1][1] = v.w; }
        if constexpr (ALIGN_EPI) { if (wr == 1) PG8_BAR; }
    }
    PG8_WAIT_V(0);
    if constexpr (!ALIGN_EPI) { if (wr == 0) PG8_BAR; }
    PG8_BAR;
#undef PG8_SA
#undef PG8_SB
#undef PG8_STAGE
#undef PG8_LDA
#undef PG8_LDB
#undef PG8_MMA
#undef PG8_WAIT_V
#undef PG8_WAIT_L
#undef PG8_BAR
#undef PG8_SCHED
#undef PG8_AOFFS
#undef PG8_BKO
}
}

constexpr int BATCH = 16, SEQ = 2048, T = BATCH * SEQ, D = 1024, NIN = 2304, NL = 2;
constexpr int CC = 256, CP = 256, CA = 512, NH = 4, DH = 64, DV = 128, CW = 31;
constexpr int NE = 16, DE = 256, NBKT = 24;
constexpr float EPS = 1e-6f;
constexpr float QSCALE = 0.125f * 1.4426950408889634f;
constexpr int NWAVES = 8, NTHREADS = 512;

constexpr size_t MiB = 1u << 20, KiB = 1u << 10;
constexpr size_t WS_CTL = 0, CTL_ZERO_BYTES = 1 * MiB;
constexpr size_t WS_SS = 2 * MiB;
constexpr size_t WS_SS1 = 4 * MiB;
constexpr size_t WS_RS1 = 6 * MiB;
constexpr size_t WS_WTS = 6 * MiB + 256 * KiB;
constexpr size_t WS_TOKB = 6 * MiB + 512 * KiB;
constexpr size_t WS_LIST = 7 * MiB;
constexpr size_t WS_WR = 10 * MiB;
constexpr size_t WS_WPW = 10 * MiB + 512 * KiB;
constexpr size_t WS_WPOOL = 10 * MiB + 768 * KiB;
constexpr size_t WS_ERR = 11 * MiB;
constexpr size_t WS_WIN = 16 * MiB;
constexpr size_t WS_WOUT = 25 * MiB;
constexpr size_t WS_WGU = 29 * MiB;
constexpr size_t WS_WD = 61 * MiB;
constexpr size_t WS_XB = 80 * MiB;
constexpr size_t WS_X1B = 144 * MiB;
constexpr size_t WS_MIX = 208 * MiB;
constexpr size_t WS_U = 272 * MiB;
constexpr size_t WS_PIN = 288 * MiB;
constexpr size_t WS_Q = 304 * MiB;
constexpr size_t WS_K = 336 * MiB;
constexpr size_t WS_V = 368 * MiB;
constexpr size_t WS_ACT = 400 * MiB;
constexpr size_t WS_DBG = 440 * MiB;
constexpr size_t WS_END = 512 * MiB;
constexpr int CW_BAR = 4096;
constexpr int CW_CNT = 16384;
constexpr int RING_BYTES = 131072;
constexpr int MISC_OFF = RING_BYTES;
constexpr int LDS_EXTRA = RING_BYTES + 1024;
constexpr int LDS_BYTES = 163840;

#define LDS_WAIT() asm volatile("s_waitcnt lgkmcnt(0)" ::: "memory")
#define VM_WAIT() asm volatile("s_waitcnt vmcnt(0)" ::: "memory")

#define XB_TMO      128
#define XB_XCNT(j)  (256  + 64 * (j))
#define XB_XSUB(j)  (1280 + 64 * (j))
#define XB_XGEN(j)  (2304 + 64 * (j))
#define XB_TOP      3328
#define XB_TOPGEN   3392
#define XCD_BAR_WORDS 3456
#define XB_SPIN_CAP (1u << 22)
__device__ __forceinline__ unsigned xb_ld(unsigned* p)              { return __hip_atomic_load(p, __ATOMIC_RELAXED, __HIP_MEMORY_SCOPE_AGENT); }
__device__ __forceinline__ unsigned xb_add(unsigned* p, unsigned v) { return __hip_atomic_fetch_add(p, v, __ATOMIC_RELAXED, __HIP_MEMORY_SCOPE_AGENT); }
__device__ __forceinline__ unsigned xb_xcc_id() { return (unsigned)__builtin_amdgcn_s_getreg((3 << 11) | 20) & 0xFu; }
#define XB_SPIN(cond, bar) do { unsigned _sp = 0; while (cond) { __builtin_amdgcn_s_sleep(1); \
    if ((++_sp & 255u) == 0u) { if (xb_ld(&(bar)[XB_TMO])) break; if (_sp > XB_SPIN_CAP) { atomicAdd(&(bar)[XB_TMO], 1u); break; } } } } while (0)
struct XcdBarrier { unsigned* bar; unsigned x; volatile LAS unsigned* st; };
__device__ __forceinline__ XcdBarrier xcd_barrier_post(unsigned* bar, volatile LAS unsigned* st) {
    XcdBarrier b; b.bar = bar; b.x = xb_xcc_id(); b.st = st;
    if (threadIdx.x == 0) (void)xb_add(&bar[XB_XCNT(b.x)], 1u);
    return b;
}
__device__ __forceinline__ void xcd_barrier_complete(unsigned* bar, unsigned x, unsigned& nloc, unsigned& nx) {
    const unsigned G = gridDim.x * gridDim.y * gridDim.z;
    unsigned sum, cnt, mine, sp = 0u;
    for (;;) {
        sum = 0u; cnt = 0u; mine = 0u;
#pragma unroll
        for (unsigned j = 0; j < 16; ++j) { const unsigned c = xb_ld(&bar[XB_XCNT(j)]); sum += c; cnt += (c > 0u) ? 1u : 0u; mine = (j == x) ? c : mine; }
        if (sum == G) break;
        __builtin_amdgcn_s_sleep(1);
        if ((++sp & 255u) == 0u) { if (xb_ld(&bar[XB_TMO])) break; if (sp > XB_SPIN_CAP) { atomicAdd(&bar[XB_TMO], 1u); break; } }
    }
    nloc = mine > 0u ? mine : 1u; nx = cnt > 0u ? cnt : 1u;
}
__device__ __forceinline__ void xcd_barrier(const XcdBarrier& b) {
    asm volatile("s_waitcnt vmcnt(0)" ::: "memory");
    __syncthreads();
    if (threadIdx.x == 0) {
        unsigned* bar = b.bar;
        __builtin_amdgcn_s_waitcnt(0);
        unsigned nloc = b.st[0], nx = b.st[1];
        if (nloc == 0u) { xcd_barrier_complete(bar, b.x, nloc, nx); b.st[0] = nloc; b.st[1] = nx; }
        const unsigned old = xb_add(&bar[XB_XSUB(b.x)], 1u);
        const unsigned gen = old / nloc;
        if (old + 1u == (gen + 1u) * nloc) {
            __builtin_amdgcn_fence(__ATOMIC_RELEASE, "agent");
            asm volatile("s_waitcnt vmcnt(0)" ::: "memory");
            const unsigned og = xb_add(&bar[XB_TOP], 1u);
            const unsigned tg = og / nx;
            if (og + 1u == (tg + 1u) * nx) xb_add(&bar[XB_TOPGEN], 1u);
            else XB_SPIN(xb_ld(&bar[XB_TOPGEN]) == tg, bar);
            __builtin_amdgcn_fence(__ATOMIC_ACQUIRE, "agent");
            xb_add(&bar[XB_XGEN(b.x)], 1u);
            asm volatile("s_waitcnt vmcnt(0)" ::: "memory");
        } else {
            XB_SPIN(xb_ld(&bar[XB_XGEN(b.x)]) == gen, bar);
            __builtin_amdgcn_fence(__ATOMIC_ACQUIRE, "agent");
            asm volatile("s_waitcnt vmcnt(0)" ::: "memory");
        }
    }
    __syncthreads();
}

struct Args { const float* in[27]; float* out; unsigned char* ws; int ph_lo, ph_hi; };
enum { I_X = 0, I_ANG, I_WIN, I_CW, I_CB, I_CLG, I_CLB, I_CPW, I_CPB, I_PW, I_PS, I_QG, I_KG, I_LQ1, I_LK1, I_LQ2, I_LK2, I_ASG, I_WOUT, I_FNG, I_RGW, I_RGB, I_REW, I_REB, I_WG, I_WU, I_WDN };

struct Frame {
    LAS unsigned char* lds;
    int tid, lane, wave, vcu, G;
};

__device__ __forceinline__ void tr_item(const float* S, int ldS, int scol, int k0, const float* gk, bf16_t* Dst, int ldD, int prow) {
    const float* sp = S + (size_t)k0 * ldS + scol;
    unsigned w[32];
#pragma unroll
    for (int i = 0; i < 32; ++i) { float a = sp[(size_t)(2 * i) * ldS], b = sp[(size_t)(2 * i + 1) * ldS]; if (gk) { a *= gk[k0 + 2 * i]; b *= gk[k0 + 2 * i + 1]; } w[i] = pk2(a, b); }
    u32x4* dp = (u32x4*)(Dst + (size_t)prow * ldD + k0);
#pragma unroll
    for (int j = 0; j < 8; ++j) dp[j] = (u32x4){w[4 * j], w[4 * j + 1], w[4 * j + 2], w[4 * j + 3]};
}
__device__ __forceinline__ int win_logical(int p0) {
    const int pn = p0 >> 8, c = p0 & 255;
    if (pn < 2) return (c < 128) ? (pn * 128 + c) : (256 + pn * 128 + (c - 128));
    if (pn == 2) return 512 + c;
    if (pn < 7) { const int bj = c >> 7, wc = (c >> 5) & 3; return 768 + (pn - 3) * 256 + 64 * wc + 32 * bj; }
    return 1792 + (pn - 7) * 256 + c;
}
__device__ __forceinline__ void p0_prologue(const Args& args, Frame& F) {
    unsigned char* ws = args.ws;
    const int gw = F.vcu * NWAVES + F.wave, NGW = F.G * NWAVES, lane = F.lane;
    constexpr int I_IN = 16 * 36, I_OUT = 16 * 16, I_GU = 16 * 8 * 16, I_DN = 4 * 16 * 16, I_PWI = 4 * 4, I_PL = 4;
    constexpr int PER_L = I_IN + I_OUT + I_GU + I_DN + I_PWI + I_PL;
    for (int it = gw; it < NL * PER_L; it += NGW) {
        const int l = it / PER_L; int r = it % PER_L;
        if (r < I_IN) { const int kb = r / 36, pb = r % 36; const int p = pb * 64 + lane;
            tr_item(args.in[I_WIN] + (size_t)l * D * NIN, NIN, win_logical(p & ~31) + (p & 31), kb * 64, args.in[I_ANG] + l * D, (bf16_t*)(ws + WS_WIN) + (size_t)l * NIN * D, D, p); continue; }
        r -= I_IN;
        if (r < I_OUT) { const int kb = r / 16, pb = r % 16; const int p = pb * 64 + lane;
            tr_item(args.in[I_WOUT] + (size_t)l * D * D, D, p, kb * 64, nullptr, (bf16_t*)(ws + WS_WOUT) + (size_t)l * D * D, D, p); continue; }
        r -= I_OUT;
        if (r < I_GU) { const int e = r / 128, q = r % 128, kb = q / 8, pb = q % 8; const int p = pb * 64 + lane;
            const int half = p >> 8, gu = (p >> 7) & 1, i0 = p & 127; const float* src = (gu ? args.in[I_WU] : args.in[I_WG]) + (size_t)(l * NE + e) * D * DE;
            tr_item(src, DE, half * 128 + i0, kb * 64, args.in[I_FNG] + l * D, (bf16_t*)(ws + WS_WGU) + (size_t)(l * NE + e) * 512 * D, D, p); continue; }
        r -= I_GU;
        if (r < I_DN) { const int e = r / 64, q = r % 64, kb = q / 16, pb = q % 16; const int p = pb * 64 + lane;
            tr_item(args.in[I_WDN] + (size_t)(l * NE + e) * DE * D, D, p, kb * 64, nullptr, (bf16_t*)(ws + WS_WD) + (size_t)(l * NE + e) * D * DE, DE, p); continue; }
        r -= I_DN;
        if (r < I_PWI) { const int kb = r / 4, pb = r % 4; const int p = pb * 64 + lane;
            tr_item(args.in[I_CPW] + (size_t)l * CC * CC, CC, p, kb * 64, nullptr, (bf16_t*)(ws + WS_WPW) + (size_t)l * CC * CC, CC, p); continue; }
        r -= I_PWI;
        { const int gi = r;
            tr_item(args.in[I_PW] + (size_t)(l * 4 + gi) * 64 * 64, 64, lane, 0, nullptr, (bf16_t*)(ws + WS_WPOOL) + (size_t)(l * 4 + gi) * 64 * 64, 64, lane); }
    }
    for (int i = (F.vcu * NTHREADS + F.tid); i < NL * 32 * D; i += F.G * NTHREADS) {
        const int l = i / (32 * D), j = (i / D) % 32, k = i % D;
        float w = 0.f; if (j < 4) w = args.in[I_RGW][(size_t)(l * D + k) * 4 + j]; else if (j < 20) w = args.in[I_REW][(size_t)(l * D + k) * 16 + (j - 4)];
        w *= args.in[I_FNG][l * D + k];
        const unsigned h = f2bf(w); const unsigned lo = f2bf(w - bf2f(h));
        bf16_t* base = (bf16_t*)(ws + WS_WR) + (size_t)l * 2 * 32 * D;
        base[(size_t)j * D + k] = (bf16_t)h; base[(size_t)(32 + j) * D + k] = (bf16_t)lo;
    }
    for (int m = gw; m < T; m += NGW) {
        const GAS f32x4* xr = (const GAS f32x4*)(args.in[I_X] + (size_t)m * D) + lane;
        GAS unsigned long long* o8 = (GAS unsigned long long*)((bf16_t*)(ws + WS_XB) + (size_t)m * D) + lane;
        float s = 0.f;
#pragma unroll
        for (int j = 0; j < 4; ++j) { const f32x4 v = xr[64 * j]; s += (v.x * v.x + v.y * v.y) + (v.z * v.z + v.w * v.w);
            o8[64 * j] = (unsigned long long)pk2(v.x, v.y) | ((unsigned long long)pk2(v.z, v.w) << 32); }
        s = wave_sum(s);
        if (lane < 16) ((float*)(ws + WS_SS))[(size_t)m * 16 + lane] = (lane == 0) ? s : 0.f;
    }
}

struct DenseOrder {
    int nM, nN, nwg, G, c; const char* Bt; size_t btile;
    __device__ void init(int M, int N, int G_, int c_, const void* Bt_, int ldb) { nM = M / 256; nN = N / 256; nwg = nM * nN; G = G_; c = c_; Bt = (const char*)Bt_; btile = (size_t)256 * ldb * 2; }
    __device__ __forceinline__ bool next(int i, pg8::Unit& u) const {
        const long L = (long)i * G + c; if (L >= nwg) return false;
        int wgid = (int)L; { const int q = nwg / 8, r = nwg % 8, xcd = wgid % 8, off = wgid / 8; wgid = (xcd < r ? xcd * (q + 1) : r * (q + 1) + (xcd - r) * q) + off; }
        const int nig = 8 * nN, gid = wgid / nig, fm = gid * 8, gsz = (nM - fm) < 8 ? (nM - fm) : 8;
        u.pm = fm + ((wgid % nig) % gsz); u.pn = (wgid % nig) / gsz;
        u.bb = Bt + (size_t)u.pn * btile; u.bjump = 0; u.arow0 = u.pm * 256; u.acount = 256; u.aux = 0; return true;
    }
};
struct MoeOrder {
    const LAS int* ti; int G, c, l, mode; const char* W;
    __device__ __forceinline__ bool next(int i, pg8::Unit& u) const {
        const int NT = __builtin_amdgcn_readfirstlane(ti[0]); const int nwg = NT * 4;
        const long L = (long)i * G + c; if (L >= nwg) return false;
        int wgid = (int)L; { const int q = nwg / 8, r = nwg % 8, xcd = wgid % 8, off = wgid / 8; wgid = (xcd < r ? xcd * (q + 1) : r * (q + 1) + (xcd - r) * q) + off; }
        const int rt = wgid >> 2, pn = wgid & 3;
        const int inf = __builtin_amdgcn_readfirstlane(ti[2 + 2 * rt]); const int b = inf & 255, lt = inf >> 8;
        const int grp = b / 6, pi = b % 6;
        const int lo = (pi < 3) ? 0 : (pi < 5 ? 1 : 2), hi = (pi < 3) ? pi + 1 : (pi < 5 ? pi - 1 : 3);
        const int e0 = grp * 4 + lo, e1 = grp * 4 + hi;
        u.pm = rt; u.pn = pn; u.acount = __builtin_amdgcn_readfirstlane(ti[3 + 2 * rt]);
        if (mode == 1) { const int e = (pn < 2) ? e0 : e1; u.bb = W + ((size_t)(l * NE + e) * 512 + (size_t)(pn & 1) * 256) * D * 2; u.bjump = 0; u.arow0 = b * T + lt * 256; u.aux = b; }
        else { u.bb = W + ((size_t)(l * NE + e0) * D + (size_t)pn * 256) * DE * 2; u.bjump = (long)(e1 - e0) * D * DE * 2 - 4 * 128; u.arow0 = rt * 256; u.aux = b * T + lt * 256; }
        return true;
    }
};

__device__ __forceinline__ float sigmoidf_(float x) { return __frcp_rn(1.f + __expf(-x)); }
__device__ __forceinline__ float row_rstd16(const float* p) {
    const f32x4 a = ((const f32x4*)p)[0], b = ((const f32x4*)p)[1], c = ((const f32x4*)p)[2], d = ((const f32x4*)p)[3];
    const float s = ((a.x + a.y) + (a.z + a.w)) + ((b.x + b.y) + (b.z + b.w)) + ((c.x + c.y) + (c.z + c.w)) + ((d.x + d.y) + (d.z + d.w));
    return rsqrtf(s * (1.f / D) + EPS);
}
__device__ __forceinline__ u32x4 pack8(const f32x4 a, const f32x4 b) { u32x4 w; w.x = pg8::cvt_pk_bf16(a[0], a[1]); w.y = pg8::cvt_pk_bf16(a[2], a[3]); w.z = pg8::cvt_pk_bf16(b[0], b[1]); w.w = pg8::cvt_pk_bf16(b[2], b[3]); return w; }

struct EpiInProj {
    static constexpr bool PERM = true;
    const float* SS; bf16_t *U, *PIN, *Q, *Kb, *V; const float *qg, *kg;
    __device__ __forceinline__ void operator()(const f32x4 (&acc)[2][2][4][2], const pg8::Unit& u, int wr, int wc, int fr, int fq) const {
        const int row0 = u.pm * 256 + wr * 64 + fr, pn = u.pn;
        if (pn < 2) {
#pragma unroll
            for (int ai = 0; ai < 2; ++ai)
#pragma unroll
                for (int m = 0; m < 4; ++m) { const int row = row0 + ai * 128 + m * 16; const float rs = row_rstd16(SS + (size_t)row * 16);
                    f32x4 o[2];
#pragma unroll
                    for (int n = 0; n < 2; ++n) { const f32x4 v = acc[ai][0][m][n] * rs, g = acc[ai][1][m][n] * rs;
                        o[n] = (f32x4){v[0] * sigmoidf_(g[0]), v[1] * sigmoidf_(g[1]), v[2] * sigmoidf_(g[2]), v[3] * sigmoidf_(g[3])}; }
                    *(u32x4*)(U + (size_t)row * CC + pn * 128 + wc * 32 + 8 * fq) = pack8(o[0], o[1]); }
        } else if (pn == 2 || pn >= 7) {
            bf16_t* dst = (pn == 2) ? PIN : V; const int ld = (pn == 2) ? CP : CA; const int cb = (pn == 2) ? 0 : (pn - 7) * 256;
#pragma unroll
            for (int ai = 0; ai < 2; ++ai)
#pragma unroll
                for (int m = 0; m < 4; ++m) { const int row = row0 + ai * 128 + m * 16; const float rs = row_rstd16(SS + (size_t)row * 16);
#pragma unroll
                    for (int bj = 0; bj < 2; ++bj) *(u32x4*)(dst + (size_t)row * ld + cb + bj * 128 + wc * 32 + 8 * fq) = pack8(acc[ai][bj][m][0] * rs, acc[ai][bj][m][1] * rs); }
        } else {
            const bool isq = pn < 5; bf16_t* dst = isq ? Q : Kb; const float* gn = isq ? qg : kg; const int hs = (isq ? (pn - 3) : (pn - 5)) * 4 + wc;
            f32x4 gv[2][2];
#pragma unroll
            for (int bj = 0; bj < 2; ++bj)
#pragma unroll
                for (int n = 0; n < 2; ++n) gv[bj][n] = *(const f32x4*)(gn + 32 * bj + 8 * fq + 4 * n);
#pragma unroll
            for (int ai = 0; ai < 2; ++ai)
#pragma unroll
                for (int m = 0; m < 4; ++m) { const int row = row0 + ai * 128 + m * 16; const float rs = row_rstd16(SS + (size_t)row * 16);
                    f32x4 z[2][2]; float ss = 0.f;
#pragma unroll
                    for (int bj = 0; bj < 2; ++bj)
#pragma unroll
                        for (int n = 0; n < 2; ++n) { z[bj][n] = acc[ai][bj][m][n] * rs; const f32x4 q = z[bj][n] * z[bj][n]; ss += (q[0] + q[1]) + (q[2] + q[3]); }
                    ss += __shfl_xor(ss, 16); ss += __shfl_xor(ss, 32);
                    const float r = rsqrtf(ss * (1.f / DH) + EPS) * (isq ? QSCALE : 1.f);
#pragma unroll
                    for (int bj = 0; bj < 2; ++bj) *(u32x4*)(dst + (size_t)row * CA + hs * 64 + 32 * bj + 8 * fq) = pack8(z[bj][0] * r * gv[bj][0], z[bj][1] * r * gv[bj][1]); }
        }
    }
};

struct EpiOutProj {
    static constexpr bool PERM = false;
    const float* xin; float* out; bf16_t* X1B; float* SS1;
    __device__ __forceinline__ void operator()(const f32x4 (&acc)[2][2][4][2], const pg8::Unit& u, int wr, int wc, int fr, int fq) const {
        const int row0 = u.pm * 256 + wr * 64 + fr, col0 = u.pn * 256 + wc * 32 + 4 * fq;
#pragma unroll
        for (int ai = 0; ai < 2; ++ai)
#pragma unroll
            for (int m = 0; m < 4; ++m) { const int row = row0 + ai * 128 + m * 16; float ss = 0.f;
#pragma unroll
                for (int bj = 0; bj < 2; ++bj)
#pragma unroll
                    for (int n = 0; n < 2; ++n) { const size_t off = (size_t)row * D + col0 + bj * 128 + n * 16; const f32x4 x = *(const f32x4*)(xin + off) + acc[ai][bj][m][n];
                        *(f32x4*)(out + off) = x; const f32x4 q = x * x; ss += (q[0] + q[1]) + (q[2] + q[3]);
                        u32x2 w; w.x = pg8::cvt_pk_bf16(x[0], x[1]); w.y = pg8::cvt_pk_bf16(x[2], x[3]); *(u32x2*)(X1B + off) = w; }
                ss += __shfl_xor(ss, 16); ss += __shfl_xor(ss, 32);
                if (fq == 0) SS1[(size_t)row * 16 + u.pn * 4 + wc] = ss; }
    }
};

struct EpiMoe1 {
    static constexpr bool PERM = true;
    const int* LIST; const float* RS1; const float* WTS; bf16_t* ACT;
    __device__ __forceinline__ void operator()(const f32x4 (&acc)[2][2][4][2], const pg8::Unit& u, int wr, int wc, int fr, int fq) const {
        const int pn = u.pn;
#pragma unroll
        for (int ai = 0; ai < 2; ++ai)
#pragma unroll
            for (int m = 0; m < 4; ++m) { const int r = ai * 128 + wr * 64 + m * 16 + fr; const int tok = (r < u.acount) ? LIST[u.arow0 + r] : 0;
                const float rs = RS1[tok], w = WTS[tok * 2 + (pn >> 1)];
                f32x4 o[2];
#pragma unroll
                for (int n = 0; n < 2; ++n) { const f32x4 g = acc[ai][0][m][n] * rs, uu = acc[ai][1][m][n] * (rs * w);
                    o[n] = (f32x4){g[0] * sigmoidf_(g[0]) * uu[0], g[1] * sigmoidf_(g[1]) * uu[1], g[2] * sigmoidf_(g[2]) * uu[2], g[3] * sigmoidf_(g[3]) * uu[3]}; }
                *(u32x4*)(ACT + (size_t)(u.pm * 256 + r) * 512 + (pn >> 1) * 256 + (pn & 1) * 128 + wc * 32 + 8 * fq) = pack8(o[0], o[1]); }
    }
};

struct EpiMoe2 {
    static constexpr bool PERM = false;
    const int* LIST; float* out; bf16_t* XB; float* SS; int last;
    __device__ __forceinline__ void operator()(const f32x4 (&acc)[2][2][4][2], const pg8::Unit& u, int wr, int wc, int fr, int fq) const {
        const int col0 = u.pn * 256 + wc * 32 + 4 * fq;
#pragma unroll
        for (int ai = 0; ai < 2; ++ai)
#pragma unroll
            for (int m = 0; m < 4; ++m) { const int r = ai * 128 + wr * 64 + m * 16 + fr; const bool valid = r < u.acount; float ss = 0.f; int tok = 0;
                if (valid) { tok = LIST[u.aux + r];
#pragma unroll
                    for (int bj = 0; bj < 2; ++bj)
#pragma unroll
                        for (int n = 0; n < 2; ++n) { const size_t off = (size_t)tok * D + col0 + bj * 128 + n * 16; const f32x4 x = *(const f32x4*)(out + off) + acc[ai][bj][m][n];
                            *(f32x4*)(out + off) = x; const f32x4 q = x * x; ss += (q[0] + q[1]) + (q[2] + q[3]);
                            if (!last) { u32x2 w; w.x = pg8::cvt_pk_bf16(x[0], x[1]); w.y = pg8::cvt_pk_bf16(x[2], x[3]); *(u32x2*)(XB + off) = w; } } }
                ss += __shfl_xor(ss, 16); ss += __shfl_xor(ss, 32);
                if (valid && fq == 0 && !last) SS[(size_t)tok * 16 + u.pn * 4 + wc] = ss;
                asm volatile("" ::: "memory"); }
    }
};

__device__ __forceinline__ int crow(int r, int hi) { return (r & 3) + 8 * (r >> 2) + 4 * hi; }
typedef short v4i16_t __attribute__((ext_vector_type(4)));
__device__ __forceinline__ s16x4 vtr(const LAS unsigned char* p) { return __builtin_bit_cast(s16x4, __builtin_amdgcn_ds_read_tr16_b64_v4i16((LAS v4i16_t*)p)); }
constexpr int AT_K = 0, AT_V = 32768;

__device__ __forceinline__ void attn_unit(const Args& args, Frame& F, int l, int b, int h, int qb, float lam, float lam_init) {
    int tid = F.tid; asm volatile("" : "+v"(tid)); const int lane = tid & 63, wave = F.wave, r32 = lane & 31, hi = lane >> 5;
    const int mp = wave >> 2, rg = wave & 3;
    LAS unsigned char* lds = F.lds;
    const bf16_t* Qg = (const bf16_t*)(args.ws + WS_Q); const bf16_t* Kg = (const bf16_t*)(args.ws + WS_K); const bf16_t* Vg = (const bf16_t*)(args.ws + WS_V);
    bf16_t* MIX = (bf16_t*)(args.ws + WS_MIX);
    const int q0 = qb * 128, nt = 2 * qb + 2;
    const int qpos = q0 + 32 * rg + r32;
    const size_t rowb = (size_t)b * SEQ;
    const float slope = (h == 0) ? 0.25f : (h == 1) ? 0.0625f : (h == 2) ? 0.015625f : 0.00390625f;
    const float sl2 = slope * 1.4426950408889634f;
    int srow[2], sch[2]; unsigned kdst[2], vdst[2];
#pragma unroll
    for (int i = 0; i < 2; ++i) { const int c = tid + 512 * i; srow[i] = c >> 4; sch[i] = c & 15; const int row = srow[i], ch = sch[i];
        kdst[i] = (unsigned)(AT_K + (ch >> 3) * 8192 + row * 128 + (((ch & 7) ^ ((row >> 1) & 7)) << 4));
        vdst[i] = (unsigned)(AT_V + 256 * row + 16 * (ch ^ (((row & 3) << 2) | ((row >> 2) & 3)))); }
    u32x4 kst[2], vst[2];
#define AT_LOAD(j) do { _Pragma("unroll") for (int i = 0; i < 2; ++i) { const size_t g_ = ((rowb + (size_t)(j) * 64 + srow[i]) * CA + h * 128) * 2 + sch[i] * 16; \
        kst[i] = *(const u32x4*)((const char*)Kg + g_); vst[i] = *(const u32x4*)((const char*)Vg + g_); } } while (0)
#define AT_STORE(buf) do { _Pragma("unroll") for (int i = 0; i < 2; ++i) { *(LAS u32x4*)(lds + (buf) * 16384 + kdst[i]) = kst[i]; *(LAS u32x4*)(lds + (buf) * 16384 + vdst[i]) = vst[i]; } } while (0)
    AT_LOAD(0);
    bf16x8 qr[4];
    { const bf16_t* qp = Qg + (rowb + qpos) * CA + h * 128 + mp * 64 + 8 * hi;
#pragma unroll
      for (int ks = 0; ks < 4; ++ks) qr[ks] = *(const bf16x8*)(qp + 16 * ks); }
    f32x16 o[4];
#pragma unroll
    for (int d = 0; d < 4; ++d) o[d] = f32x16{};
    float m_run = -INFINITY, l_run = 0.f;
    unsigned vaddr[4][2];
#pragma unroll
    for (int db = 0; db < 4; ++db)
#pragma unroll
        for (int sub = 0; sub < 2; ++sub) { const int rb = 4 * hi + 8 * sub + ((lane & 15) >> 2); const int ch = 4 * db + 2 * ((lane >> 4) & 1) + ((lane >> 1) & 1); const int x = ((rb & 3) << 2) | ((rb >> 2) & 3);
            vaddr[db][sub] = (unsigned)(AT_V + 256 * rb + 16 * (ch ^ x) + 8 * (lane & 1)); }
    AT_STORE(0);
    __syncthreads();
    for (int j = 0; j < nt; ++j) {
        const int buf = j & 1;
        if (j + 1 < nt) AT_LOAD(j + 1);
        if (64 * j <= q0 + 32 * rg + 31) {
            const LAS unsigned char* KB = lds + buf * 16384 + AT_K + mp * 8192;
            f32x16 p0, p1;
            { const float base = sl2 * (float)(64 * j - qpos + 4 * hi);
#pragma unroll
              for (int r = 0; r < 16; ++r) { p0[r] = __builtin_fmaf(sl2, (float)((r & 3) + 8 * (r >> 2)), base); p1[r] = p0[r] + 32.f * sl2; } }
#pragma unroll
            for (int ks = 0; ks < 4; ++ks) { const int cc = 2 * ks + hi;
                const bf16x8 k0 = *(const LAS bf16x8*)(KB + r32 * 128 + ((cc ^ ((r32 >> 1) & 7)) << 4));
                const bf16x8 k1 = *(const LAS bf16x8*)(KB + (r32 + 32) * 128 + ((cc ^ (((r32 + 32) >> 1) & 7)) << 4));
                p0 = __builtin_amdgcn_mfma_f32_32x32x16_bf16(k0, qr[ks], p0, 0, 0, 0);
                p1 = __builtin_amdgcn_mfma_f32_32x32x16_bf16(k1, qr[ks], p1, 0, 0, 0); }
            if (64 * j + 63 > q0 + 32 * rg) {
#pragma unroll
                for (int r = 0; r < 16; ++r) { const int kv = 64 * j + crow(r, hi); if (kv > qpos) p0[r] = -INFINITY; if (kv + 32 > qpos) p1[r] = -INFINITY; }
            }
            float mx = fmaxf(p0[0], p1[0]);
#pragma unroll
            for (int r = 1; r < 16; ++r) mx = fmaxf(mx, fmaxf(p0[r], p1[r]));
            mx = fmaxf(mx, __shfl_xor(mx, 32));
            const float m_new = fmaxf(m_run, mx);
            const float alpha = __builtin_amdgcn_exp2f(m_run - m_new);
            m_run = m_new;
            float rsum = 0.f;
#pragma unroll
            for (int r = 0; r < 16; ++r) { p0[r] = __builtin_amdgcn_exp2f(p0[r] - m_new); p1[r] = __builtin_amdgcn_exp2f(p1[r] - m_new); rsum += p0[r] + p1[r]; }
            l_run = l_run * alpha + rsum;
#pragma unroll
            for (int d = 0; d < 4; ++d)
#pragma unroll
                for (int r = 0; r < 16; ++r) o[d][r] *= alpha;
            bf16x8 pb[4];
            { u32x4 w;
              w.x = pg8::cvt_pk_bf16(p0[0], p0[1]); w.y = pg8::cvt_pk_bf16(p0[2], p0[3]); w.z = pg8::cvt_pk_bf16(p0[4], p0[5]); w.w = pg8::cvt_pk_bf16(p0[6], p0[7]); pb[0] = __builtin_bit_cast(bf16x8, w);
              w.x = pg8::cvt_pk_bf16(p0[8], p0[9]); w.y = pg8::cvt_pk_bf16(p0[10], p0[11]); w.z = pg8::cvt_pk_bf16(p0[12], p0[13]); w.w = pg8::cvt_pk_bf16(p0[14], p0[15]); pb[1] = __builtin_bit_cast(bf16x8, w);
              w.x = pg8::cvt_pk_bf16(p1[0], p1[1]); w.y = pg8::cvt_pk_bf16(p1[2], p1[3]); w.z = pg8::cvt_pk_bf16(p1[4], p1[5]); w.w = pg8::cvt_pk_bf16(p1[6], p1[7]); pb[2] = __builtin_bit_cast(bf16x8, w);
              w.x = pg8::cvt_pk_bf16(p1[8], p1[9]); w.y = pg8::cvt_pk_bf16(p1[10], p1[11]); w.z = pg8::cvt_pk_bf16(p1[12], p1[13]); w.w = pg8::cvt_pk_bf16(p1[14], p1[15]); pb[3] = __builtin_bit_cast(bf16x8, w); }
            const LAS unsigned char* VB = lds + buf * 16384;
#pragma unroll
            for (int db = 0; db < 4; ++db)
#pragma unroll
                for (int ks = 0; ks < 4; ++ks) { const s16x4 lo = vtr(VB + vaddr[db][0] + ks * 4096), h4 = vtr(VB + vaddr[db][1] + ks * 4096);
                    const bf16x8 vf = (bf16x8){lo[0], lo[1], lo[2], lo[3], h4[0], h4[1], h4[2], h4[3]};
                    o[db] = __builtin_amdgcn_mfma_f32_32x32x16_bf16(vf, pb[ks], o[db], 0, 0, 0); }
        }
        if (j + 1 < nt) AT_STORE(buf ^ 1);
        __syncthreads();
    }
#undef AT_LOAD
#undef AT_STORE
    l_run += __shfl_xor(l_run, 32);
    const float inv = 1.f / l_run;
    LAS float* X = (LAS float*)lds + rg * 4096;
    if (mp == 1) { const float f = lam * inv;
#pragma unroll
        for (int db = 0; db < 4; ++db)
#pragma unroll
            for (int r = 0; r < 16; ++r) X[(32 * db + crow(r, hi)) * 32 + r32] = o[db][r] * f; }
    __syncthreads();
    if (mp == 0) { float ss = 0.f;
#pragma unroll
        for (int db = 0; db < 4; ++db)
#pragma unroll
            for (int r = 0; r < 16; ++r) { const float v = o[db][r] * inv - X[(32 * db + crow(r, hi)) * 32 + r32]; o[db][r] = v; ss += v * v; }
        ss += __shfl_xor(ss, 32);
        const float rn = rsqrtf(ss * (1.f / DV) + EPS) * (1.f - lam_init);
        const float* gs = args.in[I_ASG] + l * DV;
        bf16_t* orow = MIX + (rowb + qpos) * D + 512 + h * 128;
#pragma unroll
        for (int db = 0; db < 4; ++db)
#pragma unroll
            for (int rr = 0; rr < 4; ++rr) { const int d0 = 32 * db + 8 * rr + 4 * hi; const f32x4 g = *(const f32x4*)(gs + d0);
                u32x2 w; w.x = pg8::cvt_pk_bf16(o[db][4 * rr] * rn * g[0], o[db][4 * rr + 1] * rn * g[1]); w.y = pg8::cvt_pk_bf16(o[db][4 * rr + 2] * rn * g[2], o[db][4 * rr + 3] * rn * g[3]);
                *(u32x2*)(orow + d0) = w; } }
    __syncthreads();
}

constexpr int LM_UH = 0, LM_Y = 49152, LM_A = 0, LM_PH = 49152, LM_D = 0;
__device__ __forceinline__ void local_unit(const Args& args, Frame& F, int l, int tile) {
    int tid = F.tid; asm volatile("" : "+v"(tid)); int lane = tid & 63; const int wave = F.wave;
#define LM_RELAUNDER() do { asm volatile("" : "+v"(tid)); lane = tid & 63; } while (0)
    LAS unsigned char* lds = F.lds;
    const int b = tile / 32, t0 = (tile % 32) * 64; const size_t row0 = (size_t)b * SEQ + t0;
    const bf16_t* U = (const bf16_t*)(args.ws + WS_U); const bf16_t* PIN = (const bf16_t*)(args.ws + WS_PIN); bf16_t* MIX = (bf16_t*)(args.ws + WS_MIX);
    for (int c = tid; c < 94 * 32; c += NTHREADS) { const int i = c >> 5, ch = c & 31; const int t = t0 - 30 + i;
        u32x4 v = (u32x4){0u, 0u, 0u, 0u}; if (t >= 0) v = *(const u32x4*)(U + ((size_t)b * SEQ + t) * CC + ch * 8);
        *(LAS u32x4*)(lds + LM_UH + i * 512 + ch * 16) = v; }
    LM_RELAUNDER();
    int c2 = tid & 127, tg = tid >> 7;
    float w0[CW], w1[CW];
#pragma unroll
    for (int j = 0; j < CW; ++j) { const f32x2 w = *(const f32x2*)(args.in[I_CW] + (size_t)(l * CW + j) * CC + 2 * c2); w0[j] = w.x; w1[j] = w.y; }
    float y0[16], y1[16];
    { const f32x2 bb = *(const f32x2*)(args.in[I_CB] + l * CC + 2 * c2);
#pragma unroll
      for (int k = 0; k < 16; ++k) { y0[k] = bb.x; y1[k] = bb.y; } }
    __syncthreads();
#pragma unroll
    for (int ii = 0; ii < 46; ++ii) { const unsigned uu = *(const LAS unsigned*)(lds + LM_UH + (16 * tg + ii) * 512 + c2 * 4); const float u0 = bf2f(uu & 0xffffu), u1 = bf2f(uu >> 16);
#pragma unroll
        for (int k = 0; k < 16; ++k) if (ii - k >= 0 && ii - k <= 30) { y0[k] += w0[ii - k] * u0; y1[k] += w1[ii - k] * u1; } }
#pragma unroll
    for (int k = 0; k < 16; ++k) *(LAS f32x2*)(lds + LM_Y + ((16 * tg + k) * 256 + 2 * c2) * 4) = (f32x2){y0[k], y1[k]};
    __syncthreads();
    LM_RELAUNDER();
    { const f32x4 lg = *(const f32x4*)(args.in[I_CLG] + l * CC + 4 * lane), lb = *(const f32x4*)(args.in[I_CLB] + l * CC + 4 * lane);
#pragma unroll 2
      for (int i = 0; i < 8; ++i) { const int row = wave * 8 + i; const f32x4 x = *(const LAS f32x4*)(lds + LM_Y + (row * 256 + 4 * lane) * 4);
        const float mean = wave_sum((x[0] + x[1]) + (x[2] + x[3])) * (1.f / CC); const f32x4 dx = x - mean;
        const float var = wave_sum((dx[0] * dx[0] + dx[1] * dx[1]) + (dx[2] * dx[2] + dx[3] * dx[3])) * (1.f / CC); const float rstd = rsqrtf(var + EPS);
        f32x4 yv = dx * rstd * lg + lb; yv = (f32x4){yv[0] * sigmoidf_(yv[0]), yv[1] * sigmoidf_(yv[1]), yv[2] * sigmoidf_(yv[2]), yv[3] * sigmoidf_(yv[3])};
        u32x2 w; w.x = pg8::cvt_pk_bf16(yv[0], yv[1]); w.y = pg8::cvt_pk_bf16(yv[2], yv[3]);
        *(LAS u32x2*)(lds + LM_A + row * 512 + (((lane >> 1) ^ (row & 15)) << 4) + 8 * (lane & 1)) = w; } }
    __syncthreads();
    LM_RELAUNDER();
    { const int mf = wave & 3, nh = wave >> 2, fr = lane & 15, fq = lane >> 4; const int arow = 16 * mf + fr;
      bf16x8 af[8];
#pragma unroll
      for (int ks = 0; ks < 8; ++ks) af[ks] = *(const LAS bf16x8*)(lds + LM_A + arow * 512 + (((4 * ks + fq) ^ (arow & 15)) << 4));
      const bf16_t* Wp = (const bf16_t*)(args.ws + WS_WPW) + (size_t)l * CC * CC;
      const float* bp = args.in[I_CPB] + l * CC;
#pragma unroll 2
      for (int nf = 0; nf < 8; ++nf) { f32x4 acc = (f32x4){0.f, 0.f, 0.f, 0.f}; const bf16_t* wr_ = Wp + (size_t)(128 * nh + 16 * nf + fr) * CC + 8 * fq;
#pragma unroll
        for (int ks = 0; ks < 8; ++ks) { const bf16x8 bfr = *(const bf16x8*)(wr_ + 32 * ks); acc = __builtin_amdgcn_mfma_f32_16x16x32_bf16(bfr, af[ks], acc, 0, 0, 0); }
        const int n0 = 128 * nh + 16 * nf + 4 * fq; const f32x4 bv = *(const f32x4*)(bp + n0); acc = acc + bv;
        u32x2 w; w.x = pg8::cvt_pk_bf16(acc[0], acc[1]); w.y = pg8::cvt_pk_bf16(acc[2], acc[3]);
        *(u32x2*)(MIX + (row0 + arow) * D + n0) = w; } }
    LM_RELAUNDER();
    for (int c = tid; c < 79 * 32; c += NTHREADS) { const int i = c >> 5, ch = c & 31; const int t = t0 - 15 + i;
        u32x4 v = (u32x4){0u, 0u, 0u, 0u}; if (t >= 0) v = *(const u32x4*)(PIN + ((size_t)b * SEQ + t) * CP + ch * 8);
        *(LAS u32x4*)(lds + LM_PH + i * 512 + ch * 16) = v; }
    __syncthreads();
    LM_RELAUNDER(); c2 = tid & 127; tg = tid >> 7;
    { const int gi = c2 >> 5, win = 2 << gi; const int r0 = 15 + 16 * tg;
      float s0 = 0.f, s1 = 0.f;
      for (int i = r0 - win + 1; i < r0; ++i) { const unsigned uu = *(const LAS unsigned*)(lds + LM_PH + i * 512 + c2 * 4); s0 += bf2f(uu & 0xffffu); s1 += bf2f(uu >> 16); }
#pragma unroll
      for (int k = 0; k < 16; ++k) { const unsigned uu = *(const LAS unsigned*)(lds + LM_PH + (r0 + k) * 512 + c2 * 4); const float u0 = bf2f(uu & 0xffffu), u1 = bf2f(uu >> 16);
        s0 += u0; s1 += u1; const int tpos = t0 + 16 * tg + k; const float cnt = (float)((tpos + 1 < win) ? (tpos + 1) : win); const float ic = 1.f / cnt;
        const int row = 16 * tg + k;
        *(LAS unsigned*)(lds + LM_D + row * 512 + (((c2 >> 2) ^ (row & 15)) << 4) + 4 * (c2 & 3)) = pg8::cvt_pk_bf16(s0 * ic - u0, s1 * ic - u1);
        const unsigned ul = *(const LAS unsigned*)(lds + LM_PH + (r0 + k - win + 1) * 512 + c2 * 4); s0 -= bf2f(ul & 0xffffu); s1 -= bf2f(ul >> 16); } }
    __syncthreads();
    LM_RELAUNDER();
    { const int gi = wave >> 1, fr = lane & 15, fq = lane >> 4;
      const bf16_t* Wp = (const bf16_t*)(args.ws + WS_WPOOL) + (size_t)(l * 4 + gi) * 64 * 64; const float* sc = args.in[I_PS] + l * CP + 64 * gi;
#pragma unroll
      for (int mf = 0; mf < 2; ++mf) { const int arow = 32 * (wave & 1) + 16 * mf + fr;
        bf16x8 af[2];
#pragma unroll
        for (int ks = 0; ks < 2; ++ks) af[ks] = *(const LAS bf16x8*)(lds + LM_D + arow * 512 + (((8 * gi + 4 * ks + fq) ^ (arow & 15)) << 4));
#pragma unroll
        for (int nf = 0; nf < 4; ++nf) { f32x4 acc = (f32x4){0.f, 0.f, 0.f, 0.f};
#pragma unroll
            for (int ks = 0; ks < 2; ++ks) { const bf16x8 bfr = *(const bf16x8*)(Wp + (size_t)(16 * nf + fr) * 64 + 32 * ks + 8 * fq); acc = __builtin_amdgcn_mfma_f32_16x16x32_bf16(bfr, af[ks], acc, 0, 0, 0); }
            const int d0 = 16 * nf + 4 * fq; const f32x4 sv = *(const f32x4*)(sc + d0); acc = acc * sv;
            u32x2 w; w.x = pg8::cvt_pk_bf16(acc[0], acc[1]); w.y = pg8::cvt_pk_bf16(acc[2], acc[3]);
            *(u32x2*)(MIX + (row0 + arow) * D + 256 + 64 * gi + d0) = w; } } }
    __syncthreads();
#undef LM_RELAUNDER
}

__device__ __forceinline__ void router_phase(const Args& args, Frame& F, int l) {
    const int tid = F.tid, lane = F.lane, wave = F.wave, fr = lane & 15, fq = lane >> 4;
    LAS unsigned char* lds = F.lds;
    LAS float* lgs = (LAS float*)lds + wave * (16 * 24);
    LAS int* bk = (LAS int*)(lds + 16384);
    LAS int* base = (LAS int*)(lds + 16384 + 512);
    const bf16_t* WRh = (const bf16_t*)(args.ws + WS_WR) + (size_t)l * 2 * 32 * D; const bf16_t* WRl = WRh + 32 * D;
    const float* X1 = args.out; const float* SS1 = (const float*)(args.ws + WS_SS1);
    float* RS1 = (float*)(args.ws + WS_RS1); float* WTS = (float*)(args.ws + WS_WTS); int* TOKB = (int*)(args.ws + WS_TOKB); int* LIST = (int*)(args.ws + WS_LIST);
    unsigned* gcnt = (unsigned*)(args.ws + WS_CTL) + CW_CNT + l * 64;
    const float* bgp = args.in[I_RGB] + l * 4; const float* bep = args.in[I_REB] + l * 16;
    for (int blk = F.vcu; blk < T / 128; blk += F.G) {
        const int row = blk * 128 + wave * 16 + fr;
        const float* xp = X1 + (size_t)row * D + 8 * fq;
        f32x4 acc0 = (f32x4){0.f, 0.f, 0.f, 0.f}, acc1 = acc0;
#pragma unroll 4
        for (int ks = 0; ks < 32; ++ks) {
            const f32x4 xa = *(const f32x4*)(xp + 32 * ks), xb = *(const f32x4*)(xp + 32 * ks + 4);
            u32x4 h; h.x = pg8::cvt_pk_bf16(xa[0], xa[1]); h.y = pg8::cvt_pk_bf16(xa[2], xa[3]); h.z = pg8::cvt_pk_bf16(xb[0], xb[1]); h.w = pg8::cvt_pk_bf16(xb[2], xb[3]);
            u32x4 lo;
            lo.x = pg8::cvt_pk_bf16(xa[0] - bf2f(h.x & 0xffffu), xa[1] - __uint_as_float(h.x & 0xffff0000u)); lo.y = pg8::cvt_pk_bf16(xa[2] - bf2f(h.y & 0xffffu), xa[3] - __uint_as_float(h.y & 0xffff0000u));
            lo.z = pg8::cvt_pk_bf16(xb[0] - bf2f(h.z & 0xffffu), xb[1] - __uint_as_float(h.z & 0xffff0000u)); lo.w = pg8::cvt_pk_bf16(xb[2] - bf2f(h.w & 0xffffu), xb[3] - __uint_as_float(h.w & 0xffff0000u));
            const bf16x8 xh = __builtin_bit_cast(bf16x8, h), xl = __builtin_bit_cast(bf16x8, lo);
            const size_t wo = (size_t)fr * D + 32 * ks + 8 * fq;
            const bf16x8 wh0 = *(const bf16x8*)(WRh + wo), wl0 = *(const bf16x8*)(WRl + wo), wh1 = *(const bf16x8*)(WRh + 16 * D + wo), wl1 = *(const bf16x8*)(WRl + 16 * D + wo);
            acc0 = __builtin_amdgcn_mfma_f32_16x16x32_bf16(wl0, xl, acc0, 0, 0, 0); acc0 = __builtin_amdgcn_mfma_f32_16x16x32_bf16(wl0, xh, acc0, 0, 0, 0);
            acc0 = __builtin_amdgcn_mfma_f32_16x16x32_bf16(wh0, xl, acc0, 0, 0, 0); acc0 = __builtin_amdgcn_mfma_f32_16x16x32_bf16(wh0, xh, acc0, 0, 0, 0);
            acc1 = __builtin_amdgcn_mfma_f32_16x16x32_bf16(wl1, xl, acc1, 0, 0, 0); acc1 = __builtin_amdgcn_mfma_f32_16x16x32_bf16(wl1, xh, acc1, 0, 0, 0);
            acc1 = __builtin_amdgcn_mfma_f32_16x16x32_bf16(wh1, xl, acc1, 0, 0, 0); acc1 = __builtin_amdgcn_mfma_f32_16x16x32_bf16(wh1, xh, acc1, 0, 0, 0);
        }
        *(LAS f32x4*)(lgs + fr * 24 + 4 * fq) = acc0; if (fq == 0) *(LAS f32x4*)(lgs + fr * 24 + 16) = acc1;
        LDS_WAIT(); asm volatile("" ::: "memory");
        if (lane < 16) {
            const float rstd = row_rstd16(SS1 + (size_t)row * 16);
            float lg[20];
#pragma unroll
            for (int q = 0; q < 5; ++q) { const f32x4 v = *(const LAS f32x4*)(lgs + lane * 24 + 4 * q); lg[4 * q] = v[0] * rstd; lg[4 * q + 1] = v[1] * rstd; lg[4 * q + 2] = v[2] * rstd; lg[4 * q + 3] = v[3] * rstd; }
            float g4[4];
#pragma unroll
            for (int j = 0; j < 4; ++j) g4[j] = lg[j] + bgp[j];
            int gidx = 0; float gm = g4[0];
#pragma unroll
            for (int j = 1; j < 4; ++j) if (g4[j] > gm) { gm = g4[j]; gidx = j; }
            float gs = 0.f;
#pragma unroll
            for (int j = 0; j < 4; ++j) gs += __expf(g4[j] - gm);
            const float gp = 1.f / gs;
            float le[4];
#pragma unroll
            for (int j = 0; j < 4; ++j) { const float v = (gidx == 0) ? lg[4 + j] : (gidx == 1) ? lg[8 + j] : (gidx == 2) ? lg[12 + j] : lg[16 + j];
                const float bb = (gidx == 0) ? bep[j] : (gidx == 1) ? bep[4 + j] : (gidx == 2) ? bep[8 + j] : bep[12 + j]; le[j] = v + bb; }
            int ia = 0; float la = le[0];
#pragma unroll
            for (int j = 1; j < 4; ++j) if (le[j] > la) { la = le[j]; ia = j; }
            int ib = -1; float lb = -INFINITY;
#pragma unroll
            for (int j = 0; j < 4; ++j) if (j != ia && le[j] > lb) { lb = le[j]; ib = j; }
            const float pa = 1.f / (1.f + __expf(lb - la)), pbv = 1.f - pa;
            const float wa = gp * pa, wb = gp * pbv;
            const int lo2 = ia < ib ? ia : ib, hi2 = ia < ib ? ib : ia; const float wlo = ia < ib ? wa : wb, whi = ia < ib ? wb : wa;
            const int pi = (lo2 == 0) ? (hi2 - 1) : (lo2 == 1) ? (hi2 + 1) : 5;
            RS1[row] = rstd; WTS[row * 2] = wlo; WTS[row * 2 + 1] = whi; bk[wave * 16 + lane] = gidx * 6 + pi;
        }
        __syncthreads();
        int mybk = 0, lpos = 0;
        if (tid < 128) { mybk = bk[tid]; for (int r = 0; r < tid; ++r) lpos += (bk[r] == mybk) ? 1 : 0; }
        if (tid >= 128 && tid < 128 + NBKT) { const int bq = tid - 128; int c = 0; for (int r = 0; r < 128; ++r) c += (bk[r] == bq) ? 1 : 0;
            base[bq] = (int)__hip_atomic_fetch_add(gcnt + bq, (unsigned)c, __ATOMIC_RELAXED, __HIP_MEMORY_SCOPE_AGENT); }
        __syncthreads();
        if (tid < 128) { const int r2 = blk * 128 + tid; const int pos = base[mybk] + lpos; LIST[(size_t)mybk * T + pos] = r2; TOKB[r2 * 2] = mybk; TOKB[r2 * 2 + 1] = pos; }
        __syncthreads();
    }
}

constexpr int N_PHASES = 1 + 6 * NL;
__global__ void __launch_bounds__(NTHREADS, 2) mega_fwd(Args args) {
    extern __shared__ __attribute__((aligned(16))) unsigned char lds_[];
    Frame F;
    F.lds = (LAS unsigned char*)lds_;
    F.tid = threadIdx.x; F.lane = F.tid & 63; F.wave = __builtin_amdgcn_readfirstlane(F.tid >> 6);
    F.G = gridDim.x; { const int bx = blockIdx.x; F.vcu = (F.G % 8 == 0) ? (bx % 8) * (F.G / 8) + bx / 8 : bx; }
    volatile LAS unsigned* MISC = (volatile LAS unsigned*)(F.lds + MISC_OFF);
    for (int u = F.tid; u < 256; u += NTHREADS) MISC[u] = 0u;
    __syncthreads();
    unsigned char* ws = args.ws;
    unsigned* ctl = (unsigned*)(ws + WS_CTL);
    const int lo = args.ph_lo, hi = args.ph_hi;
    XcdBarrier bar; bar.bar = ctl + CW_BAR; bar.x = 0; bar.st = nullptr;
    if (hi - lo > 1) bar = xcd_barrier_post(ctl + CW_BAR, MISC + 8);
#ifdef ONLY_KIND
#define IN(k) ((((k)==0?0:(((k)-1)%6)+1))==ONLY_KIND && lo <= (k) && (k) < hi)
#else
#define IN(k) (lo <= (k) && (k) < hi)
#endif
#ifdef PROBE_KIND
    unsigned long long pk_prev = __builtin_amdgcn_s_memrealtime(), pk_acc = 0ull;
#define PK_STAMP(k) do { const unsigned long long t_ = __builtin_amdgcn_s_memrealtime(); if ((((k) == 0) ? 0 : ((((k) - 1) % 6) + 1)) == PROBE_KIND) pk_acc += t_ - pk_prev; pk_prev = t_; } while (0)
#else
#define PK_STAMP(k) do { } while (0)
#endif
#define SEAM(k) do { if (IN(k) && IN((k) + 1)) xcd_barrier(bar); PK_STAMP(k); } while (0)
#define RELAUNDER() do { int t_ = threadIdx.x; asm volatile("" : "+v"(t_)); F.tid = t_; F.lane = t_ & 63; } while (0)
    if (IN(0)) { p0_prologue(args, F); SEAM(0); }
    for (int l = 0; l < NL; ++l) {
        const int pb = 1 + 6 * l;
        const float* xin = (l == 0) ? args.in[I_X] : args.out;
        if (IN(pb)) { RELAUNDER();
            pg8::Gemm g{(const char*)(ws + WS_XB), D, nullptr, D, D, 1 << 30};
            DenseOrder S; S.init(T, NIN, F.G, (int)blockIdx.x, (const bf16_t*)(ws + WS_WIN) + (size_t)l * NIN * D, D);
            EpiInProj E{(const float*)(ws + WS_SS), (bf16_t*)(ws + WS_U), (bf16_t*)(ws + WS_PIN), (bf16_t*)(ws + WS_Q), (bf16_t*)(ws + WS_K), (bf16_t*)(ws + WS_V), args.in[I_QG] + l * DH, args.in[I_KG] + l * DH};
            pg8::gemm_phase<EpiInProj, DenseOrder, true>(F.lds, g, S, E, F.tid);
            SEAM(pb);
        }
        if (IN(pb + 1)) { RELAUNDER();
            const float lam_init = 0.8f - 0.6f * expf(-0.3f * (float)l);
            float lam;
            { const float a = args.in[I_LQ1][l * DH + F.lane] * args.in[I_LK1][l * DH + F.lane], b2 = args.in[I_LQ2][l * DH + F.lane] * args.in[I_LK2][l * DH + F.lane];
              lam = expf(wave_sum(a)) - expf(wave_sum(b2)) + lam_init; }
            for (int v = F.vcu; v < 256; v += F.G) {
                const int bh = v >> 2, s = v & 3;
                for (int i = 0; i < 4; ++i) { const int qb = (i == 0) ? (15 - s) : (i == 1) ? (8 + s) : (i == 2) ? (7 - s) : s;
                    attn_unit(args, F, l, bh >> 2, bh & 3, qb, lam, lam_init); }
            }
            for (int tl = F.vcu; tl < T / 64; tl += F.G) local_unit(args, F, l, tl);
            SEAM(pb + 1);
        }
        if (IN(pb + 2)) { RELAUNDER();
            pg8::Gemm g{(const char*)(ws + WS_MIX), D, nullptr, D, D, 1 << 30};
            DenseOrder S; S.init(T, D, F.G, (int)blockIdx.x, (const bf16_t*)(ws + WS_WOUT) + (size_t)l * D * D, D);
            EpiOutProj E{xin, args.out, (bf16_t*)(ws + WS_X1B), (float*)(ws + WS_SS1)};
            pg8::gemm_phase<EpiOutProj, DenseOrder, true>(F.lds, g, S, E, F.tid);
            SEAM(pb + 2);
        }
        if (IN(pb + 3)) { RELAUNDER(); router_phase(args, F, l); SEAM(pb + 3); }
        if (IN(pb + 4) || IN(pb + 5)) { RELAUNDER();
            LAS int* ti = (LAS int*)(F.lds + LDS_EXTRA + 8192);
            LAS int* tb = ti + 512;
            const unsigned* gc = ctl + CW_CNT + l * 64;
            if (F.tid == 0) { int a = 0; for (int b = 0; b < NBKT; ++b) { const int c = (int)__hip_atomic_load(gc + b, __ATOMIC_RELAXED, __HIP_MEMORY_SCOPE_AGENT); tb[b] = a; a += (c + 255) >> 8; } tb[NBKT] = a; ti[0] = a; }
            __syncthreads();
            if (F.tid < NBKT) { const int b = F.tid; const int c = (int)__hip_atomic_load(gc + b, __ATOMIC_RELAXED, __HIP_MEMORY_SCOPE_AGENT); const int t0 = tb[b], n = tb[b + 1] - t0;
                for (int lt = 0; lt < n; ++lt) { ti[2 + 2 * (t0 + lt)] = b | (lt << 8); ti[3 + 2 * (t0 + lt)] = (c - lt * 256) < 256 ? (c - lt * 256) : 256; } }
            __syncthreads();
            if (IN(pb + 4)) { RELAUNDER();
                pg8::Gemm g{(const char*)(ws + WS_X1B), D, (const int*)(ws + WS_LIST), D, D, 1 << 30};
                MoeOrder S{ti, F.G, (int)blockIdx.x, l, 1, (const char*)(ws + WS_WGU)};
                EpiMoe1 E{(const int*)(ws + WS_LIST), (const float*)(ws + WS_RS1), (const float*)(ws + WS_WTS), (bf16_t*)(ws + WS_ACT)};
                pg8::gemm_phase<EpiMoe1, MoeOrder, true>(F.lds, g, S, E, F.tid);
                SEAM(pb + 4);
            }
            if (IN(pb + 5)) { RELAUNDER();
                pg8::Gemm g{(const char*)(ws + WS_ACT), 512, nullptr, DE, 512, 4};
                MoeOrder S{ti, F.G, (int)blockIdx.x, l, 2, (const char*)(ws + WS_WD)};
                EpiMoe2 E{(const int*)(ws + WS_LIST), args.out, (bf16_t*)(ws + WS_XB), (float*)(ws + WS_SS), (l == NL - 1) ? 1 : 0};
                pg8::gemm_phase<EpiMoe2, MoeOrder, true>(F.lds, g, S, E, F.tid);
                SEAM(pb + 5);
            }
        }
    }
#ifdef PROBE_KIND
    { const unsigned long long t0_ = __builtin_amdgcn_s_memrealtime(); while (__builtin_amdgcn_s_memrealtime() - t0_ < pk_acc) __builtin_amdgcn_s_sleep(8); }
#endif
#undef IN
#undef SEAM
#undef RELAUNDER
}

#ifdef DBG_CHECK
__device__ __forceinline__ int sample_row(int s) {
    const int tbl[24] = {0, 1, 2, 14, 15, 16, 29, 30, 31, 32, 63, 64, 65, 127, 128, 2047, 2048, 2049, 2063, 2078, 2079, 4095, 4096, 32767};
    if (s < 24) return tbl[s];
    return (int)(((unsigned)s * 2654435761u) % (unsigned)T);
}
__device__ __forceinline__ void rec_err(float* errs, int idx, float e) { if (!(e == e)) e = 1e30f; atomicMax((int*)errs + idx, __float_as_int(e)); }
__device__ __forceinline__ float blk_max(float v, float* sh) {
    __syncthreads(); sh[threadIdx.x] = v; __syncthreads();
    for (int s = 128; s > 0; s >>= 1) { if ((int)threadIdx.x < s) sh[threadIdx.x] = fmaxf(sh[threadIdx.x], sh[threadIdx.x + s]); __syncthreads(); }
    const float r = sh[0]; __syncthreads(); return r;
}
__device__ __forceinline__ float blk_sum(float v, float* sh) {
    __syncthreads(); sh[threadIdx.x] = v; __syncthreads();
    for (int s = 128; s > 0; s >>= 1) { if ((int)threadIdx.x < s) sh[threadIdx.x] += sh[threadIdx.x + s]; __syncthreads(); }
    const float r = sh[0]; __syncthreads(); return r;
}
__global__ void chk_prologue(Args a, float* errs) {
    __shared__ float sh[256];
    const int r = sample_row(blockIdx.x); const float* x = a.in[I_X] + (size_t)r * D; const bf16_t* xb = (const bf16_t*)(a.ws + WS_XB) + (size_t)r * D;
    float e = 0.f, s = 0.f;
    for (int k = threadIdx.x; k < D; k += 256) { e = fmaxf(e, fabsf(bf2f(xb[k]) - x[k]) / (fabsf(x[k]) + 1.f)); s += x[k] * x[k]; }
    s = blk_sum(s, sh); const float* ss = (const float*)(a.ws + WS_SS) + (size_t)r * 16; float s2 = 0.f; for (int i = 0; i < 16; ++i) s2 += ss[i];
    e = fmaxf(e, fabsf(s2 - s) / (s + 1.f) * 10.f);
    for (int l = 0; l < NL; ++l) { const unsigned hsh = (blockIdx.x * 256u + threadIdx.x) * 2654435761u + l * 97u;
        { const int n = hsh % D, k = (hsh >> 10) % D; const float w = a.in[I_WOUT][(size_t)l * D * D + (size_t)k * D + n]; const float g = bf2f(((const bf16_t*)(a.ws + WS_WOUT))[(size_t)l * D * D + (size_t)n * D + k]); e = fmaxf(e, fabsf(g - w) * 20.f); }
        { const int ee = hsh % NE, n = (hsh >> 4) % D, k = (hsh >> 14) % DE; const float w = a.in[I_WDN][((size_t)(l * NE + ee) * DE + k) * D + n]; const float g = bf2f(((const bf16_t*)(a.ws + WS_WD))[((size_t)(l * NE + ee) * D + n) * DE + k]); e = fmaxf(e, fabsf(g - w) * 20.f); }
        { const int ee = hsh % NE, j = (hsh >> 4) % DE, k = (hsh >> 12) % D, gu = (hsh >> 22) & 1; const float w = (gu ? a.in[I_WU] : a.in[I_WG])[((size_t)(l * NE + ee) * D + k) * DE + j] * a.in[I_FNG][l * D + k];
          const int p = (j >> 7) * 256 + gu * 128 + (j & 127); const float g = bf2f(((const bf16_t*)(a.ws + WS_WGU))[((size_t)(l * NE + ee) * 512 + p) * D + k]); e = fmaxf(e, fabsf(g - w) * 20.f); }
        { const int j = hsh % 20, k = (hsh >> 5) % D; const float w = ((j < 4) ? a.in[I_RGW][(size_t)(l * D + k) * 4 + j] : a.in[I_REW][(size_t)(l * D + k) * 16 + j - 4]) * a.in[I_FNG][l * D + k];
          const bf16_t* wr = (const bf16_t*)(a.ws + WS_WR) + (size_t)l * 2 * 32 * D; const float g = bf2f(wr[(size_t)j * D + k]) + bf2f(wr[(size_t)(32 + j) * D + k]); e = fmaxf(e, fabsf(g - w) * 1000.f); }
    }
    e = blk_max(e, sh); if (threadIdx.x == 0) rec_err(errs, 0, e);
}
__global__ void chk_inproj(Args a, int l, float* errs) {
    __shared__ float z[NIN]; __shared__ float sh[256];
    const int r = sample_row(blockIdx.x); const bf16_t* xb = (const bf16_t*)(a.ws + WS_XB) + (size_t)r * D;
    const float* ss = (const float*)(a.ws + WS_SS) + (size_t)r * 16; float s2 = 0.f; for (int i = 0; i < 16; ++i) s2 += ss[i];
    const float rstd = rsqrtf(s2 / D + EPS); const float* W = a.in[I_WIN] + (size_t)l * D * NIN; const float* g = a.in[I_ANG] + l * D;
    for (int c = threadIdx.x; c < NIN; c += 256) { float acc = 0.f; for (int k = 0; k < D; ++k) acc += bf2f(xb[k]) * g[k] * W[(size_t)k * NIN + c]; z[c] = acc * rstd; }
    __syncthreads();
    float e = 0.f; const int t = threadIdx.x;
    { const float ex = z[t] * (1.f / (1.f + expf(-z[256 + t]))); e = fmaxf(e, fabsf(ex - bf2f(((const bf16_t*)(a.ws + WS_U))[(size_t)r * CC + t]))); }
    { e = fmaxf(e, fabsf(z[512 + t] - bf2f(((const bf16_t*)(a.ws + WS_PIN))[(size_t)r * CP + t]))); }
    for (int c = t; c < CA; c += 256) {
        e = fmaxf(e, fabsf(z[1792 + c] - bf2f(((const bf16_t*)(a.ws + WS_V))[(size_t)r * CA + c])));
        const int hs = c >> 6, d = c & 63; float sq = 0.f, sk = 0.f; for (int i = 0; i < 64; ++i) { const float q = z[768 + hs * 64 + i], k = z[1280 + hs * 64 + i]; sq += q * q; sk += k * k; }
        const float eq = z[768 + c] * rsqrtf(sq / 64.f + EPS) * a.in[I_QG][l * DH + d] * QSCALE, ek = z[1280 + c] * rsqrtf(sk / 64.f + EPS) * a.in[I_KG][l * DH + d];
        e = fmaxf(e, fabsf(eq - bf2f(((const bf16_t*)(a.ws + WS_Q))[(size_t)r * CA + c])) * 4.f);
        e = fmaxf(e, fabsf(ek - bf2f(((const bf16_t*)(a.ws + WS_K))[(size_t)r * CA + c])));
    }
    e = blk_max(e, sh); if (t == 0) rec_err(errs, l * 8 + 1, e);
}
__global__ void chk_attn(Args a, int l, float* errs) {
    __shared__ float p[2][SEQ]; __shared__ float sh[256]; __shared__ float ov[DV];
    const int qt[16] = {0, 1, 31, 32, 63, 64, 65, 127, 128, 129, 191, 192, 500, 1023, 1024, 2047};
    const int q = qt[blockIdx.x & 15], h = (blockIdx.x >> 4) & 3, b = (blockIdx.x >> 6) ? 13 : 0; const int t = threadIdx.x;
    const bf16_t* Q = (const bf16_t*)(a.ws + WS_Q); const bf16_t* K = (const bf16_t*)(a.ws + WS_K); const bf16_t* V = (const bf16_t*)(a.ws + WS_V);
    const size_t rb = (size_t)b * SEQ; const float slope = exp2f(-2.f * (h + 1)); const float sl2 = slope * 1.4426950408889634f;
    const float lam_init = 0.8f - 0.6f * expf(-0.3f * (float)l); float s1 = 0.f, s2 = 0.f;
    for (int d = 0; d < DH; ++d) { s1 += a.in[I_LQ1][l * DH + d] * a.in[I_LK1][l * DH + d]; s2 += a.in[I_LQ2][l * DH + d] * a.in[I_LK2][l * DH + d]; }
    const float lam = expf(s1) - expf(s2) + lam_init;
    for (int m = 0; m < 2; ++m) {
        float mx = -INFINITY;
        for (int kv = t; kv <= q; kv += 256) { float s = 0.f; for (int d = 0; d < DH; ++d) s += bf2f(Q[(rb + q) * CA + h * 128 + m * 64 + d]) * bf2f(K[(rb + kv) * CA + h * 128 + m * 64 + d]); s -= sl2 * (float)(q - kv); p[m][kv] = s; mx = fmaxf(mx, s); }
        mx = blk_max(mx, sh); float sm = 0.f;
        for (int kv = t; kv <= q; kv += 256) { const float e_ = exp2f(p[m][kv] - mx); p[m][kv] = e_; sm += e_; }
        sm = blk_sum(sm, sh);
        for (int kv = t; kv <= q; kv += 256) p[m][kv] /= sm;
        __syncthreads();
    }
    float o = 0.f;
    if (t < DV) { for (int kv = 0; kv <= q; ++kv) o += (p[0][kv] - lam * p[1][kv]) * bf2f(V[(rb + kv) * CA + h * 128 + t]); }
    const float ssq = blk_sum(t < DV ? o * o : 0.f, sh);
    float e = 0.f;
    if (t < DV) { const float ex = o * rsqrtf(ssq / DV + EPS) * a.in[I_ASG][l * DV + t] * (1.f - lam_init); e = fabsf(ex - bf2f(((const bf16_t*)(a.ws + WS_MIX))[(rb + q) * D + 512 + h * 128 + t])); }
    e = blk_max(e, sh); if (t == 0) rec_err(errs, l * 8 + 2, e);
}
__global__ void chk_local(Args a, int l, float* errs) {
    __shared__ float sv[CC]; __shared__ float sh[256];
    const int r = sample_row(blockIdx.x); const int b = r / SEQ, tp = r % SEQ; const int t = threadIdx.x;
    const bf16_t* U = (const bf16_t*)(a.ws + WS_U); const bf16_t* PIN = (const bf16_t*)(a.ws + WS_PIN); const bf16_t* MIX = (const bf16_t*)(a.ws + WS_MIX);
    float y = a.in[I_CB][l * CC + t];
    for (int j = 0; j < CW; ++j) { const int tt = tp - 30 + j; if (tt >= 0) y += a.in[I_CW][(size_t)(l * CW + j) * CC + t] * bf2f(U[((size_t)b * SEQ + tt) * CC + t]); }
    const float mean = blk_sum(y, sh) / CC; const float dv = y - mean; const float var = blk_sum(dv * dv, sh) / CC;
    float yn = dv * rsqrtf(var + EPS) * a.in[I_CLG][l * CC + t] + a.in[I_CLB][l * CC + t]; yn = yn / (1.f + expf(-yn));
    sv[t] = yn; __syncthreads();
    float o = a.in[I_CPB][l * CC + t]; for (int c = 0; c < CC; ++c) o += sv[c] * a.in[I_CPW][(size_t)l * CC * CC + (size_t)c * CC + t];
    float e = fabsf(o - bf2f(MIX[(size_t)r * D + t]));
    __syncthreads();
    { const int gi = t >> 6, win = 2 << gi; float s = 0.f; for (int i = 0; i < win; ++i) { const int tt = tp - i; if (tt >= 0) s += bf2f(PIN[((size_t)b * SEQ + tt) * CP + t]); }
      const float cnt = (float)((tp + 1 < win) ? tp + 1 : win); sv[t] = s / cnt - bf2f(PIN[(size_t)r * CP + t]); }
    __syncthreads();
    { const int gi = t >> 6, dd = t & 63; float o2 = 0.f; for (int c = 0; c < 64; ++c) o2 += sv[gi * 64 + c] * a.in[I_PW][((size_t)(l * 4 + gi) * 64 + c) * 64 + dd];
      o2 *= a.in[I_PS][l * CP + t]; e = fmaxf(e, fabsf(o2 - bf2f(MIX[(size_t)r * D + 256 + t]))); }
    e = blk_max(e, sh); if (t == 0) rec_err(errs, l * 8 + 3, e);
}
__global__ void chk_outproj(Args a, int l, float* errs) {
    __shared__ float sh[256];
    const int r = sample_row(blockIdx.x); const int t = threadIdx.x; const bf16_t* MIX = (const bf16_t*)(a.ws + WS_MIX) + (size_t)r * D;
    float e = 0.f, ssq = 0.f;
    for (int n = t; n < D; n += 256) { float acc = 0.f; for (int k = 0; k < D; ++k) acc += bf2f(MIX[k]) * a.in[I_WOUT][(size_t)l * D * D + (size_t)k * D + n];
        const float xin = (l == 0) ? a.in[I_X][(size_t)r * D + n] : bf2f(((const bf16_t*)(a.ws + WS_XB))[(size_t)r * D + n]);
        const float got = a.out[(size_t)r * D + n]; e = fmaxf(e, fabsf(xin + acc - got)); ssq += got * got;
        e = fmaxf(e, fabsf(bf2f(((const bf16_t*)(a.ws + WS_X1B))[(size_t)r * D + n]) - got) / (fabsf(got) + 1.f) * 4.f); }
    ssq = blk_sum(ssq, sh); const float* ss = (const float*)(a.ws + WS_SS1) + (size_t)r * 16; float s2 = 0.f; for (int i = 0; i < 16; ++i) s2 += ss[i];
    e = fmaxf(e, fabsf(s2 - ssq) / (ssq + 1.f) * 10.f);
    e = blk_max(e, sh); if (t == 0) rec_err(errs, l * 8 + 4, e);
}
__global__ void chk_router_moe(Args a, int l, float* errs) {
    __shared__ float sh[256]; __shared__ float hf[D]; __shared__ float lgs[20]; __shared__ float act[2][DE]; __shared__ int eid[2]; __shared__ float wv[2];
    const int r = sample_row(blockIdx.x); const int t = threadIdx.x; const float* x1 = a.out + (size_t)r * D;
    float s = 0.f; for (int k = t; k < D; k += 256) s += x1[k] * x1[k];
    s = blk_sum(s, sh); const float rstd = rsqrtf(s / D + EPS);
    for (int k = t; k < D; k += 256) hf[k] = x1[k] * rstd * a.in[I_FNG][l * D + k];
    __syncthreads();
    if (t < 20) { double acc = 0.0; for (int k = 0; k < D; ++k) acc += (double)hf[k] * (double)((t < 4) ? a.in[I_RGW][(size_t)(l * D + k) * 4 + t] : a.in[I_REW][(size_t)(l * D + k) * 16 + t - 4]);
        lgs[t] = (float)acc + ((t < 4) ? a.in[I_RGB][l * 4 + t] : a.in[I_REB][l * 16 + t - 4]); }
    __syncthreads();
    float e = 0.f;
    if (t == 0) {
        int gi = 0; for (int j = 1; j < 4; ++j) if (lgs[j] > lgs[gi]) gi = j;
        float gs = 0.f; for (int j = 0; j < 4; ++j) gs += expf(lgs[j] - lgs[gi]); const float gp = 1.f / gs;
        const float* le = lgs + 4 + 4 * gi; int ia = 0; for (int j = 1; j < 4; ++j) if (le[j] > le[ia]) ia = j;
        int ib = -1; for (int j = 0; j < 4; ++j) if (j != ia && (ib < 0 || le[j] > le[ib])) ib = j;
        const float pa = 1.f / (1.f + expf(le[ib] - le[ia])); const float wa = gp * pa, wb = gp * (1.f - pa);
        const int lo = ia < ib ? ia : ib, hi = ia < ib ? ib : ia; const float wlo = ia < ib ? wa : wb, whi = ia < ib ? wb : wa;
        const int pi = (lo == 0) ? hi - 1 : (lo == 1) ? hi + 1 : 5; const int bkt = gi * 6 + pi;
        const int* TOKB = (const int*)(a.ws + WS_TOKB); const float* WTS = (const float*)(a.ws + WS_WTS); const int* LIST = (const int*)(a.ws + WS_LIST);
        if (TOKB[r * 2] != bkt) e = 1000.f;
        else { const int pos = TOKB[r * 2 + 1]; const unsigned cnt = ((const unsigned*)(a.ws + WS_CTL))[CW_CNT + l * 64 + bkt];
            if (pos < 0 || (unsigned)pos >= cnt || LIST[(size_t)bkt * T + pos] != r) e = 500.f; }
        e = fmaxf(e, fabsf(WTS[r * 2] - wlo) * 10.f); e = fmaxf(e, fabsf(WTS[r * 2 + 1] - whi) * 10.f);
        e = fmaxf(e, fabsf(((const float*)(a.ws + WS_RS1))[r] - rstd) * 10.f);
        eid[0] = gi * 4 + lo; eid[1] = gi * 4 + hi; wv[0] = wlo; wv[1] = whi;
    }
    __syncthreads();
    for (int s2 = 0; s2 < 2; ++s2) { const int ee = eid[s2]; const float* Wg = a.in[I_WG] + (size_t)(l * NE + ee) * D * DE; const float* Wu = a.in[I_WU] + (size_t)(l * NE + ee) * D * DE;
        float g = 0.f, u = 0.f; for (int k = 0; k < D; ++k) { g += hf[k] * Wg[(size_t)k * DE + t]; u += hf[k] * Wu[(size_t)k * DE + t]; }
        act[s2][t] = g / (1.f + expf(-g)) * u * wv[s2]; }
    __syncthreads();
    float* exp_out = (float*)(a.ws + WS_DBG) + (size_t)blockIdx.x * D;
    for (int n = t; n < D; n += 256) { float y = 0.f; for (int s2 = 0; s2 < 2; ++s2) { const float* Wd = a.in[I_WDN] + (size_t)(l * NE + eid[s2]) * DE * D; for (int j = 0; j < DE; ++j) y += act[s2][j] * Wd[(size_t)j * D + n]; }
        exp_out[n] = x1[n] + y; }
    e = blk_max(e, sh); if (t == 0) rec_err(errs, l * 8 + 5, e);
}
__global__ void chk_moe_post(Args a, int l, float* errs) {
    __shared__ float sh[256];
    const int r = sample_row(blockIdx.x); const int t = threadIdx.x; const float* exp_out = (const float*)(a.ws + WS_DBG) + (size_t)blockIdx.x * D;
    float e = 0.f, ssq = 0.f;
    for (int n = t; n < D; n += 256) { const float got = a.out[(size_t)r * D + n]; e = fmaxf(e, fabsf(got - exp_out[n])); ssq += got * got;
        if (l < NL - 1) e = fmaxf(e, fabsf(bf2f(((const bf16_t*)(a.ws + WS_XB))[(size_t)r * D + n]) - got) / (fabsf(got) + 1.f) * 4.f); }
    ssq = blk_sum(ssq, sh);
    if (l < NL - 1) { const float* ss = (const float*)(a.ws + WS_SS) + (size_t)r * 16; float s2 = 0.f; for (int i = 0; i < 16; ++i) s2 += ss[i]; e = fmaxf(e, fabsf(s2 - ssq) / (ssq + 1.f) * 10.f); }
    e = blk_max(e, sh); if (t == 0) rec_err(errs, l * 8 + 6, e);
}
#ifndef DBG_SHOW
#define DBG_SHOW -2
#endif
__global__ void chk_report(Args a, const float* errs) {
    const float tol[8] = {0.05f, 0.06f, 0.05f, 0.06f, 0.08f, 0.05f, 0.08f, 1e30f};
    int bad = -1; for (int i = 0; i < 16; ++i) if (errs[i] > tol[i & 7]) { bad = i; break; }
    float val = 0.f; bool over = false;
    if (DBG_SHOW == -1) { val = 16.f; over = true; }
    else if (DBG_SHOW >= 0) { val = 1000.f * errs[DBG_SHOW]; over = true; }
    else if (bad >= 0) { val = 8.f * exp2f((float)bad); over = true; }
    if (over) for (size_t i = (size_t)blockIdx.x * blockDim.x + threadIdx.x; i < (size_t)T * D; i += (size_t)gridDim.x * blockDim.x) a.out[i] = val;
}
#endif

extern "C" void kernel_launch(void* const* d_in, const int* in_sizes, int n_in, void* d_out, int out_size, void* d_ws, size_t ws_size, hipStream_t stream) {
    static int grid = 0;
    if (grid == 0) {
        if (n_in != 27 || out_size != T * D || ws_size < WS_END) { fprintf(stderr, "kernel_launch: unexpected shapes (n_in %d out %d ws %zu)\n", n_in, out_size, ws_size); grid = -1; return; }
        int dev = 0, cus = 0, per_cu = 0;
        if (hipGetDevice(&dev) != hipSuccess || hipDeviceGetAttribute(&cus, hipDeviceAttributeMultiprocessorCount, dev) != hipSuccess) { grid = -1; return; }
        if (hipFuncSetAttribute((const void*)mega_fwd, hipFuncAttributeMaxDynamicSharedMemorySize, LDS_BYTES) != hipSuccess) { fprintf(stderr, "kernel_launch: hipFuncSetAttribute failed\n"); grid = -1; return; }
        if (hipOccupancyMaxActiveBlocksPerMultiprocessor(&per_cu, (const void*)mega_fwd, NTHREADS, LDS_BYTES) != hipSuccess || per_cu < 1) fprintf(stderr, "kernel_launch: occupancy query reports %d\n", per_cu);
        (void)hipGetLastError();
        grid = cus;
    }
    if (grid < 0) return;
    (void)hipMemsetAsync((char*)d_ws + WS_CTL, 0, CTL_ZERO_BYTES, stream);
    Args a{};
    for (int i = 0; i < 27; ++i) a.in[i] = (const float*)d_in[i];
    a.out = (float*)d_out; a.ws = (unsigned char*)d_ws;
#ifdef DBG_CHECK
    float* errs = (float*)((char*)d_ws + WS_ERR);
    (void)hipMemsetAsync(errs, 0, 4096, stream);
    auto run = [&](int lo, int hi) { a.ph_lo = lo; a.ph_hi = hi; hipLaunchKernelGGL(mega_fwd, dim3(grid), dim3(NTHREADS), LDS_BYTES, stream, a); };
    run(0, 1); chk_prologue<<<48, 256, 0, stream>>>(a, errs);
    for (int l = 0; l < NL; ++l) { const int pb = 1 + 6 * l;
        run(pb, pb + 1); chk_inproj<<<48, 256, 0, stream>>>(a, l, errs);
        run(pb + 1, pb + 2); chk_attn<<<128, 256, 0, stream>>>(a, l, errs); chk_local<<<48, 256, 0, stream>>>(a, l, errs);
        run(pb + 2, pb + 3); chk_outproj<<<48, 256, 0, stream>>>(a, l, errs);
        run(pb + 3, pb + 4); chk_router_moe<<<48, 256, 0, stream>>>(a, l, errs);
        run(pb + 4, pb + 5); run(pb + 5, pb + 6); chk_moe_post<<<48, 256, 0, stream>>>(a, l, errs);
    }
    chk_report<<<1024, 256, 0, stream>>>(a, errs);
#else
#ifndef N_SPLIT
#define N_SPLIT 0
#endif
    if (N_SPLIT) { for (int p = 0; p < N_PHASES; ++p) { a.ph_lo = p; a.ph_hi = p + 1; hipLaunchKernelGGL(mega_fwd, dim3(grid), dim3(NTHREADS), LDS_BYTES, stream, a); } }
    else { a.ph_lo = 0; a.ph_hi = N_PHASES; hipLaunchKernelGGL(mega_fwd, dim3(grid), dim3(NTHREADS), LDS_BYTES, stream, a); }
#endif
}
```

```cpp
#include <hip/hip_runtime.h>
#include <cstdio>
#include <cstdint>

#define GAS __attribute__((address_space(1)))
#define LAS __attribute__((address_space(3)))
typedef unsigned short bf16_t;
typedef short bf16x8 __attribute__((ext_vector_type(8)));
typedef short s16x4 __attribute__((ext_vector_type(4)));
typedef float f32x4 __attribute__((ext_vector_type(4)));
typedef float f32x2 __attribute__((ext_vector_type(2)));
typedef float f32x16 __attribute__((ext_vector_type(16)));
typedef unsigned u32x4 __attribute__((ext_vector_type(4)));
typedef unsigned u32x2 __attribute__((ext_vector_type(2)));

__device__ __forceinline__ float bf2f(unsigned v) { return __uint_as_float(v << 16); }
__device__ __forceinline__ unsigned f2bf(float f) { unsigned u = __float_as_uint(f); return (u + 0x7fffu + ((u >> 16) & 1u)) >> 16; }
__device__ __forceinline__ unsigned pk2(float lo, float hi) { return f2bf(lo) | (f2bf(hi) << 16); }
__device__ __forceinline__ float wave_sum(float v) {
#define WS_DPP(ctrl, rmask) __builtin_bit_cast(float, __builtin_amdgcn_update_dpp(0, __builtin_bit_cast(int, v), (ctrl), (rmask), 0xf, true))
    v += WS_DPP(0xB1, 0xf);
    v += WS_DPP(0x4E, 0xf);
    v += WS_DPP(0x141, 0xf);
    v += WS_DPP(0x140, 0xf);
    v += WS_DPP(0x142, 0xa);
    v += WS_DPP(0x143, 0xc);
#undef WS_DPP
    return __builtin_bit_cast(float, __builtin_amdgcn_readlane(__builtin_bit_cast(int, v), 63));
}

namespace pg8 {
constexpr int BM = 256, BK = 64, HALF = 128, HTB = HALF * BK * 2, STAGE_BYTES = 8 * HTB;
__host__ __device__ __forceinline__ int lds_byte(int r, int c) { const int st = (r >> 4) * 2 + (c >> 5), rr = r & 15, cc = c & 31, ob = rr * 64 + cc * 2; return st * 1024 + (ob ^ (((ob >> 9) & 1) << 5)); }
__host__ __device__ __forceinline__ void stage_rc(int b, int& R, int& C) { const int st = b / 1024, sb = b % 1024, swz = sb ^ (((sb >> 9) & 1) << 5); R = (st >> 1) * 16 + swz / 64; C = (st & 1) * 32 + (swz % 64) / 2; }
__host__ __device__ __forceinline__ int perm32(int rho) { const int n = rho >> 4, i = rho & 15; return 8 * (i >> 2) + 4 * n + (i & 3); }

struct Unit { int pm, pn; const char* bb; long bjump; int arow0; int acount; int aux; };
struct Gemm { const char* A; int lda; const int* gather; int ldb; int K; int bsplit; };

__device__ __forceinline__ unsigned cvt_pk_bf16(float lo, float hi) { unsigned r; asm volatile("v_cvt_pk_bf16_f32 %0, %1, %2" : "=v"(r) : "v"(lo), "v"(hi)); return r; }

template <class Epi, class Sched, bool ALIGN_EPI>
__device__ __forceinline__ void gemm_phase(LAS unsigned char* lds, const Gemm g, const Sched& S, const Epi& E, const int tid) {
    const int wid = __builtin_amdgcn_readfirstlane(tid >> 6), lane = tid & 63, wr = wid >> 2, wc = wid & 3, fr = lane & 15, fq = lane >> 4;
    const int K = g.K, nt = K / BK;
    unsigned voffB[2];
#pragma unroll
    for (int i = 0; i < 2; ++i) { int R, C; stage_rc(tid * 16 + i * 8192, R, C); const int Rb = Epi::PERM ? ((R & ~31) + perm32(R & 31)) : R; voffB[i] = (unsigned)(Rb * g.ldb + C) * 2u; }
    const size_t kstep = (size_t)(BK * 2);
    const size_t bh = (size_t)HALF * g.ldb * 2;
    const unsigned ldsw = (unsigned)wid * 1024u;
    const int aoff = lds_byte(wr * 64 + fr, fq * 8), boff = lds_byte(wc * 32 + fr, fq * 8);
    const char* const Ab = g.A;
#define PG8_SA(b, h) (((b) * 2 + (h)) * HTB)
#define PG8_SB(b, h) ((4 + (b) * 2 + (h)) * HTB)
#define PG8_STAGE(bufoff, gbase, voff) do { _Pragma("unroll") for (int _i = 0; _i < 2; ++_i) \
        __builtin_amdgcn_global_load_lds((const unsigned*)((const char*)(gbase) + (voff)[_i]), (LAS unsigned*)(lds + (bufoff) + ldsw + _i * 8192), 16, 0, 0); } while (0)
#define PG8_LDA(dst, b, h) do { _Pragma("unroll") for (int m = 0; m < 4; ++m) _Pragma("unroll") for (int k = 0; k < 2; ++k) dst[m][k] = *(const LAS bf16x8*)(lds + PG8_SA(b, h) + aoff + m * 2048 + k * 1024); } while (0)
#define PG8_LDB(dst, b, h) do { _Pragma("unroll") for (int n = 0; n < 2; ++n) _Pragma("unroll") for (int k = 0; k < 2; ++k) dst[n][k] = *(const LAS bf16x8*)(lds + PG8_SB(b, h) + boff + n * 2048 + k * 1024); } while (0)
#define PG8_MMA(ai, bj, At, Bt) do { __builtin_amdgcn_s_setprio(1); _Pragma("unroll") for (int m = 0; m < 4; ++m) _Pragma("unroll") for (int n = 0; n < 2; ++n) _Pragma("unroll") for (int k = 0; k < 2; ++k) \
        acc[ai][bj][m][n] = __builtin_amdgcn_mfma_f32_16x16x32_bf16(Bt[n][k], At[m][k], acc[ai][bj][m][n], 0, 0, 0); __builtin_amdgcn_s_setprio(0); } while (0)
#define PG8_WAIT_V(n) asm volatile("s_waitcnt vmcnt(" #n ")" ::: "memory")
#define PG8_WAIT_L(n) asm volatile("s_waitcnt lgkmcnt(" #n ")" ::: "memory")
#define PG8_BAR __builtin_amdgcn_s_barrier()
#define PG8_SCHED __builtin_amdgcn_sched_barrier(0)
#define PG8_AOFFS(u, o) do { _Pragma("unroll") for (int _h = 0; _h < 2; ++_h) _Pragma("unroll") for (int _i = 0; _i < 2; ++_i) { int _R, _C; stage_rc(tid * 16 + _i * 8192, _R, _C); const int _r = _h * HALF + _R; \
        int _row; if (g.gather) { _row = (_r < (u).acount) ? g.gather[(u).arow0 + _r] : 0; } else { _row = (u).arow0 + _r; } (o)[_h][_i] = (unsigned)(_row * g.lda + _C) * 2u; } } while (0)
#define PG8_BKO(u, tt) ((size_t)(tt) * kstep + (((tt) >= g.bsplit) ? (size_t)(u).bjump : (size_t)0))
    Unit cur, nxt; int ui = 0;
    if (!S.next(0, cur)) return;
    f32x4 acc[2][2][4][2];
#pragma unroll
    for (int a = 0; a < 2; ++a)
#pragma unroll
        for (int b = 0; b < 2; ++b)
#pragma unroll
            for (int m = 0; m < 4; ++m)
#pragma unroll
                for (int n = 0; n < 2; ++n) acc[a][b][m][n] = (f32x4){0.f, 0.f, 0.f, 0.f};
    bf16x8 At[4][2], B0[2][2], B1[2][2];
    unsigned cao[2][2];
    LAS u32x4* const naol = (LAS u32x4*)(lds + STAGE_BYTES + 1024) + tid;
    PG8_AOFFS(cur, cao);
    const char* cB = cur.bb;
    PG8_STAGE(PG8_SB(0, 0), cB, voffB); PG8_STAGE(PG8_SB(0, 1), cB + bh, voffB); PG8_STAGE(PG8_SA(0, 0), Ab, cao[0]); PG8_STAGE(PG8_SA(0, 1), Ab, cao[1]);
    if (wr == 1) PG8_BAR;
    PG8_WAIT_V(2); PG8_BAR;
    PG8_STAGE(PG8_SB(1, 0), cB + kstep, voffB); PG8_STAGE(PG8_SA(1, 0), Ab + kstep, cao[0]); PG8_STAGE(PG8_SB(1, 1), cB + bh + kstep, voffB);
    PG8_WAIT_V(6); PG8_BAR;
    for (;;) {
        const bool has_next = S.next(ui + 1, nxt);
        const char* nB = cB;
        { unsigned nao[2][2];
          if (has_next) { PG8_AOFFS(nxt, nao); nB = nxt.bb; }
          else {
#pragma unroll
            for (int h = 0; h < 2; ++h)
#pragma unroll
                for (int i = 0; i < 2; ++i) nao[h][i] = cao[h][i];
          }
          *naol = (u32x4){nao[0][0], nao[0][1], nao[1][0], nao[1][1]}; }
#pragma unroll 1
        for (int t = 0; t < nt; t += 2) {
            const bool last = (t == nt - 2);
            const char* a1 = Ab + (size_t)(t + 1) * kstep;
            const char* a2 = last ? Ab : Ab + (size_t)(t + 2) * kstep;
            const char* a3 = a2 + kstep;
            const char* b2 = last ? nB : cB + PG8_BKO(cur, t + 2);
            const char* b3 = last ? nB + kstep : cB + PG8_BKO(cur, t + 3);
            unsigned ao2[2][2];
#pragma unroll
            for (int h = 0; h < 2; ++h)
#pragma unroll
                for (int i = 0; i < 2; ++i) ao2[h][i] = cao[h][i];
            if (last) { const u32x4 v = *naol; ao2[0][0] = v.x; ao2[0][1] = v.y; ao2[1][0] = v.z; ao2[1][1] = v.w; }
            PG8_LDB(B0, 0, 0); PG8_LDB(B1, 0, 1); PG8_SCHED; PG8_LDA(At, 0, 0); PG8_STAGE(PG8_SA(1, 1), a1, cao[1]);
            PG8_WAIT_V(8); PG8_WAIT_L(0); PG8_BAR; PG8_MMA(0, 0, At, B0); PG8_MMA(0, 1, At, B1); PG8_BAR; PG8_SCHED;
            PG8_LDA(At, 0, 1); PG8_STAGE(PG8_SB(0, 0), b2, voffB); PG8_STAGE(PG8_SB(0, 1), b2 + bh, voffB); PG8_STAGE(PG8_SA(0, 0), a2, ao2[0]);
            PG8_WAIT_V(8); PG8_WAIT_L(0); PG8_BAR; PG8_MMA(1, 0, At, B0); PG8_MMA(1, 1, At, B1); PG8_BAR; PG8_SCHED;
            PG8_LDB(B0, 1, 0); PG8_LDB(B1, 1, 1); PG8_SCHED; PG8_LDA(At, 1, 0); PG8_STAGE(PG8_SA(0, 1), a2, ao2[1]);
            PG8_WAIT_V(8); PG8_WAIT_L(0); PG8_BAR; PG8_MMA(0, 0, At, B0); PG8_MMA(0, 1, At, B1); PG8_BAR; PG8_SCHED;
            PG8_LDA(At, 1, 1); PG8_STAGE(PG8_SB(1, 0), b3, voffB); PG8_STAGE(PG8_SB(1, 1), b3 + bh, voffB); PG8_STAGE(PG8_SA(1, 0), a3, ao2[0]);
            PG8_WAIT_V(8); PG8_WAIT_L(0); PG8_BAR; PG8_MMA(1, 0, At, B0); PG8_MMA(1, 1, At, B1); PG8_BAR; PG8_SCHED;
        }
        if constexpr (ALIGN_EPI) { if (wr == 0) PG8_BAR; }
        { int t2_ = tid; asm volatile("" : "+v"(t2_)); const int l2_ = t2_ & 63; E(acc, cur, wr, wc, l2_ & 15, l2_ >> 4); }
        if (!has_next) break;
#pragma unroll
        for (int a = 0; a < 2; ++a)
#pragma unroll
            for (int b = 0; b < 2; ++b)
#pragma unroll
                for (int m = 0; m < 4; ++m)
#pragma unroll
                    for (int n = 0; n < 2; ++n) acc[a][b][m][n] = (f32x4){0.f, 0.f, 0.f, 0.f};
        cur = nxt; cB = nB; ++ui;
        { const u32x4 v = *naol; cao[0][0] = v.x; cao[0][1] = v.y; cao[1][0] = v.z; cao[1][1] = v.w; }
        if constexpr (ALIGN_EPI) { if (wr == 1) PG8_BAR; }
    }
    PG8_WAIT_V(0);
    if constexpr (!ALIGN_EPI) { if (wr == 0) PG8_BAR; }
    PG8_BAR;
#undef PG8_SA
#undef PG8_SB
#undef PG8_STAGE
#undef PG8_LDA
#undef PG8_LDB
#undef PG8_MMA
#undef PG8_WAIT_V
#undef PG8_WAIT_L
#undef PG8_BAR
#undef PG8_SCHED
#undef PG8_AOFFS
#undef PG8_BKO
}
}

constexpr int BATCH = 16, SEQ = 2048, T = BATCH * SEQ, D = 1024, NIN = 2304, NL = 2;
constexpr int CC = 256, CP = 256, CA = 512, NH = 4, DH = 64, DV = 128, CW = 31;
constexpr int NE = 16, DE = 256, NBKT = 24;
constexpr float EPS = 1e-6f;
constexpr float QSCALE = 0.125f * 1.4426950408889634f;
constexpr int NWAVES = 8, NTHREADS = 512;

constexpr size_t MiB = 1u << 20, KiB = 1u << 10;
constexpr size_t WS_CTL = 0, CTL_ZERO_BYTES = 1 * MiB;
constexpr size_t WS_SS = 2 * MiB;
constexpr size_t WS_SS1 = 4 * MiB;
constexpr size_t WS_RS1 = 6 * MiB;
constexpr size_t WS_WTS = 6 * MiB + 256 * KiB;
constexpr size_t WS_TOKB = 6 * MiB + 512 * KiB;
constexpr size_t WS_LIST = 7 * MiB;
constexpr size_t WS_WR = 10 * MiB;
constexpr size_t WS_WPW = 10 * MiB + 512 * KiB;
constexpr size_t WS_WPOOL = 10 * MiB + 768 * KiB;
constexpr size_t WS_ERR = 11 * MiB;
constexpr size_t WS_WIN = 16 * MiB;
constexpr size_t WS_WOUT = 25 * MiB;
constexpr size_t WS_WGU = 29 * MiB;
constexpr size_t WS_WD = 61 * MiB;
constexpr size_t WS_XB = 80 * MiB;
constexpr size_t WS_X1B = 144 * MiB;
constexpr size_t WS_MIX = 208 * MiB;
constexpr size_t WS_U = 272 * MiB;
constexpr size_t WS_PIN = 288 * MiB;
constexpr size_t WS_Q = 304 * MiB;
constexpr size_t WS_K = 336 * MiB;
constexpr size_t WS_V = 368 * MiB;
constexpr size_t WS_ACT = 400 * MiB;
constexpr size_t WS_DBG = 440 * MiB;
constexpr size_t WS_END = 512 * MiB;
constexpr int CW_BAR = 4096;
constexpr int CW_CNT = 16384;
constexpr int RING_BYTES = 131072;
constexpr int MISC_OFF = RING_BYTES;
constexpr int LDS_EXTRA = RING_BYTES + 1024;
constexpr int LDS_BYTES = 163840;

#define LDS_WAIT() asm volatile("s_waitcnt lgkmcnt(0)" ::: "memory")
#define VM_WAIT() asm volatile("s_waitcnt vmcnt(0)" ::: "memory")

#define XB_TMO      128
#define XB_XCNT(j)  (256  + 64 * (j))
#define XB_XSUB(j)  (1280 + 64 * (j))
#define XB_XGEN(j)  (2304 + 64 * (j))
#define XB_TOP      3328
#define XB_TOPGEN   3392
#define XCD_BAR_WORDS 3456
#define XB_SPIN_CAP (1u << 22)
__device__ __forceinline__ unsigned xb_ld(unsigned* p)              { return __hip_atomic_load(p, __ATOMIC_RELAXED, __HIP_MEMORY_SCOPE_AGENT); }
__device__ __forceinline__ unsigned xb_add(unsigned* p, unsigned v) { return __hip_atomic_fetch_add(p, v, __ATOMIC_RELAXED, __HIP_MEMORY_SCOPE_AGENT); }
__device__ __forceinline__ unsigned xb_xcc_id() { return (unsigned)__builtin_amdgcn_s_getreg((3 << 11) | 20) & 0xFu; }
#define XB_SPIN(cond, bar) do { unsigned _sp = 0; while (cond) { __builtin_amdgcn_s_sleep(1); \
    if ((++_sp & 255u) == 0u) { if (xb_ld(&(bar)[XB_TMO])) break; if (_sp > XB_SPIN_CAP) { atomicAdd(&(bar)[XB_TMO], 1u); break; } } } } while (0)
struct XcdBarrier { unsigned* bar; unsigned x; volatile LAS unsigned* st; };
__device__ __forceinline__ XcdBarrier xcd_barrier_post(unsigned* bar, volatile LAS unsigned* st) {
    XcdBarrier b; b.bar = bar; b.x = xb_xcc_id(); b.st = st;
    if (threadIdx.x == 0) (void)xb_add(&bar[XB_XCNT(b.x)], 1u);
    return b;
}
__device__ __forceinline__ void xcd_barrier_complete(unsigned* bar, unsigned x, unsigned& nloc, unsigned& nx) {
    const unsigned G = gridDim.x * gridDim.y * gridDim.z;
    unsigned sum, cnt, mine, sp = 0u;
    for (;;) {
        sum = 0u; cnt = 0u; mine = 0u;
#pragma unroll
        for (unsigned j = 0; j < 16; ++j) { const unsigned c = xb_ld(&bar[XB_XCNT(j)]); sum += c; cnt += (c > 0u) ? 1u : 0u; mine = (j == x) ? c : mine; }
        if (sum == G) break;
        __builtin_amdgcn_s_sleep(1);
        if ((++sp & 255u) == 0u) { if (xb_ld(&bar[XB_TMO])) break; if (sp > XB_SPIN_CAP) { atomicAdd(&bar[XB_TMO], 1u); break; } }
    }
    nloc = mine > 0u ? mine : 1u; nx = cnt > 0u ? cnt : 1u;
}
__device__ __forceinline__ void xcd_barrier(const XcdBarrier& b) {
    asm volatile("s_waitcnt vmcnt(0)" ::: "memory");
    __syncthreads();
    if (threadIdx.x == 0) {
        unsigned* bar = b.bar;
        __builtin_amdgcn_s_waitcnt(0);
        unsigned nloc = b.st[0], nx = b.st[1];
        if (nloc == 0u) { xcd_barrier_complete(bar, b.x, nloc, nx); b.st[0] = nloc; b.st[1] = nx; }
        const unsigned old = xb_add(&bar[XB_XSUB(b.x)], 1u);
        const unsigned gen = old / nloc;
        if (old + 1u == (gen + 1u) * nloc) {
            __builtin_amdgcn_fence(__ATOMIC_RELEASE, "agent");
            asm volatile("s_waitcnt vmcnt(0)" ::: "memory");
            const unsigned og = xb_add(&bar[XB_TOP], 1u);
            const unsigned tg = og / nx;
            if (og + 1u == (tg + 1u) * nx) xb_add(&bar[XB_TOPGEN], 1u);
            else XB_SPIN(xb_ld(&bar[XB_TOPGEN]) == tg, bar);
            __builtin_amdgcn_fence(__ATOMIC_ACQUIRE, "agent");
            xb_add(&bar[XB_XGEN(b.x)], 1u);
            asm volatile("s_waitcnt vmcnt(0)" ::: "memory");
        } else {
            XB_SPIN(xb_ld(&bar[XB_XGEN(b.x)]) == gen, bar);
            __builtin_amdgcn_fence(__ATOMIC_ACQUIRE, "agent");
            asm volatile("s_waitcnt vmcnt(0)" ::: "memory");
        }
    }
    __syncthreads();
}

struct Args { const float* in[27]; float* out; unsigned char* ws; int ph_lo, ph_hi; };
enum { I_X = 0, I_ANG, I_WIN, I_CW, I_CB, I_CLG, I_CLB, I_CPW, I_CPB, I_PW, I_PS, I_QG, I_KG, I_LQ1, I_LK1, I_LQ2, I_LK2, I_ASG, I_WOUT, I_FNG, I_RGW, I_RGB, I_REW, I_REB, I_WG, I_WU, I_WDN };

struct Frame {
    LAS unsigned char* lds;
    int tid, lane, wave, vcu, G;
#ifdef PROBE_KIND
    unsigned long long pk_prev, pk_acc;
#endif
};
#ifdef PROBE_KIND
#define PK_SUB(F, kind) do { const unsigned long long t_ = __builtin_amdgcn_s_memrealtime(); if ((kind) == PROBE_KIND) (F).pk_acc += t_ - (F).pk_prev; (F).pk_prev = t_; } while (0)
#else
#define PK_SUB(F, kind) do { } while (0)
#endif

template <bool HASG> __device__ __forceinline__ void tr_item(const float* S, int ldS, int scol, int k0, const float* gk, bf16_t* Dst, int ldD, int prow0, LAS unsigned char* scr, int lane) {
    const float* sp = S + (size_t)k0 * ldS + scol;
    float v[64]; f32x4 g4[16];
    if (HASG) {
#pragma unroll
        for (int i = 0; i < 16; ++i) g4[i] = *(const f32x4*)(gk + k0 + 4 * i);
    }
#pragma unroll
    for (int i = 0; i < 64; ++i) v[i] = sp[(size_t)i * ldS];
    asm volatile("" ::: "memory");
    unsigned w[32];
#pragma unroll
    for (int i = 0; i < 32; ++i) { float a = v[2 * i], b = v[2 * i + 1]; if (HASG) { a *= g4[i >> 1][(2 * i) & 3]; b *= g4[i >> 1][(2 * i + 1) & 3]; } w[i] = pk2(a, b); }
#pragma unroll
    for (int j = 0; j < 8; ++j) *(LAS u32x4*)(scr + lane * 144 + j * 16) = (u32x4){w[4 * j], w[4 * j + 1], w[4 * j + 2], w[4 * j + 3]};
    LDS_WAIT(); asm volatile("" ::: "memory");
#pragma unroll
    for (int j = 0; j < 8; ++j) { const int r = 8 * j + (lane >> 3), c = lane & 7; const u32x4 v = *(const LAS u32x4*)(scr + r * 144 + c * 16);
        *(u32x4*)(Dst + (size_t)(prow0 + r) * ldD + k0 + 8 * c) = v; }
    LDS_WAIT(); asm volatile("" ::: "memory");
}
__device__ __forceinline__ int win_logical(int p0) {
    const int pn = p0 >> 8, c = p0 & 255;
    if (pn < 2) return (c < 128) ? (pn * 128 + c) : (256 + pn * 128 + (c - 128));
    if (pn == 2) return 512 + c;
    if (pn < 7) { const int bj = c >> 7, wc = (c >> 5) & 3; return 768 + (pn - 3) * 256 + 64 * wc + 32 * bj; }
    return 1792 + (pn - 7) * 256 + c;
}
__device__ __forceinline__ void p0_prologue(const Args& args, Frame& F) {
    unsigned char* ws = args.ws;
    const int gw = F.vcu * NWAVES + F.wave, NGW = F.G * NWAVES, lane = F.lane;
    LAS unsigned char* scr = F.lds + F.wave * 16384;
    constexpr int I_IN = 16 * 36, I_OUT = 16 * 16, I_GU = 16 * 8 * 16, I_DN = 4 * 16 * 16, I_PWI = 4 * 4, I_PL = 4;
    constexpr int PER_L = I_IN + I_OUT + I_GU + I_DN + I_PWI + I_PL;
    for (int it = gw; it < NL * PER_L; it += NGW) {
        const int itu = __builtin_amdgcn_readfirstlane(it); const int l = itu / PER_L; int r = itu % PER_L;
        if (r < I_IN) { const int kb = r / 36, pb = r % 36; const int p = pb * 64 + lane;
            tr_item<true>(args.in[I_WIN] + (size_t)l * D * NIN, NIN, win_logical(p & ~31) + (p & 31), kb * 64, args.in[I_ANG] + l * D, (bf16_t*)(ws + WS_WIN) + (size_t)l * NIN * D, D, pb * 64, scr, lane); continue; }
        r -= I_IN;
        if (r < I_OUT) { const int kb = r / 16, pb = r % 16; const int p = pb * 64 + lane;
            tr_item<false>(args.in[I_WOUT] + (size_t)l * D * D, D, p, kb * 64, nullptr, (bf16_t*)(ws + WS_WOUT) + (size_t)l * D * D, D, pb * 64, scr, lane); continue; }
        r -= I_OUT;
        if (r < I_GU) { const int e = r / 128, q = r % 128, kb = q / 8, pb = q % 8; const int p = pb * 64 + lane;
            const int half = p >> 8, gu = (p >> 7) & 1, i0 = p & 127; const float* src = (gu ? args.in[I_WU] : args.in[I_WG]) + (size_t)(l * NE + e) * D * DE;
            tr_item<true>(src, DE, half * 128 + i0, kb * 64, args.in[I_FNG] + l * D, (bf16_t*)(ws + WS_WGU) + (size_t)(l * NE + e) * 512 * D, D, pb * 64, scr, lane); continue; }
        r -= I_GU;
        if (r < I_DN) { const int e = r / 64, q = r % 64, kb = q / 16, pb = q % 16; const int p = pb * 64 + lane;
            tr_item<false>(args.in[I_WDN] + (size_t)(l * NE + e) * DE * D, D, p, kb * 64, nullptr, (bf16_t*)(ws + WS_WD) + (size_t)(l * NE + e) * D * DE, DE, pb * 64, scr, lane); continue; }
        r -= I_DN;
        if (r < I_PWI) { const int kb = r / 4, pb = r % 4; const int p = pb * 64 + lane;
            tr_item<false>(args.in[I_CPW] + (size_t)l * CC * CC, CC, p, kb * 64, nullptr, (bf16_t*)(ws + WS_WPW) + (size_t)l * CC * CC, CC, pb * 64, scr, lane); continue; }
        r -= I_PWI;
        { const int gi = r;
            tr_item<false>(args.in[I_PW] + (size_t)(l * 4 + gi) * 64 * 64, 64, lane, 0, nullptr, (bf16_t*)(ws + WS_WPOOL) + (size_t)(l * 4 + gi) * 64 * 64, 64, 0, scr, lane); }
    }
    PK_SUB(F, 7);
    for (int i = (F.vcu * NTHREADS + F.tid); i < NL * 32 * D; i += F.G * NTHREADS) {
        const int l = i / (32 * D), j = (i / D) % 32, k = i % D;
        float w = 0.f; if (j < 4) w = args.in[I_RGW][(size_t)(l * D + k) * 4 + j]; else if (j < 20) w = args.in[I_REW][(size_t)(l * D + k) * 16 + (j - 4)];
        w *= args.in[I_FNG][l * D + k];
        const unsigned h = f2bf(w); const unsigned lo = f2bf(w - bf2f(h));
        bf16_t* base = (bf16_t*)(ws + WS_WR) + (size_t)l * 2 * 32 * D;
        base[(size_t)j * D + k] = (bf16_t)h; base[(size_t)(32 + j) * D + k] = (bf16_t)lo;
    }
    PK_SUB(F, 8);
    for (int m0 = gw * 4; m0 < T; m0 += NGW * 4) {
        f32x4 v[4][4];
#pragma unroll
        for (int r = 0; r < 4; ++r) { const GAS f32x4* xr = (const GAS f32x4*)(args.in[I_X] + (size_t)(m0 + r) * D) + lane;
#pragma unroll
            for (int j = 0; j < 4; ++j) v[r][j] = xr[64 * j]; }
#pragma unroll
        for (int r = 0; r < 4; ++r) { const int m = m0 + r; GAS unsigned long long* o8 = (GAS unsigned long long*)((bf16_t*)(ws + WS_XB) + (size_t)m * D) + lane; float s = 0.f;
#pragma unroll
            for (int j = 0; j < 4; ++j) { const f32x4 x = v[r][j]; s += (x.x * x.x + x.y * x.y) + (x.z * x.z + x.w * x.w); o8[64 * j] = (unsigned long long)pk2(x.x, x.y) | ((unsigned long long)pk2(x.z, x.w) << 32); }
            s = wave_sum(s);
            if (lane < 16) ((float*)(ws + WS_SS))[(size_t)m * 16 + lane] = (lane == 0) ? s : 0.f; }
    }
}

struct DenseOrder {
    int nM, nN, nwg, G, c; const char* Bt; size_t btile;
    __device__ void init(int M, int N, int G_, int c_, const void* Bt_, int ldb) { nM = M / 256; nN = N / 256; nwg = nM * nN; G = G_; c = c_; Bt = (const char*)Bt_; btile = (size_t)256 * ldb * 2; }
    __device__ __forceinline__ bool next(int i, pg8::Unit& u) const {
        const long L = (long)i * G + c; if (L >= nwg) return false;
        int wgid = (int)L; { const int q = nwg / 8, r = nwg % 8, xcd = wgid % 8, off = wgid / 8; wgid = (xcd < r ? xcd * (q + 1) : r * (q + 1) + (xcd - r) * q) + off; }
        const int nig = 8 * nN, gid = wgid / nig, fm = gid * 8, gsz = (nM - fm) < 8 ? (nM - fm) : 8;
        u.pm = fm + ((wgid % nig) % gsz); u.pn = (wgid % nig) / gsz;
        u.bb = Bt + (size_t)u.pn * btile; u.bjump = 0; u.arow0 = u.pm * 256; u.acount = 256; u.aux = 0; return true;
    }
};
struct MoeOrder {
    const LAS int* ti; int G, c, l, mode; const char* W;
    __device__ __forceinline__ bool next(int i, pg8::Unit& u) const {
        const int NT = __builtin_amdgcn_readfirstlane(ti[0]); const int nwg = NT * 4;
        const long L = (long)i * G + c; if (L >= nwg) return false;
        int wgid = (int)L; { const int q = nwg / 8, r = nwg % 8, xcd = wgid % 8, off = wgid / 8; wgid = (xcd < r ? xcd * (q + 1) : r * (q + 1) + (xcd - r) * q) + off; }
        const int rt = wgid >> 2, pn = wgid & 3;
        const int inf = __builtin_amdgcn_readfirstlane(ti[2 + 2 * rt]); const int b = inf & 255, lt = inf >> 8;
        const int grp = b / 6, pi = b % 6;
        const int lo = (pi < 3) ? 0 : (pi < 5 ? 1 : 2), hi = (pi < 3) ? pi + 1 : (pi < 5 ? pi - 1 : 3);
        const int e0 = grp * 4 + lo, e1 = grp * 4 + hi;
        u.pm = rt; u.pn = pn; u.acount = __builtin_amdgcn_readfirstlane(ti[3 + 2 * rt]);
        if (mode == 1) { const int e = (pn < 2) ? e0 : e1; u.bb = W + ((size_t)(l * NE + e) * 512 + (size_t)(pn & 1) * 256) * D * 2; u.bjump = 0; u.arow0 = b * T + lt * 256; u.aux = b; }
        else { u.bb = W + ((size_t)(l * NE + e0) * D + (size_t)pn * 256) * DE * 2; u.bjump = (long)(e1 - e0) * D * DE * 2 - 4 * 128; u.arow0 = rt * 256; u.aux = b * T + lt * 256; }
        return true;
    }
};

__device__ __forceinline__ float sigmoidf_(float x) { return __frcp_rn(1.f + __expf(-x)); }
__device__ __forceinline__ float row_rstd16(const float* p) {
    const f32x4 a = ((const f32x4*)p)[0], b = ((const f32x4*)p)[1], c = ((const f32x4*)p)[2], d = ((const f32x4*)p)[3];
    const float s = ((a.x + a.y) + (a.z + a.w)) + ((b.x + b.y) + (b.z + b.w)) + ((c.x + c.y) + (c.z + c.w)) + ((d.x + d.y) + (d.z + d.w));
    return rsqrtf(s * (1.f / D) + EPS);
}
__device__ __forceinline__ u32x4 pack8(const f32x4 a, const f32x4 b) { u32x4 w; w.x = pg8::cvt_pk_bf16(a[0], a[1]); w.y = pg8::cvt_pk_bf16(a[2], a[3]); w.z = pg8::cvt_pk_bf16(b[0], b[1]); w.w = pg8::cvt_pk_bf16(b[2], b[3]); return w; }

struct EpiInProj {
    static constexpr bool PERM = true;
    const float* SS; bf16_t *U, *PIN, *Q, *Kb, *V; const float *qg, *kg;
    __device__ __forceinline__ void operator()(const f32x4 (&acc)[2][2][4][2], const pg8::Unit& u, int wr, int wc, int fr, int fq) const {
        const int row0 = u.pm * 256 + wr * 64 + fr, pn = u.pn;
        if (pn < 2) {
#pragma unroll
            for (int ai = 0; ai < 2; ++ai)
#pragma unroll
                for (int m = 0; m < 4; ++m) { const int row = row0 + ai * 128 + m * 16; const float rs = row_rstd16(SS + (size_t)row * 16);
                    f32x4 o[2];
#pragma unroll
                    for (int n = 0; n < 2; ++n) { const f32x4 v = acc[ai][0][m][n] * rs, g = acc[ai][1][m][n] * rs;
                        o[n] = (f32x4){v[0] * sigmoidf_(g[0]), v[1] * sigmoidf_(g[1]), v[2] * sigmoidf_(g[2]), v[3] * sigmoidf_(g[3])}; }
                    *(u32x4*)(U + (size_t)row * CC + pn * 128 + wc * 32 + 8 * fq) = pack8(o[0], o[1]); }
        } else if (pn == 2 || pn >= 7) {
            bf16_t* dst = (pn == 2) ? PIN : V; const int ld = (pn == 2) ? CP : CA; const int cb = (pn == 2) ? 0 : (pn - 7) * 256;
#pragma unroll
            for (int ai = 0; ai < 2; ++ai)
#pragma unroll
                for (int m = 0; m < 4; ++m) { const int row = row0 + ai * 128 + m * 16; const float rs = row_rstd16(SS + (size_t)row * 16);
#pragma unroll
                    for (int bj = 0; bj < 2; ++bj) *(u32x4*)(dst + (size_t)row * ld + cb + bj * 128 + wc * 32 + 8 * fq) = pack8(acc[ai][bj][m][0] * rs, acc[ai][bj][m][1] * rs); }
        } else {
            const bool isq = pn < 5; bf16_t* dst = isq ? Q : Kb; const float* gn = isq ? qg : kg; const int hs = (isq ? (pn - 3) : (pn - 5)) * 4 + wc;
            f32x4 gv[2][2];
#pragma unroll
            for (int bj = 0; bj < 2; ++bj)
#pragma unroll
                for (int n = 0; n < 2; ++n) gv[bj][n] = *(const f32x4*)(gn + 32 * bj + 8 * fq + 4 * n);
#pragma unroll
            for (int ai = 0; ai < 2; ++ai)
#pragma unroll
                for (int m = 0; m < 4; ++m) { const int row = row0 + ai * 128 + m * 16; const float rs = row_rstd16(SS + (size_t)row * 16);
                    f32x4 z[2][2]; float ss = 0.f;
#pragma unroll
                    for (int bj = 0; bj < 2; ++bj)
#pragma unroll
                        for (int n = 0; n < 2; ++n) { z[bj][n] = acc[ai][bj][m][n] * rs; const f32x4 q = z[bj][n] * z[bj][n]; ss += (q[0] + q[1]) + (q[2] + q[3]); }
                    ss += __shfl_xor(ss, 16); ss += __shfl_xor(ss, 32);
                    const float r = rsqrtf(ss * (1.f / DH) + EPS) * (isq ? QSCALE : 1.f);
#pragma unroll
                    for (int bj = 0; bj < 2; ++bj) *(u32x4*)(dst + (size_t)row * CA + hs * 64 + 32 * bj + 8 * fq) = pack8(z[bj][0] * r * gv[bj][0], z[bj][1] * r * gv[bj][1]); }
        }
    }
};

struct EpiOutProj {
    static constexpr bool PERM = false;
    const float* xin; float* out; bf16_t* X1B; float* SS1;
    __device__ __forceinline__ void operator()(const f32x4 (&acc)[2][2][4][2], const pg8::Unit& u, int wr, int wc, int fr, int fq) const {
        const int row0 = u.pm * 256 + wr * 64 + fr, col0 = u.pn * 256 + wc * 32 + 4 * fq;
#pragma unroll
        for (int ai = 0; ai < 2; ++ai)
#pragma unroll
            for (int m = 0; m < 4; ++m) { const int row = row0 + ai * 128 + m * 16; float ss = 0.f;
#pragma unroll
                for (int bj = 0; bj < 2; ++bj)
#pragma unroll
                    for (int n = 0; n < 2; ++n) { const size_t off = (size_t)row * D + col0 + bj * 128 + n * 16; const f32x4 x = *(const f32x4*)(xin + off) + acc[ai][bj][m][n];
                        *(f32x4*)(out + off) = x; const f32x4 q = x * x; ss += (q[0] + q[1]) + (q[2] + q[3]);
                        u32x2 w; w.x = pg8::cvt_pk_bf16(x[0], x[1]); w.y = pg8::cvt_pk_bf16(x[2], x[3]); *(u32x2*)(X1B + off) = w; }
                ss += __shfl_xor(ss, 16); ss += __shfl_xor(ss, 32);
                if (fq == 0) SS1[(size_t)row * 16 + u.pn * 4 + wc] = ss; }
    }
};

struct EpiMoe1 {
    static constexpr bool PERM = true;
    const int* LIST; const float* RS1; const float* WTS; bf16_t* ACT;
    __device__ __forceinline__ void operator()(const f32x4 (&acc)[2][2][4][2], const pg8::Unit& u, int wr, int wc, int fr, int fq) const {
        const int pn = u.pn;
#pragma unroll
        for (int ai = 0; ai < 2; ++ai)
#pragma unroll
            for (int m = 0; m < 4; ++m) { const int r = ai * 128 + wr * 64 + m * 16 + fr; const int tok = (r < u.acount) ? LIST[u.arow0 + r] : 0;
                const float rs = RS1[tok], w = WTS[tok * 2 + (pn >> 1)];
                f32x4 o[2];
#pragma unroll
                for (int n = 0; n < 2; ++n) { const f32x4 g = acc[ai][0][m][n] * rs, uu = acc[ai][1][m][n] * (rs * w);
                    o[n] = (f32x4){g[0] * sigmoidf_(g[0]) * uu[0], g[1] * sigmoidf_(g[1]) * uu[1], g[2] * sigmoidf_(g[2]) * uu[2], g[3] * sigmoidf_(g[3]) * uu[3]}; }
                *(u32x4*)(ACT + (size_t)(u.pm * 256 + r) * 512 + (pn >> 1) * 256 + (pn & 1) * 128 + wc * 32 + 8 * fq) = pack8(o[0], o[1]); }
    }
};

struct EpiMoe2 {
    static constexpr bool PERM = false;
    const int* LIST; float* out; bf16_t* XB; float* SS; int last;
    __device__ __forceinline__ void operator()(const f32x4 (&acc)[2][2][4][2], const pg8::Unit& u, int wr, int wc, int fr, int fq) const {
        const int col0 = u.pn * 256 + wc * 32 + 4 * fq;
#pragma unroll
        for (int ai = 0; ai < 2; ++ai)
#pragma unroll
            for (int m = 0; m < 4; ++m) { const int r = ai * 128 + wr * 64 + m * 16 + fr; const bool valid = r < u.acount; float ss = 0.f; int tok = 0;
                if (valid) { tok = LIST[u.aux + r];
#pragma unroll
                    for (int bj = 0; bj < 2; ++bj)
#pragma unroll
                        for (int n = 0; n < 2; ++n) { const size_t off = (size_t)tok * D + col0 + bj * 128 + n * 16; const f32x4 x = *(const f32x4*)(out + off) + acc[ai][bj][m][n];
                            *(f32x4*)(out + off) = x; const f32x4 q = x * x; ss += (q[0] + q[1]) + (q[2] + q[3]);
                            if (!last) { u32x2 w; w.x = pg8::cvt_pk_bf16(x[0], x[1]); w.y = pg8::cvt_pk_bf16(x[2], x[3]); *(u32x2*)(XB + off) = w; } } }
                ss += __shfl_xor(ss, 16); ss += __shfl_xor(ss, 32);
                if (valid && fq == 0 && !last) SS[(size_t)tok * 16 + u.pn * 4 + wc] = ss;
                asm volatile("" ::: "memory"); }
    }
};

__device__ __forceinline__ int crow(int r, int hi) { return (r & 3) + 8 * (r >> 2) + 4 * hi; }
typedef short v4i16_t __attribute__((ext_vector_type(4)));
__device__ __forceinline__ s16x4 vtr(const LAS unsigned char* p) { return __builtin_bit_cast(s16x4, __builtin_amdgcn_ds_read_tr16_b64_v4i16((LAS v4i16_t*)p)); }
constexpr int AT_K = 0, AT_V = 32768;

__device__ __forceinline__ void attn_unit(const Args& args, Frame& F, int l, int b, int h, int qb, float lam, float lam_init) {
    int tid = F.tid; asm volatile("" : "+v"(tid)); const int lane = tid & 63, wave = F.wave, r32 = lane & 31, hi = lane >> 5;
    const int mp = wave >> 2, rg = wave & 3;
    LAS unsigned char* lds = F.lds;
    const bf16_t* Qg = (const bf16_t*)(args.ws + WS_Q); const bf16_t* Kg = (const bf16_t*)(args.ws + WS_K); const bf16_t* Vg = (const bf16_t*)(args.ws + WS_V);
    bf16_t* MIX = (bf16_t*)(args.ws + WS_MIX);
    const int q0 = qb * 128, nt = 2 * qb + 2;
    const int qpos = q0 + 32 * rg + r32;
    const size_t rowb = (size_t)b * SEQ;
    const float slope = (h == 0) ? 0.25f : (h == 1) ? 0.0625f : (h == 2) ? 0.015625f : 0.00390625f;
    const float sl2 = slope * 1.4426950408889634f;
    int srow[2], sch[2]; unsigned kdst[2], vdst[2];
#pragma unroll
    for (int i = 0; i < 2; ++i) { const int c = tid + 512 * i; srow[i] = c >> 4; sch[i] = c & 15; const int row = srow[i], ch = sch[i];
        kdst[i] = (unsigned)(AT_K + (ch >> 3) * 8192 + row * 128 + (((ch & 7) ^ ((row >> 1) & 7)) << 4));
        vdst[i] = (unsigned)(AT_V + 256 * row + 16 * (ch ^ (((row & 3) << 2) | ((row >> 2) & 3)))); }
    u32x4 kst[2], vst[2];
#define AT_LOAD(j) do { _Pragma("unroll") for (int i = 0; i < 2; ++i) { const size_t g_ = ((rowb + (size_t)(j) * 64 + srow[i]) * CA + h * 128) * 2 + sch[i] * 16; \
        kst[i] = *(const u32x4*)((const char*)Kg + g_); vst[i] = *(const u32x4*)((const char*)Vg + g_); } } while (0)
#define AT_STORE(buf) do { _Pragma("unroll") for (int i = 0; i < 2; ++i) { *(LAS u32x4*)(lds + (buf) * 16384 + kdst[i]) = kst[i]; *(LAS u32x4*)(lds + (buf) * 16384 + vdst[i]) = vst[i]; } } while (0)
    AT_LOAD(0);
    bf16x8 qr[4];
    { const bf16_t* qp = Qg + (rowb + qpos) * CA + h * 128 + mp * 64 + 8 * hi;
#pragma unroll
      for (int ks = 0; ks < 4; ++ks) qr[ks] = *(const bf16x8*)(qp + 16 * ks); }
    f32x16 o[4];
#pragma unroll
    for (int d = 0; d < 4; ++d) o[d] = f32x16{};
    float m_run = -INFINITY, l_run = 0.f;
    unsigned vaddr[4][2];
#pragma unroll
    for (int db = 0; db < 4; ++db)
#pragma unroll
        for (int sub = 0; sub < 2; ++sub) { const int rb = 4 * hi + 8 * sub + ((lane & 15) >> 2); const int ch = 4 * db + 2 * ((lane >> 4) & 1) + ((lane >> 1) & 1); const int x = ((rb & 3) << 2) | ((rb >> 2) & 3);
            vaddr[db][sub] = (unsigned)(AT_V + 256 * rb + 16 * (ch ^ x) + 8 * (lane & 1)); }
    AT_STORE(0);
    __syncthreads();
    for (int j = 0; j < nt; ++j) {
        const int buf = j & 1;
        if (j + 1 < nt) AT_LOAD(j + 1);
        if (64 * j <= q0 + 32 * rg + 31) {
            const LAS unsigned char* KB = lds + buf * 16384 + AT_K + mp * 8192;
            f32x16 p0, p1;
            { const float base = sl2 * (float)(64 * j - qpos + 4 * hi);
#pragma unroll
              for (int r = 0; r < 16; ++r) { p0[r] = __builtin_fmaf(sl2, (float)((r & 3) + 8 * (r >> 2)), base); p1[r] = p0[r] + 32.f * sl2; } }
#pragma unroll
            for (int ks = 0; ks < 4; ++ks) { const int cc = 2 * ks + hi;
                const bf16x8 k0 = *(const LAS bf16x8*)(KB + r32 * 128 + ((cc ^ ((r32 >> 1) & 7)) << 4));
                const bf16x8 k1 = *(const LAS bf16x8*)(KB + (r32 + 32) * 128 + ((cc ^ (((r32 + 32) >> 1) & 7)) << 4));
                p0 = __builtin_amdgcn_mfma_f32_32x32x16_bf16(k0, qr[ks], p0, 0, 0, 0);
                p1 = __builtin_amdgcn_mfma_f32_32x32x16_bf16(k1, qr[ks], p1, 0, 0, 0); }
            if (64 * j + 63 > q0 + 32 * rg) {
#pragma unroll
                for (int r = 0; r < 16; ++r) { const int kv = 64 * j + crow(r, hi); if (kv > qpos) p0[r] = -INFINITY; if (kv + 32 > qpos) p1[r] = -INFINITY; }
            }
            float mx = fmaxf(p0[0], p1[0]);
#pragma unroll
            for (int r = 1; r < 16; ++r) mx = fmaxf(mx, fmaxf(p0[r], p1[r]));
            mx = fmaxf(mx, __shfl_xor(mx, 32));
            const float m_new = fmaxf(m_run, mx);
            const float alpha = __builtin_amdgcn_exp2f(m_run - m_new);
            m_run = m_new;
            float rsum = 0.f;
#pragma unroll
            for (int r = 0; r < 16; ++r) { p0[r] = __builtin_amdgcn_exp2f(p0[r] - m_new); p1[r] = __builtin_amdgcn_exp2f(p1[r] - m_new); rsum += p0[r] + p1[r]; }
            l_run = l_run * alpha + rsum;
#pragma unroll
            for (int d = 0; d < 4; ++d)
#pragma unroll
                for (int r = 0; r < 16; ++r) o[d][r] *= alpha;
            bf16x8 pb[4];
            { u32x4 w;
              w.x = pg8::cvt_pk_bf16(p0[0], p0[1]); w.y = pg8::cvt_pk_bf16(p0[2], p0[3]); w.z = pg8::cvt_pk_bf16(p0[4], p0[5]); w.w = pg8::cvt_pk_bf16(p0[6], p0[7]); pb[0] = __builtin_bit_cast(bf16x8, w);
              w.x = pg8::cvt_pk_bf16(p0[8], p0[9]); w.y = pg8::cvt_pk_bf16(p0[10], p0[11]); w.z = pg8::cvt_pk_bf16(p0[12], p0[13]); w.w = pg8::cvt_pk_bf16(p0[14], p0[15]); pb[1] = __builtin_bit_cast(bf16x8, w);
              w.x = pg8::cvt_pk_bf16(p1[0], p1[1]); w.y = pg8::cvt_pk_bf16(p1[2], p1[3]); w.z = pg8::cvt_pk_bf16(p1[4], p1[5]); w.w = pg8::cvt_pk_bf16(p1[6], p1[7]); pb[2] = __builtin_bit_cast(bf16x8, w);
              w.x = pg8::cvt_pk_bf16(p1[8], p1[9]); w.y = pg8::cvt_pk_bf16(p1[10], p1[11]); w.z = pg8::cvt_pk_bf16(p1[12], p1[13]); w.w = pg8::cvt_pk_bf16(p1[14], p1[15]); pb[3] = __builtin_bit_cast(bf16x8, w); }
            const LAS unsigned char* VB = lds + buf * 16384;
#pragma unroll
            for (int db = 0; db < 4; ++db)
#pragma unroll
                for (int ks = 0; ks < 4; ++ks) { const s16x4 lo = vtr(VB + vaddr[db][0] + ks * 4096), h4 = vtr(VB + vaddr[db][1] + ks * 4096);
                    const bf16x8 vf = (bf16x8){lo[0], lo[1], lo[2], lo[3], h4[0], h4[1], h4[2], h4[3]};
                    o[db] = __builtin_amdgcn_mfma_f32_32x32x16_bf16(vf, pb[ks], o[db], 0, 0, 0); }
        }
        if (j + 1 < nt) AT_STORE(buf ^ 1);
        __syncthreads();
    }
#undef AT_LOAD
#undef AT_STORE
    l_run += __shfl_xor(l_run, 32);
    const float inv = 1.f / l_run;
    LAS float* X = (LAS float*)lds + rg * 4096;
    if (mp == 1) { const float f = lam * inv;
#pragma unroll
        for (int db = 0; db < 4; ++db)
#pragma unroll
            for (int r = 0; r < 16; ++r) X[(32 * db + crow(r, hi)) * 32 + r32] = o[db][r] * f; }
    __syncthreads();
    if (mp == 0) { float ss = 0.f;
#pragma unroll
        for (int db = 0; db < 4; ++db)
#pragma unroll
            for (int r = 0; r < 16; ++r) { const float v = o[db][r] * inv - X[(32 * db + crow(r, hi)) * 32 + r32]; o[db][r] = v; ss += v * v; }
        ss += __shfl_xor(ss, 32);
        const float rn = rsqrtf(ss * (1.f / DV) + EPS) * (1.f - lam_init);
        const float* gs = args.in[I_ASG] + l * DV;
        bf16_t* orow = MIX + (rowb + qpos) * D + 512 + h * 128;
#pragma unroll
        for (int db = 0; db < 4; ++db)
#pragma unroll
            for (int rr = 0; rr < 4; ++rr) { const int d0 = 32 * db + 8 * rr + 4 * hi; const f32x4 g = *(const f32x4*)(gs + d0);
                u32x2 w; w.x = pg8::cvt_pk_bf16(o[db][4 * rr] * rn * g[0], o[db][4 * rr + 1] * rn * g[1]); w.y = pg8::cvt_pk_bf16(o[db][4 * rr + 2] * rn * g[2], o[db][4 * rr + 3] * rn * g[3]);
                *(u32x2*)(orow + d0) = w; } }
    __syncthreads();
}

constexpr int LM_UH = 0, LM_Y = 49152, LM_A = 0, LM_PH = 49152, LM_D = 0;
__device__ __forceinline__ void local_unit(const Args& args, Frame& F, int l, int tile) {
    int tid = F.tid; asm volatile("" : "+v"(tid)); int lane = tid & 63; const int wave = F.wave;
#define LM_RELAUNDER() do { asm volatile("" : "+v"(tid)); lane = tid & 63; } while (0)
    LAS unsigned char* lds = F.lds;
    const int b = tile / 32, t0 = (tile % 32) * 64; const size_t row0 = (size_t)b * SEQ + t0;
    const bf16_t* U = (const bf16_t*)(args.ws + WS_U); const bf16_t* PIN = (const bf16_t*)(args.ws + WS_PIN); bf16_t* MIX = (bf16_t*)(args.ws + WS_MIX);
    u32x4 hu[6], hp[5];
#pragma unroll
    for (int q = 0; q < 6; ++q) { const int c = tid + q * NTHREADS; const int i = c >> 5, ch = c & 31; const int t = t0 - 30 + i;
        hu[q] = (u32x4){0u, 0u, 0u, 0u}; if (c < 94 * 32 && t >= 0) hu[q] = *(const u32x4*)(U + ((size_t)b * SEQ + t) * CC + ch * 8); }
#pragma unroll
    for (int q = 0; q < 5; ++q) { const int c = tid + q * NTHREADS; const int i = c >> 5, ch = c & 31; const int t = t0 - 15 + i;
        hp[q] = (u32x4){0u, 0u, 0u, 0u}; if (c < 79 * 32 && t >= 0) hp[q] = *(const u32x4*)(PIN + ((size_t)b * SEQ + t) * CP + ch * 8); }
#pragma unroll
    for (int q = 0; q < 6; ++q) { const int c = tid + q * NTHREADS; const int i = c >> 5, ch = c & 31; if (c < 94 * 32) *(LAS u32x4*)(lds + LM_UH + i * 512 + ch * 16) = hu[q]; }
    LM_RELAUNDER();
    int c2 = tid & 127, tg = tid >> 7;
    float w0[CW], w1[CW];
#pragma unroll
    for (int j = 0; j < CW; ++j) { const f32x2 w = *(const f32x2*)(args.in[I_CW] + (size_t)(l * CW + j) * CC + 2 * c2); w0[j] = w.x; w1[j] = w.y; }
    float y0[16], y1[16];
    { const f32x2 bb = *(const f32x2*)(args.in[I_CB] + l * CC + 2 * c2);
#pragma unroll
      for (int k = 0; k < 16; ++k) { y0[k] = bb.x; y1[k] = bb.y; } }
    __syncthreads();
#pragma unroll
    for (int ii = 0; ii < 46; ++ii) { const unsigned uu = *(const LAS unsigned*)(lds + LM_UH + (16 * tg + ii) * 512 + c2 * 4); const float u0 = bf2f(uu & 0xffffu), u1 = bf2f(uu >> 16);
#pragma unroll
        for (int k = 0; k < 16; ++k) if (ii - k >= 0 && ii - k <= 30) { y0[k] += w0[ii - k] * u0; y1[k] += w1[ii - k] * u1; } }
#pragma unroll
    for (int k = 0; k < 16; ++k) *(LAS f32x2*)(lds + LM_Y + ((16 * tg + k) * 256 + 2 * c2) * 4) = (f32x2){y0[k], y1[k]};
    bf16x8 pwb[2][8];
    { const bf16_t* Wp = (const bf16_t*)(args.ws + WS_WPW) + (size_t)l * CC * CC;
#pragma unroll
      for (int nf = 0; nf < 2; ++nf)
#pragma unroll
          for (int ks = 0; ks < 8; ++ks) pwb[nf][ks] = *(const bf16x8*)(Wp + (size_t)(32 * wave + 16 * nf + (lane & 15)) * CC + 32 * ks + 8 * (lane >> 4)); }
    __syncthreads();
    PK_SUB(F, 20);
    LM_RELAUNDER();
    { const f32x4 lg = *(const f32x4*)(args.in[I_CLG] + l * CC + 4 * lane), lb = *(const f32x4*)(args.in[I_CLB] + l * CC + 4 * lane);
#pragma unroll 2
      for (int i = 0; i < 8; ++i) { const int row = wave * 8 + i; const f32x4 x = *(const LAS f32x4*)(lds + LM_Y + (row * 256 + 4 * lane) * 4);
        const float mean = wave_sum((x[0] + x[1]) + (x[2] + x[3])) * (1.f / CC); const f32x4 dx = x - mean;
        const float var = wave_sum((dx[0] * dx[0] + dx[1] * dx[1]) + (dx[2] * dx[2] + dx[3] * dx[3])) * (1.f / CC); const float rstd = rsqrtf(var + EPS);
        f32x4 yv = dx * rstd * lg + lb; yv = (f32x4){yv[0] * sigmoidf_(yv[0]), yv[1] * sigmoidf_(yv[1]), yv[2] * sigmoidf_(yv[2]), yv[3] * sigmoidf_(yv[3])};
        u32x2 w; w.x = pg8::cvt_pk_bf16(yv[0], yv[1]); w.y = pg8::cvt_pk_bf16(yv[2], yv[3]);
        *(LAS u32x2*)(lds + LM_A + row * 512 + (((lane >> 1) ^ (row & 15)) << 4) + 8 * (lane & 1)) = w; } }
    __syncthreads();
    PK_SUB(F, 21);
    LM_RELAUNDER();
    { const int fr = lane & 15, fq = lane >> 4;
      f32x4 acc[4][2];
#pragma unroll
      for (int mf = 0; mf < 4; ++mf)
#pragma unroll
          for (int nf = 0; nf < 2; ++nf) acc[mf][nf] = (f32x4){0.f, 0.f, 0.f, 0.f};
#pragma unroll
      for (int ks = 0; ks < 8; ++ks) {
          bf16x8 af[4];
#pragma unroll
          for (int mf = 0; mf < 4; ++mf) { const int arow = 16 * mf + fr; af[mf] = *(const LAS bf16x8*)(lds + LM_A + arow * 512 + (((4 * ks + fq) ^ (arow & 15)) << 4)); }
#pragma unroll
          for (int mf = 0; mf < 4; ++mf)
#pragma unroll
              for (int nf = 0; nf < 2; ++nf) acc[mf][nf] = __builtin_amdgcn_mfma_f32_16x16x32_bf16(pwb[nf][ks], af[mf], acc[mf][nf], 0, 0, 0);
      }
      const float* bp = args.in[I_CPB] + l * CC;
#pragma unroll
      for (int nf = 0; nf < 2; ++nf) { const int n0 = 32 * wave + 16 * nf + 4 * fq; const f32x4 bv = *(const f32x4*)(bp + n0);
#pragma unroll
          for (int mf = 0; mf < 4; ++mf) { const f32x4 a = acc[mf][nf] + bv; u32x2 w; w.x = pg8::cvt_pk_bf16(a[0], a[1]); w.y = pg8::cvt_pk_bf16(a[2], a[3]);
              *(u32x2*)(MIX + (row0 + 16 * mf + fr) * D + n0) = w; } }
    }
    PK_SUB(F, 22);
#pragma unroll
    for (int q = 0; q < 5; ++q) { const int c = tid + q * NTHREADS; const int i = c >> 5, ch = c & 31; if (c < 79 * 32) *(LAS u32x4*)(lds + LM_PH + i * 512 + ch * 16) = hp[q]; }
    __syncthreads();
    bf16x8 plb[4][2];
    { const bf16_t* Wq = (const bf16_t*)(args.ws + WS_WPOOL) + (size_t)(l * 4 + (wave >> 1)) * 64 * 64;
#pragma unroll
      for (int nf = 0; nf < 4; ++nf)
#pragma unroll
          for (int ks = 0; ks < 2; ++ks) plb[nf][ks] = *(const bf16x8*)(Wq + (size_t)(16 * nf + (lane & 15)) * 64 + 32 * ks + 8 * (lane >> 4)); }
    LM_RELAUNDER(); c2 = tid & 127; tg = tid >> 7;
    { const int gi = c2 >> 5, win = 2 << gi; const int r0 = 15 + 16 * tg;
      float s0 = 0.f, s1 = 0.f;
      for (int i = r0 - win + 1; i < r0; ++i) { const unsigned uu = *(const LAS unsigned*)(lds + LM_PH + i * 512 + c2 * 4); s0 += bf2f(uu & 0xffffu); s1 += bf2f(uu >> 16); }
#pragma unroll
      for (int k = 0; k < 16; ++k) { const unsigned uu = *(const LAS unsigned*)(lds + LM_PH + (r0 + k) * 512 + c2 * 4); const float u0 = bf2f(uu & 0xffffu), u1 = bf2f(uu >> 16);
        s0 += u0; s1 += u1; const int tpos = t0 + 16 * tg + k; const float cnt = (float)((tpos + 1 < win) ? (tpos + 1) : win); const float ic = 1.f / cnt;
        const int row = 16 * tg + k;
        *(LAS unsigned*)(lds + LM_D + row * 512 + (((c2 >> 2) ^ (row & 15)) << 4) + 4 * (c2 & 3)) = pg8::cvt_pk_bf16(s0 * ic - u0, s1 * ic - u1);
        const unsigned ul = *(const LAS unsigned*)(lds + LM_PH + (r0 + k - win + 1) * 512 + c2 * 4); s0 -= bf2f(ul & 0xffffu); s1 -= bf2f(ul >> 16); } }
    __syncthreads();
    PK_SUB(F, 23);
    LM_RELAUNDER();
    { const int gi = wave >> 1, fr = lane & 15, fq = lane >> 4;
      const float* sc = args.in[I_PS] + l * CP + 64 * gi;
#pragma unroll
      for (int mf = 0; mf < 2; ++mf) { const int arow = 32 * (wave & 1) + 16 * mf + fr;
        bf16x8 af[2];
#pragma unroll
        for (int ks = 0; ks < 2; ++ks) af[ks] = *(const LAS bf16x8*)(lds + LM_D + arow * 512 + (((8 * gi + 4 * ks + fq) ^ (arow & 15)) << 4));
#pragma unroll
        for (int nf = 0; nf < 4; ++nf) { f32x4 acc = (f32x4){0.f, 0.f, 0.f, 0.f};
#pragma unroll
            for (int ks = 0; ks < 2; ++ks) acc = __builtin_amdgcn_mfma_f32_16x16x32_bf16(plb[nf][ks], af[ks], acc, 0, 0, 0);
            const int d0 = 16 * nf + 4 * fq; const f32x4 sv = *(const f32x4*)(sc + d0); acc = acc * sv;
            u32x2 w; w.x = pg8::cvt_pk_bf16(acc[0], acc[1]); w.y = pg8::cvt_pk_bf16(acc[2], acc[3]);
            *(u32x2*)(MIX + (row0 + arow) * D + 256 + 64 * gi + d0) = w; } } }
    __syncthreads();
    PK_SUB(F, 24);
#undef LM_RELAUNDER
}

__device__ __forceinline__ void router_phase(const Args& args, Frame& F, int l) {
    const int tid = F.tid, lane = F.lane, wave = F.wave, fr = lane & 15, fq = lane >> 4;
    LAS unsigned char* lds = F.lds;
    LAS float* lgs = (LAS float*)lds + wave * (16 * 24);
    LAS int* bk = (LAS int*)(lds + 16384);
    LAS int* base = (LAS int*)(lds + 16384 + 512);
    const bf16_t* WRh = (const bf16_t*)(args.ws + WS_WR) + (size_t)l * 2 * 32 * D; const bf16_t* WRl = WRh + 32 * D;
    const float* X1 = args.out; const float* SS1 = (const float*)(args.ws + WS_SS1);
    float* RS1 = (float*)(args.ws + WS_RS1); float* WTS = (float*)(args.ws + WS_WTS); int* TOKB = (int*)(args.ws + WS_TOKB); int* LIST = (int*)(args.ws + WS_LIST);
    unsigned* gcnt = (unsigned*)(args.ws + WS_CTL) + CW_CNT + l * 64;
    const float* bgp = args.in[I_RGB] + l * 4; const float* bep = args.in[I_REB] + l * 16;
    for (int blk = F.vcu; blk < T / 128; blk += F.G) {
        const int row = blk * 128 + wave * 16 + fr;
        const float* xp = X1 + (size_t)row * D + 8 * fq;
        f32x4 acc0 = (f32x4){0.f, 0.f, 0.f, 0.f}, acc1 = acc0;
#pragma unroll 4
        for (int ks = 0; ks < 32; ++ks) {
            const f32x4 xa = *(const f32x4*)(xp + 32 * ks), xb = *(const f32x4*)(xp + 32 * ks + 4);
            u32x4 h; h.x = pg8::cvt_pk_bf16(xa[0], xa[1]); h.y = pg8::cvt_pk_bf16(xa[2], xa[3]); h.z = pg8::cvt_pk_bf16(xb[0], xb[1]); h.w = pg8::cvt_pk_bf16(xb[2], xb[3]);
            u32x4 lo;
            lo.x = pg8::cvt_pk_bf16(xa[0] - bf2f(h.x & 0xffffu), xa[1] - __uint_as_float(h.x & 0xffff0000u)); lo.y = pg8::cvt_pk_bf16(xa[2] - bf2f(h.y & 0xffffu), xa[3] - __uint_as_float(h.y & 0xffff0000u));
            lo.z = pg8::cvt_pk_bf16(xb[0] - bf2f(h.z & 0xffffu), xb[1] - __uint_as_float(h.z & 0xffff0000u)); lo.w = pg8::cvt_pk_bf16(xb[2] - bf2f(h.w & 0xffffu), xb[3] - __uint_as_float(h.w & 0xffff0000u));
            const bf16x8 xh = __builtin_bit_cast(bf16x8, h), xl = __builtin_bit_cast(bf16x8, lo);
            const size_t wo = (size_t)fr * D + 32 * ks + 8 * fq;
            const bf16x8 wh0 = *(const bf16x8*)(WRh + wo), wl0 = *(const bf16x8*)(WRl + wo), wh1 = *(const bf16x8*)(WRh + 16 * D + wo), wl1 = *(const bf16x8*)(WRl + 16 * D + wo);
            acc0 = __builtin_amdgcn_mfma_f32_16x16x32_bf16(wl0, xl, acc0, 0, 0, 0); acc0 = __builtin_amdgcn_mfma_f32_16x16x32_bf16(wl0, xh, acc0, 0, 0, 0);
            acc0 = __builtin_amdgcn_mfma_f32_16x16x32_bf16(wh0, xl, acc0, 0, 0, 0); acc0 = __builtin_amdgcn_mfma_f32_16x16x32_bf16(wh0, xh, acc0, 0, 0, 0);
            acc1 = __builtin_amdgcn_mfma_f32_16x16x32_bf16(wl1, xl, acc1, 0, 0, 0); acc1 = __builtin_amdgcn_mfma_f32_16x16x32_bf16(wl1, xh, acc1, 0, 0, 0);
            acc1 = __builtin_amdgcn_mfma_f32_16x16x32_bf16(wh1, xl, acc1, 0, 0, 0); acc1 = __builtin_amdgcn_mfma_f32_16x16x32_bf16(wh1, xh, acc1, 0, 0, 0);
        }
        *(LAS f32x4*)(lgs + fr * 24 + 4 * fq) = acc0; if (fq == 0) *(LAS f32x4*)(lgs + fr * 24 + 16) = acc1;
        LDS_WAIT(); asm volatile("" ::: "memory");
        if (lane < 16) {
            const float rstd = row_rstd16(SS1 + (size_t)row * 16);
            float lg[20];
#pragma unroll
            for (int q = 0; q < 5; ++q) { const f32x4 v = *(const LAS f32x4*)(lgs + lane * 24 + 4 * q); lg[4 * q] = v[0] * rstd; lg[4 * q + 1] = v[1] * rstd; lg[4 * q + 2] = v[2] * rstd; lg[4 * q + 3] = v[3] * rstd; }
            float g4[4];
#pragma unroll
            for (int j = 0; j < 4; ++j) g4[j] = lg[j] + bgp[j];
            int gidx = 0; float gm = g4[0];
#pragma unroll
            for (int j = 1; j < 4; ++j) if (g4[j] > gm) { gm = g4[j]; gidx = j; }
            float gs = 0.f;
#pragma unroll
            for (int j = 0; j < 4; ++j) gs += __expf(g4[j] - gm);
            const float gp = 1.f / gs;
            float le[4];
#pragma unroll
            for (int j = 0; j < 4; ++j) { const float v = (gidx == 0) ? lg[4 + j] : (gidx == 1) ? lg[8 + j] : (gidx == 2) ? lg[12 + j] : lg[16 + j];
                const float bb = (gidx == 0) ? bep[j] : (gidx == 1) ? bep[4 + j] : (gidx == 2) ? bep[8 + j] : bep[12 + j]; le[j] = v + bb; }
            int ia = 0; float la = le[0];
#pragma unroll
            for (int j = 1; j < 4; ++j) if (le[j] > la) { la = le[j]; ia = j; }
            int ib = -1; float lb = -INFINITY;
#pragma unroll
            for (int j = 0; j < 4; ++j) if (j != ia && le[j] > lb) { lb = le[j]; ib = j; }
            const float pa = 1.f / (1.f + __expf(lb - la)), pbv = 1.f - pa;
            const float wa = gp * pa, wb = gp * pbv;
            const int lo2 = ia < ib ? ia : ib, hi2 = ia < ib ? ib : ia; const float wlo = ia < ib ? wa : wb, whi = ia < ib ? wb : wa;
            const int pi = (lo2 == 0) ? (hi2 - 1) : (lo2 == 1) ? (hi2 + 1) : 5;
            RS1[row] = rstd; WTS[row * 2] = wlo; WTS[row * 2 + 1] = whi; bk[wave * 16 + lane] = gidx * 6 + pi;
        }
        __syncthreads();
        int mybk = 0, lpos = 0;
        if (tid < 128) { mybk = bk[tid]; for (int r = 0; r < tid; ++r) lpos += (bk[r] == mybk) ? 1 : 0; }
        if (tid >= 128 && tid < 128 + NBKT) { const int bq = tid - 128; int c = 0; for (int r = 0; r < 128; ++r) c += (bk[r] == bq) ? 1 : 0;
            base[bq] = (int)__hip_atomic_fetch_add(gcnt + bq, (unsigned)c, __ATOMIC_RELAXED, __HIP_MEMORY_SCOPE_AGENT); }
        __syncthreads();
        if (tid < 128) { const int r2 = blk * 128 + tid; const int pos = base[mybk] + lpos; LIST[(size_t)mybk * T + pos] = r2; TOKB[r2 * 2] = mybk; TOKB[r2 * 2 + 1] = pos; }
        __syncthreads();
    }
}

constexpr int N_PHASES = 1 + 6 * NL;
__global__ void __launch_bounds__(NTHREADS, 2) mega_fwd(Args args) {
    extern __shared__ __attribute__((aligned(16))) unsigned char lds_[];
    Frame F;
    F.lds = (LAS unsigned char*)lds_;
    F.tid = threadIdx.x; F.lane = F.tid & 63; F.wave = __builtin_amdgcn_readfirstlane(F.tid >> 6);
    F.G = gridDim.x; { const int bx = blockIdx.x; F.vcu = (F.G % 8 == 0) ? (bx % 8) * (F.G / 8) + bx / 8 : bx; }
    volatile LAS unsigned* MISC = (volatile LAS unsigned*)(F.lds + MISC_OFF);
    for (int u = F.tid; u < 256; u += NTHREADS) MISC[u] = 0u;
    __syncthreads();
    unsigned char* ws = args.ws;
    unsigned* ctl = (unsigned*)(ws + WS_CTL);
    const int lo = args.ph_lo, hi = args.ph_hi;
    XcdBarrier bar; bar.bar = ctl + CW_BAR; bar.x = 0; bar.st = nullptr;
    if (hi - lo > 1) bar = xcd_barrier_post(ctl + CW_BAR, MISC + 8);
#ifdef ONLY_KIND
#define IN(k) ((((k)==0?0:(((k)-1)%6)+1))==ONLY_KIND && lo <= (k) && (k) < hi)
#else
#define IN(k) (lo <= (k) && (k) < hi)
#endif
#ifdef PROBE_KIND
    F.pk_prev = __builtin_amdgcn_s_memrealtime(); F.pk_acc = 0ull;
#define PK_STAMP(k) do { const unsigned long long t_ = __builtin_amdgcn_s_memrealtime(); if ((((k) == 0) ? 0 : ((((k) - 1) % 6) + 1)) == PROBE_KIND) F.pk_acc += t_ - F.pk_prev; F.pk_prev = t_; } while (0)
#else
#define PK_STAMP(k) do { } while (0)
#endif
#define SEAM(k) do { if (IN(k) && IN((k) + 1)) xcd_barrier(bar); PK_STAMP(k); } while (0)
#define RELAUNDER() do { int t_ = threadIdx.x; asm volatile("" : "+v"(t_)); F.tid = t_; F.lane = t_ & 63; } while (0)
    if (IN(0)) { p0_prologue(args, F); SEAM(0); }
    for (int l = 0; l < NL; ++l) {
        const int pb = 1 + 6 * l;
        const float* xin = (l == 0) ? args.in[I_X] : args.out;
        if (IN(pb)) { RELAUNDER();
            pg8::Gemm g{(const char*)(ws + WS_XB), D, nullptr, D, D, 1 << 30};
            DenseOrder S; S.init(T, NIN, F.G, (int)blockIdx.x, (const bf16_t*)(ws + WS_WIN) + (size_t)l * NIN * D, D);
            EpiInProj E{(const float*)(ws + WS_SS), (bf16_t*)(ws + WS_U), (bf16_t*)(ws + WS_PIN), (bf16_t*)(ws + WS_Q), (bf16_t*)(ws + WS_K), (bf16_t*)(ws + WS_V), args.in[I_QG] + l * DH, args.in[I_KG] + l * DH};
            pg8::gemm_phase<EpiInProj, DenseOrder, true>(F.lds, g, S, E, F.tid);
            SEAM(pb);
        }
        if (IN(pb + 1)) { RELAUNDER(); PK_SUB(F, 11);
            const float lam_init = 0.8f - 0.6f * expf(-0.3f * (float)l);
            float lam;
            { const float a = args.in[I_LQ1][l * DH + F.lane] * args.in[I_LK1][l * DH + F.lane], b2 = args.in[I_LQ2][l * DH + F.lane] * args.in[I_LK2][l * DH + F.lane];
              lam = expf(wave_sum(a)) - expf(wave_sum(b2)) + lam_init; }
            for (int v = F.vcu; v < 256; v += F.G) {
                const int bh = v >> 2, s = v & 3;
                for (int i = 0; i < 4; ++i) { const int qb = (i == 0) ? (15 - s) : (i == 1) ? (8 + s) : (i == 2) ? (7 - s) : s;
                    attn_unit(args, F, l, bh >> 2, bh & 3, qb, lam, lam_init); }
            }
            PK_SUB(F, 9);
            for (int tl = F.vcu; tl < T / 64; tl += F.G) local_unit(args, F, l, tl);
            PK_SUB(F, 10);
            SEAM(pb + 1);
        }
        if (IN(pb + 2)) { RELAUNDER();
            pg8::Gemm g{(const char*)(ws + WS_MIX), D, nullptr, D, D, 1 << 30};
            DenseOrder S; S.init(T, D, F.G, (int)blockIdx.x, (const bf16_t*)(ws + WS_WOUT) + (size_t)l * D * D, D);
            EpiOutProj E{xin, args.out, (bf16_t*)(ws + WS_X1B), (float*)(ws + WS_SS1)};
            pg8::gemm_phase<EpiOutProj, DenseOrder, true>(F.lds, g, S, E, F.tid);
            SEAM(pb + 2);
        }
        if (IN(pb + 3)) { RELAUNDER(); router_phase(args, F, l); SEAM(pb + 3); }
        if (IN(pb + 4) || IN(pb + 5)) { RELAUNDER();
            LAS int* ti = (LAS int*)(F.lds + LDS_EXTRA + 8192);
            LAS int* tb = ti + 512;
            const unsigned* gc = ctl + CW_CNT + l * 64;
            if (F.tid == 0) { int a = 0; for (int b = 0; b < NBKT; ++b) { const int c = (int)__hip_atomic_load(gc + b, __ATOMIC_RELAXED, __HIP_MEMORY_SCOPE_AGENT); tb[b] = a; a += (c + 255) >> 8; } tb[NBKT] = a; ti[0] = a; }
            __syncthreads();
            if (F.tid < NBKT) { const int b = F.tid; const int c = (int)__hip_atomic_load(gc + b, __ATOMIC_RELAXED, __HIP_MEMORY_SCOPE_AGENT); const int t0 = tb[b], n = tb[b + 1] - t0;
                for (int lt = 0; lt < n; ++lt) { ti[2 + 2 * (t0 + lt)] = b | (lt << 8); ti[3 + 2 * (t0 + lt)] = (c - lt * 256) < 256 ? (c - lt * 256) : 256; } }
            __syncthreads();
            if (IN(pb + 4)) { RELAUNDER();
                pg8::Gemm g{(const char*)(ws + WS_X1B), D, (const int*)(ws + WS_LIST), D, D, 1 << 30};
                MoeOrder S{ti, F.G, (int)blockIdx.x, l, 1, (const char*)(ws + WS_WGU)};
                EpiMoe1 E{(const int*)(ws + WS_LIST), (const float*)(ws + WS_RS1), (const float*)(ws + WS_WTS), (bf16_t*)(ws + WS_ACT)};
                pg8::gemm_phase<EpiMoe1, MoeOrder, true>(F.lds, g, S, E, F.tid);
                SEAM(pb + 4);
            }
            if (IN(pb + 5)) { RELAUNDER();
                pg8::Gemm g{(const char*)(ws + WS_ACT), 512, nullptr, DE, 512, 4};
                MoeOrder S{ti, F.G, (int)blockIdx.x, l, 2, (const char*)(ws + WS_WD)};
                EpiMoe2 E{(const int*)(ws + WS_LIST), args.out, (bf16_t*)(ws + WS_XB), (float*)(ws + WS_SS), (l == NL - 1) ? 1 : 0};
                pg8::gemm_phase<EpiMoe2, MoeOrder, true>(F.lds, g, S, E, F.tid);
                SEAM(pb + 5);
            }
        }
    }
#ifdef PROBE_KIND
    { const unsigned long long t0_ = __builtin_amdgcn_s_memrealtime(); while (__builtin_amdgcn_s_memrealtime() - t0_ < F.pk_acc) __builtin_amdgcn_s_sleep(8); }
#endif
#undef IN
#undef SEAM
#undef RELAUNDER
}

#ifdef DBG_CHECK
__device__ __forceinline__ int sample_row(int s) {
    const int tbl[24] = {0, 1, 2, 14, 15, 16, 29, 30, 31, 32, 63, 64, 65, 127, 128, 2047, 2048, 2049, 2063, 2078, 2079, 4095, 4096, 32767};
    if (s < 24) return tbl[s];
    return (int)(((unsigned)s * 2654435761u) % (unsigned)T);
}
__device__ __forceinline__ void rec_err(float* errs, int idx, float e) { if (!(e == e)) e = 1e30f; atomicMax((int*)errs + idx, __float_as_int(e)); }
__device__ __forceinline__ float blk_max(float v, float* sh) {
    __syncthreads(); sh[threadIdx.x] = v; __syncthreads();
    for (int s = 128; s > 0; s >>= 1) { if ((int)threadIdx.x < s) sh[threadIdx.x] = fmaxf(sh[threadIdx.x], sh[threadIdx.x + s]); __syncthreads(); }
    const float r = sh[0]; __syncthreads(); return r;
}
__device__ __forceinline__ float blk_sum(float v, float* sh) {
    __syncthreads(); sh[threadIdx.x] = v; __syncthreads();
    for (int s = 128; s > 0; s >>= 1) { if ((int)threadIdx.x < s) sh[threadIdx.x] += sh[threadIdx.x + s]; __syncthreads(); }
    const float r = sh[0]; __syncthreads(); return r;
}
__global__ void chk_prologue(Args a, float* errs) {
    __shared__ float sh[256];
    const int r = sample_row(blockIdx.x); const float* x = a.in[I_X] + (size_t)r * D; const bf16_t* xb = (const bf16_t*)(a.ws + WS_XB) + (size_t)r * D;
    float e = 0.f, s = 0.f;
    for (int k = threadIdx.x; k < D; k += 256) { e = fmaxf(e, fabsf(bf2f(xb[k]) - x[k]) / (fabsf(x[k]) + 1.f)); s += x[k] * x[k]; }
    s = blk_sum(s, sh); const float* ss = (const float*)(a.ws + WS_SS) + (size_t)r * 16; float s2 = 0.f; for (int i = 0; i < 16; ++i) s2 += ss[i];
    e = fmaxf(e, fabsf(s2 - s) / (s + 1.f) * 10.f);
    for (int l = 0; l < NL; ++l) { const unsigned hsh = (blockIdx.x * 256u + threadIdx.x) * 2654435761u + l * 97u;
        { const int n = hsh % D, k = (hsh >> 10) % D; const float w = a.in[I_WOUT][(size_t)l * D * D + (size_t)k * D + n]; const float g = bf2f(((const bf16_t*)(a.ws + WS_WOUT))[(size_t)l * D * D + (size_t)n * D + k]); e = fmaxf(e, fabsf(g - w) * 20.f); }
        { const int ee = hsh % NE, n = (hsh >> 4) % D, k = (hsh >> 14) % DE; const float w = a.in[I_WDN][((size_t)(l * NE + ee) * DE + k) * D + n]; const float g = bf2f(((const bf16_t*)(a.ws + WS_WD))[((size_t)(l * NE + ee) * D + n) * DE + k]); e = fmaxf(e, fabsf(g - w) * 20.f); }
        { const int ee = hsh % NE, j = (hsh >> 4) % DE, k = (hsh >> 12) % D, gu = (hsh >> 22) & 1; const float w = (gu ? a.in[I_WU] : a.in[I_WG])[((size_t)(l * NE + ee) * D + k) * DE + j] * a.in[I_FNG][l * D + k];
          const int p = (j >> 7) * 256 + gu * 128 + (j & 127); const float g = bf2f(((const bf16_t*)(a.ws + WS_WGU))[((size_t)(l * NE + ee) * 512 + p) * D + k]); e = fmaxf(e, fabsf(g - w) * 20.f); }
        { const int j = hsh % 20, k = (hsh >> 5) % D; const float w = ((j < 4) ? a.in[I_RGW][(size_t)(l * D + k) * 4 + j] : a.in[I_REW][(size_t)(l * D + k) * 16 + j - 4]) * a.in[I_FNG][l * D + k];
          const bf16_t* wr = (const bf16_t*)(a.ws + WS_WR) + (size_t)l * 2 * 32 * D; const float g = bf2f(wr[(size_t)j * D + k]) + bf2f(wr[(size_t)(32 + j) * D + k]); e = fmaxf(e, fabsf(g - w) * 1000.f); }
    }
    e = blk_max(e, sh); if (threadIdx.x == 0) rec_err(errs, 0, e);
}
__global__ void chk_inproj(Args a, int l, float* errs) {
    __shared__ float z[NIN]; __shared__ float sh[256];
    const int r = sample_row(blockIdx.x); const bf16_t* xb = (const bf16_t*)(a.ws + WS_XB) + (size_t)r * D;
    const float* ss = (const float*)(a.ws + WS_SS) + (size_t)r * 16; float s2 = 0.f; for (int i = 0; i < 16; ++i) s2 += ss[i];
    const float rstd = rsqrtf(s2 / D + EPS); const float* W = a.in[I_WIN] + (size_t)l * D * NIN; const float* g = a.in[I_ANG] + l * D;
    for (int c = threadIdx.x; c < NIN; c += 256) { float acc = 0.f; for (int k = 0; k < D; ++k) acc += bf2f(xb[k]) * g[k] * W[(size_t)k * NIN + c]; z[c] = acc * rstd; }
    __syncthreads();
    float e = 0.f; const int t = threadIdx.x;
    { const float ex = z[t] * (1.f / (1.f + expf(-z[256 + t]))); e = fmaxf(e, fabsf(ex - bf2f(((const bf16_t*)(a.ws + WS_U))[(size_t)r * CC + t]))); }
    { e = fmaxf(e, fabsf(z[512 + t] - bf2f(((const bf16_t*)(a.ws + WS_PIN))[(size_t)r * CP + t]))); }
    for (int c = t; c < CA; c += 256) {
        e = fmaxf(e, fabsf(z[1792 + c] - bf2f(((const bf16_t*)(a.ws + WS_V))[(size_t)r * CA + c])));
        const int hs = c >> 6, d = c & 63; float sq = 0.f, sk = 0.f; for (int i = 0; i < 64; ++i) { const float q = z[768 + hs * 64 + i], k = z[1280 + hs * 64 + i]; sq += q * q; sk += k * k; }
        const float eq = z[768 + c] * rsqrtf(sq / 64.f + EPS) * a.in[I_QG][l * DH + d] * QSCALE, ek = z[1280 + c] * rsqrtf(sk / 64.f + EPS) * a.in[I_KG][l * DH + d];
        e = fmaxf(e, fabsf(eq - bf2f(((const bf16_t*)(a.ws + WS_Q))[(size_t)r * CA + c])) * 4.f);
        e = fmaxf(e, fabsf(ek - bf2f(((const bf16_t*)(a.ws + WS_K))[(size_t)r * CA + c])));
    }
    e = blk_max(e, sh); if (t == 0) rec_err(errs, l * 8 + 1, e);
}
__global__ void chk_attn(Args a, int l, float* errs) {
    __shared__ float p[2][SEQ]; __shared__ float sh[256]; __shared__ float ov[DV];
    const int qt[16] = {0, 1, 31, 32, 63, 64, 65, 127, 128, 129, 191, 192, 500, 1023, 1024, 2047};
    const int q = qt[blockIdx.x & 15], h = (blockIdx.x >> 4) & 3, b = (blockIdx.x >> 6) ? 13 : 0; const int t = threadIdx.x;
    const bf16_t* Q = (const bf16_t*)(a.ws + WS_Q); const bf16_t* K = (const bf16_t*)(a.ws + WS_K); const bf16_t* V = (const bf16_t*)(a.ws + WS_V);
    const size_t rb = (size_t)b * SEQ; const float slope = exp2f(-2.f * (h + 1)); const float sl2 = slope * 1.4426950408889634f;
    const float lam_init = 0.8f - 0.6f * expf(-0.3f * (float)l); float s1 = 0.f, s2 = 0.f;
    for (int d = 0; d < DH; ++d) { s1 += a.in[I_LQ1][l * DH + d] * a.in[I_LK1][l * DH + d]; s2 += a.in[I_LQ2][l * DH + d] * a.in[I_LK2][l * DH + d]; }
    const float lam = expf(s1) - expf(s2) + lam_init;
    for (int m = 0; m < 2; ++m) {
        float mx = -INFINITY;
        for (int kv = t; kv <= q; kv += 256) { float s = 0.f; for (int d = 0; d < DH; ++d) s += bf2f(Q[(rb + q) * CA + h * 128 + m * 64 + d]) * bf2f(K[(rb + kv) * CA + h * 128 + m * 64 + d]); s -= sl2 * (float)(q - kv); p[m][kv] = s; mx = fmaxf(mx, s); }
        mx = blk_max(mx, sh); float sm = 0.f;
        for (int kv = t; kv <= q; kv += 256) { const float e_ = exp2f(p[m][kv] - mx); p[m][kv] = e_; sm += e_; }
        sm = blk_sum(sm, sh);
        for (int kv = t; kv <= q; kv += 256) p[m][kv] /= sm;
        __syncthreads();
    }
    float o = 0.f;
    if (t < DV) { for (int kv = 0; kv <= q; ++kv) o += (p[0][kv] - lam * p[1][kv]) * bf2f(V[(rb + kv) * CA + h * 128 + t]); }
    const float ssq = blk_sum(t < DV ? o * o : 0.f, sh);
    float e = 0.f;
    if (t < DV) { const float ex = o * rsqrtf(ssq / DV + EPS) * a.in[I_ASG][l * DV + t] * (1.f - lam_init); e = fabsf(ex - bf2f(((const bf16_t*)(a.ws + WS_MIX))[(rb + q) * D + 512 + h * 128 + t])); }
    e = blk_max(e, sh); if (t == 0) rec_err(errs, l * 8 + 2, e);
}
__global__ void chk_local(Args a, int l, float* errs) {
    __shared__ float sv[CC]; __shared__ float sh[256];
    const int r = sample_row(blockIdx.x); const int b = r / SEQ, tp = r % SEQ; const int t = threadIdx.x;
    const bf16_t* U = (const bf16_t*)(a.ws + WS_U); const bf16_t* PIN = (const bf16_t*)(a.ws + WS_PIN); const bf16_t* MIX = (const bf16_t*)(a.ws + WS_MIX);
    float y = a.in[I_CB][l * CC + t];
    for (int j = 0; j < CW; ++j) { const int tt = tp - 30 + j; if (tt >= 0) y += a.in[I_CW][(size_t)(l * CW + j) * CC + t] * bf2f(U[((size_t)b * SEQ + tt) * CC + t]); }
    const float mean = blk_sum(y, sh) / CC; const float dv = y - mean; const float var = blk_sum(dv * dv, sh) / CC;
    float yn = dv * rsqrtf(var + EPS) * a.in[I_CLG][l * CC + t] + a.in[I_CLB][l * CC + t]; yn = yn / (1.f + expf(-yn));
    sv[t] = yn; __syncthreads();
    float o = a.in[I_CPB][l * CC + t]; for (int c = 0; c < CC; ++c) o += sv[c] * a.in[I_CPW][(size_t)l * CC * CC + (size_t)c * CC + t];
    float e = fabsf(o - bf2f(MIX[(size_t)r * D + t]));
    __syncthreads();
    { const int gi = t >> 6, win = 2 << gi; float s = 0.f; for (int i = 0; i < win; ++i) { const int tt = tp - i; if (tt >= 0) s += bf2f(PIN[((size_t)b * SEQ + tt) * CP + t]); }
      const float cnt = (float)((tp + 1 < win) ? tp + 1 : win); sv[t] = s / cnt - bf2f(PIN[(size_t)r * CP + t]); }
    __syncthreads();
    { const int gi = t >> 6, dd = t & 63; float o2 = 0.f; for (int c = 0; c < 64; ++c) o2 += sv[gi * 64 + c] * a.in[I_PW][((size_t)(l * 4 + gi) * 64 + c) * 64 + dd];
      o2 *= a.in[I_PS][l * CP + t]; e = fmaxf(e, fabsf(o2 - bf2f(MIX[(size_t)r * D + 256 + t]))); }
    e = blk_max(e, sh); if (t == 0) rec_err(errs, l * 8 + 3, e);
}
__global__ void chk_outproj(Args a, int l, float* errs) {
    __shared__ float sh[256];
    const int r = sample_row(blockIdx.x); const int t = threadIdx.x; const bf16_t* MIX = (const bf16_t*)(a.ws + WS_MIX) + (size_t)r * D;
    float e = 0.f, ssq = 0.f;
    for (int n = t; n < D; n += 256) { float acc = 0.f; for (int k = 0; k < D; ++k) acc += bf2f(MIX[k]) * a.in[I_WOUT][(size_t)l * D * D + (size_t)k * D + n];
        const float xin = (l == 0) ? a.in[I_X][(size_t)r * D + n] : bf2f(((const bf16_t*)(a.ws + WS_XB))[(size_t)r * D + n]);
        const float got = a.out[(size_t)r * D + n]; e = fmaxf(e, fabsf(xin + acc - got)); ssq += got * got;
        e = fmaxf(e, fabsf(bf2f(((const bf16_t*)(a.ws + WS_X1B))[(size_t)r * D + n]) - got) / (fabsf(got) + 1.f) * 4.f); }
    ssq = blk_sum(ssq, sh); const float* ss = (const float*)(a.ws + WS_SS1) + (size_t)r * 16; float s2 = 0.f; for (int i = 0; i < 16; ++i) s2 += ss[i];
    e = fmaxf(e, fabsf(s2 - ssq) / (ssq + 1.f) * 10.f);
    e = blk_max(e, sh); if (t == 0) rec_err(errs, l * 8 + 4, e);
}
__global__ void chk_router_moe(Args a, int l, float* errs) {
    __shared__ float sh[256]; __shared__ float hf[D]; __shared__ float lgs[20]; __shared__ float act[2][DE]; __shared__ int eid[2]; __shared__ float wv[2];
    const int r = sample_row(blockIdx.x); const int t = threadIdx.x; const float* x1 = a.out + (size_t)r * D;
    float s = 0.f; for (int k = t; k < D; k += 256) s += x1[k] * x1[k];
    s = blk_sum(s, sh); const float rstd = rsqrtf(s / D + EPS);
    for (int k = t; k < D; k += 256) hf[k] = x1[k] * rstd * a.in[I_FNG][l * D + k];
    __syncthreads();
    if (t < 20) { double acc = 0.0; for (int k = 0; k < D; ++k) acc += (double)hf[k] * (double)((t < 4) ? a.in[I_RGW][(size_t)(l * D + k) * 4 + t] : a.in[I_REW][(size_t)(l * D + k) * 16 + t - 4]);
        lgs[t] = (float)acc + ((t < 4) ? a.in[I_RGB][l * 4 + t] : a.in[I_REB][l * 16 + t - 4]); }
    __syncthreads();
    float e = 0.f;
    if (t == 0) {
        int gi = 0; for (int j = 1; j < 4; ++j) if (lgs[j] > lgs[gi]) gi = j;
        float gs = 0.f; for (int j = 0; j < 4; ++j) gs += expf(lgs[j] - lgs[gi]); const float gp = 1.f / gs;
        const float* le = lgs + 4 + 4 * gi; int ia = 0; for (int j = 1; j < 4; ++j) if (le[j] > le[ia]) ia = j;
        int ib = -1; for (int j = 0; j < 4; ++j) if (j != ia && (ib < 0 || le[j] > le[ib])) ib = j;
        const float pa = 1.f / (1.f + expf(le[ib] - le[ia])); const float wa = gp * pa, wb = gp * (1.f - pa);
        const int lo = ia < ib ? ia : ib, hi = ia < ib ? ib : ia; const float wlo = ia < ib ? wa : wb, whi = ia < ib ? wb : wa;
        const int pi = (lo == 0) ? hi - 1 : (lo == 1) ? hi + 1 : 5; const int bkt = gi * 6 + pi;
        const int* TOKB = (const int*)(a.ws + WS_TOKB); const float* WTS = (const float*)(a.ws + WS_WTS); const int* LIST = (const int*)(a.ws + WS_LIST);
        if (TOKB[r * 2] != bkt) e = 1000.f;
        else { const int pos = TOKB[r * 2 + 1]; const unsigned cnt = ((const unsigned*)(a.ws + WS_CTL))[CW_CNT + l * 64 + bkt];
            if (pos < 0 || (unsigned)pos >= cnt || LIST[(size_t)bkt * T + pos] != r) e = 500.f; }
        e = fmaxf(e, fabsf(WTS[r * 2] - wlo) * 10.f); e = fmaxf(e, fabsf(WTS[r * 2 + 1] - whi) * 10.f);
        e = fmaxf(e, fabsf(((const float*)(a.ws + WS_RS1))[r] - rstd) * 10.f);
        eid[0] = gi * 4 + lo; eid[1] = gi * 4 + hi; wv[0] = wlo; wv[1] = whi;
    }
    __syncthreads();
    for (int s2 = 0; s2 < 2; ++s2) { const int ee = eid[s2]; const float* Wg = a.in[I_WG] + (size_t)(l * NE + ee) * D * DE; const float* Wu = a.in[I_WU] + (size_t)(l * NE + ee) * D * DE;
        float g = 0.f, u = 0.f; for (int k = 0; k < D; ++k) { g += hf[k] * Wg[(size_t)k * DE + t]; u += hf[k] * Wu[(size_t)k * DE + t]; }
        act[s2][t] = g / (1.f + expf(-g)) * u * wv[s2]; }
    __syncthreads();
    float* exp_out = (float*)(a.ws + WS_DBG) + (size_t)blockIdx.x * D;
    for (int n = t; n < D; n += 256) { float y = 0.f; for (int s2 = 0; s2 < 2; ++s2) { const float* Wd = a.in[I_WDN] + (size_t)(l * NE + eid[s2]) * DE * D; for (int j = 0; j < DE; ++j) y += act[s2][j] * Wd[(size_t)j * D + n]; }
        exp_out[n] = x1[n] + y; }
    e = blk_max(e, sh); if (t == 0) rec_err(errs, l * 8 + 5, e);
}
__global__ void chk_moe_post(Args a, int l, float* errs) {
    __shared__ float sh[256];
    const int r = sample_row(blockIdx.x); const int t = threadIdx.x; const float* exp_out = (const float*)(a.ws + WS_DBG) + (size_t)blockIdx.x * D;
    float e = 0.f, ssq = 0.f;
    for (int n = t; n < D; n += 256) { const float got = a.out[(size_t)r * D + n]; e = fmaxf(e, fabsf(got - exp_out[n])); ssq += got * got;
        if (l < NL - 1) e = fmaxf(e, fabsf(bf2f(((const bf16_t*)(a.ws + WS_XB))[(size_t)r * D + n]) - got) / (fabsf(got) + 1.f) * 4.f); }
    ssq = blk_sum(ssq, sh);
    if (l < NL - 1) { const float* ss = (const float*)(a.ws + WS_SS) + (size_t)r * 16; float s2 = 0.f; for (int i = 0; i < 16; ++i) s2 += ss[i]; e = fmaxf(e, fabsf(s2 - ssq) / (ssq + 1.f) * 10.f); }
    e = blk_max(e, sh); if (t == 0) rec_err(errs, l * 8 + 6, e);
}
#ifndef DBG_SHOW
#define DBG_SHOW -2
#endif
__global__ void chk_report(Args a, const float* errs) {
    const float tol[8] = {0.05f, 0.06f, 0.05f, 0.06f, 0.08f, 0.05f, 0.08f, 1e30f};
    int bad = -1; for (int i = 0; i < 16; ++i) if (errs[i] > tol[i & 7]) { bad = i; break; }
    float val = 0.f; bool over = false;
    if (DBG_SHOW == -1) { val = 16.f; over = true; }
    else if (DBG_SHOW >= 0) { val = 1000.f * errs[DBG_SHOW]; over = true; }
    else if (bad >= 0) { val = 8.f * exp2f((float)bad); over = true; }
    if (over) for (size_t i = (size_t)blockIdx.x * blockDim.x + threadIdx.x; i < (size_t)T * D; i += (size_t)gridDim.x * blockDim.x) a.out[i] = val;
}
#endif

extern "C" void kernel_launch(void* const* d_in, const int* in_sizes, int n_in, void* d_out, int out_size, void* d_ws, size_t ws_size, hipStream_t stream) {
    static int grid = 0;
    if (grid == 0) {
        if (n_in != 27 || out_size != T * D || ws_size < WS_END) { fprintf(stderr, "kernel_launch: unexpected shapes (n_in %d out %d ws %zu)\n", n_in, out_size, ws_size); grid = -1; return; }
        int dev = 0, cus = 0, per_cu = 0;
        if (hipGetDevice(&dev) != hipSuccess || hipDeviceGetAttribute(&cus, hipDeviceAttributeMultiprocessorCount, dev) != hipSuccess) { grid = -1; return; }
        if (hipFuncSetAttribute((const void*)mega_fwd, hipFuncAttributeMaxDynamicSharedMemorySize, LDS_BYTES) != hipSuccess) { fprintf(stderr, "kernel_launch: hipFuncSetAttribute failed\n"); grid = -1; return; }
        if (hipOccupancyMaxActiveBlocksPerMultiprocessor(&per_cu, (const void*)mega_fwd, NTHREADS, LDS_BYTES) != hipSuccess || per_cu < 1) fprintf(stderr, "kernel_launch: occupancy query reports %d\n", per_cu);
        (void)hipGetLastError();
        grid = cus;
    }
    if (grid < 0) return;
    (void)hipMemsetAsync((char*)d_ws + WS_CTL, 0, CTL_ZERO_BYTES, stream);
    Args a{};
    for (int i = 0; i < 27; ++i) a.in[i] = (const float*)d_in[i];
    a.out = (float*)d_out; a.ws = (unsigned char*)d_ws;
#ifdef DBG_CHECK
    float* errs = (float*)((char*)d_ws + WS_ERR);
    (void)hipMemsetAsync(errs, 0, 4096, stream);
    auto run = [&](int lo, int hi) { a.ph_lo = lo; a.ph_hi = hi; hipLaunchKernelGGL(mega_fwd, dim3(grid), dim3(NTHREADS), LDS_BYTES, stream, a); };
    run(0, 1); chk_prologue<<<48, 256, 0, stream>>>(a, errs);
    for (int l = 0; l < NL; ++l) { const int pb = 1 + 6 * l;
        run(pb, pb + 1); chk_inproj<<<48, 256, 0, stream>>>(a, l, errs);
        run(pb + 1, pb + 2); chk_attn<<<128, 256, 0, stream>>>(a, l, errs); chk_local<<<48, 256, 0, stream>>>(a, l, errs);
        run(pb + 2, pb + 3); chk_outproj<<<48, 256, 0, stream>>>(a, l, errs);
        run(pb + 3, pb + 4); chk_router_moe<<<48, 256, 0, stream>>>(a, l, errs);
        run(pb + 4, pb + 5); run(pb + 5, pb + 6); chk_moe_post<<<48, 256, 0, stream>>>(a, l, errs);
    }
    chk_report<<<1024, 256, 0, stream>>>(a, errs);
#else
#ifndef N_SPLIT
#define N_SPLIT 0
#endif
    if (N_SPLIT) { for (int p = 0; p < N_PHASES; ++p) { a.ph_lo = p; a.ph_hi = p + 1; hipLaunchKernelGGL(mega_fwd, dim3(grid), dim3(NTHREADS), LDS_BYTES, stream, a); } }
    else { a.ph_lo = 0; a.ph_hi = N_PHASES; hipLaunchKernelGGL(mega_fwd, dim3(grid), dim3(NTHREADS), LDS_BYTES, stream, a); }
#endif
}
```

```cpp
#include <hip/hip_runtime.h>
#include <cstdio>
#include <cstdint>

#define GAS __attribute__((address_space(1)))
#define LAS __attribute__((address_space(3)))
typedef unsigned short bf16_t;
typedef short bf16x8 __attribute__((ext_vector_type(8)));
typedef short s16x4 __attribute__((ext_vector_type(4)));
typedef float f32x4 __attribute__((ext_vector_type(4)));
typedef float f32x2 __attribute__((ext_vector_type(2)));
typedef float f32x16 __attribute__((ext_vector_type(16)));
typedef unsigned u32x4 __attribute__((ext_vector_type(4)));
typedef unsigned u32x2 __attribute__((ext_vector_type(2)));

__device__ __forceinline__ float bf2f(unsigned v) { return __uint_as_float(v << 16); }
__device__ __forceinline__ unsigned f2bf(float f) { unsigned u = __float_as_uint(f); return (u + 0x7fffu + ((u >> 16) & 1u)) >> 16; }
__device__ __forceinline__ unsigned pk2(float lo, float hi) { return f2bf(lo) | (f2bf(hi) << 16); }
__device__ __forceinline__ float wave_sum(float v) {
#define WS_DPP(ctrl, rmask) __builtin_bit_cast(float, __builtin_amdgcn_update_dpp(0, __builtin_bit_cast(int, v), (ctrl), (rmask), 0xf, true))
    v += WS_DPP(0xB1, 0xf);
    v += WS_DPP(0x4E, 0xf);
    v += WS_DPP(0x141, 0xf);
    v += WS_DPP(0x140, 0xf);
    v += WS_DPP(0x142, 0xa);
    v += WS_DPP(0x143, 0xc);
#undef WS_DPP
    return __builtin_bit_cast(float, __builtin_amdgcn_readlane(__builtin_bit_cast(int, v), 63));
}

namespace pg8 {
constexpr int BM = 256, BK = 64, HALF = 128, HTB = HALF * BK * 2, STAGE_BYTES = 8 * HTB;
__host__ __device__ __forceinline__ int lds_byte(int r, int c) { const int st = (r >> 4) * 2 + (c >> 5), rr = r & 15, cc = c & 31, ob = rr * 64 + cc * 2; return st * 1024 + (ob ^ (((ob >> 9) & 1) << 5)); }
__host__ __device__ __forceinline__ void stage_rc(int b, int& R, int& C) { const int st = b / 1024, sb = b % 1024, swz = sb ^ (((sb >> 9) & 1) << 5); R = (st >> 1) * 16 + swz / 64; C = (st & 1) * 32 + (swz % 64) / 2; }
__host__ __device__ __forceinline__ int perm32(int rho) { const int n = rho >> 4, i = rho & 15; return 8 * (i >> 2) + 4 * n + (i & 3); }

struct Unit { int pm, pn; const char* bb; long bjump; int arow0; int acount; int aux; };
struct Gemm { const char* A; int lda; const int* gather; int ldb; int K; int bsplit; };

__device__ __forceinline__ unsigned cvt_pk_bf16(float lo, float hi) { unsigned r; asm volatile("v_cvt_pk_bf16_f32 %0, %1, %2" : "=v"(r) : "v"(lo), "v"(hi)); return r; }

template <class Epi, class Sched, bool ALIGN_EPI>
__device__ __forceinline__ void gemm_phase(LAS unsigned char* lds, const Gemm g, const Sched& S, const Epi& E, const int tid) {
    const int wid = __builtin_amdgcn_readfirstlane(tid >> 6), lane = tid & 63, wr = wid >> 2, wc = wid & 3, fr = lane & 15, fq = lane >> 4;
    const int K = g.K, nt = K / BK;
    unsigned voffB[2];
#pragma unroll
    for (int i = 0; i < 2; ++i) { int R, C; stage_rc(tid * 16 + i * 8192, R, C); const int Rb = Epi::PERM ? ((R & ~31) + perm32(R & 31)) : R; voffB[i] = (unsigned)(Rb * g.ldb + C) * 2u; }
    const size_t kstep = (size_t)(BK * 2);
    const size_t bh = (size_t)HALF * g.ldb * 2;
    const unsigned ldsw = (unsigned)wid * 1024u;
    const int aoff = lds_byte(wr * 64 + fr, fq * 8), boff = lds_byte(wc * 32 + fr, fq * 8);
    const char* const Ab = g.A;
#define PG8_SA(b, h) (((b) * 2 + (h)) * HTB)
#define PG8_SB(b, h) ((4 + (b) * 2 + (h)) * HTB)
#define PG8_STAGE(bufoff, gbase, voff) do { _Pragma("unroll") for (int _i = 0; _i < 2; ++_i) \
        __builtin_amdgcn_global_load_lds((const unsigned*)((const char*)(gbase) + (voff)[_i]), (LAS unsigned*)(lds + (bufoff) + ldsw + _i * 8192), 16, 0, 0); } while (0)
#define PG8_LDA(dst, b, h) do { _Pragma("unroll") for (int m = 0; m < 4; ++m) _Pragma("unroll") for (int k = 0; k < 2; ++k) dst[m][k] = *(const LAS bf16x8*)(lds + PG8_SA(b, h) + aoff + m * 2048 + k * 1024); } while (0)
#define PG8_LDB(dst, b, h) do { _Pragma("unroll") for (int n = 0; n < 2; ++n) _Pragma("unroll") for (int k = 0; k < 2; ++k) dst[n][k] = *(const LAS bf16x8*)(lds + PG8_SB(b, h) + boff + n * 2048 + k * 1024); } while (0)
#define PG8_MMA(ai, bj, At, Bt) do { __builtin_amdgcn_s_setprio(1); _Pragma("unroll") for (int m = 0; m < 4; ++m) _Pragma("unroll") for (int n = 0; n < 2; ++n) _Pragma("unroll") for (int k = 0; k < 2; ++k) \
        acc[ai][bj][m][n] = __builtin_amdgcn_mfma_f32_16x16x32_bf16(Bt[n][k], At[m][k], acc[ai][bj][m][n], 0, 0, 0); __builtin_amdgcn_s_setprio(0); } while (0)
#define PG8_WAIT_V(n) asm volatile("s_waitcnt vmcnt(" #n ")" ::: "memory")
#define PG8_WAIT_L(n) asm volatile("s_waitcnt lgkmcnt(" #n ")" ::: "memory")
#define PG8_BAR __builtin_amdgcn_s_barrier()
#define PG8_SCHED __builtin_amdgcn_sched_barrier(0)
#define PG8_AOFFS(u, o) do { _Pragma("unroll") for (int _h = 0; _h < 2; ++_h) _Pragma("unroll") for (int _i = 0; _i < 2; ++_i) { int _R, _C; stage_rc(tid * 16 + _i * 8192, _R, _C); const int _r = _h * HALF + _R; \
        int _row; if (g.gather) { _row = (_r < (u).acount) ? g.gather[(u).arow0 + _r] : 0; } else { _row = (u).arow0 + _r; } (o)[_h][_i] = (unsigned)(_row * g.lda + _C) * 2u; } } while (0)
#define PG8_BKO(u, tt) ((size_t)(tt) * kstep + (((tt) >= g.bsplit) ? (size_t)(u).bjump : (size_t)0))
    Unit cur, nxt; int ui = 0;
    if (!S.next(0, cur)) return;
    f32x4 acc[2][2][4][2];
#pragma unroll
    for (int a = 0; a < 2; ++a)
#pragma unroll
        for (int b = 0; b < 2; ++b)
#pragma unroll
            for (int m = 0; m < 4; ++m)
#pragma unroll
                for (int n = 0; n < 2; ++n) acc[a][b][m][n] = (f32x4){0.f, 0.f, 0.f, 0.f};
    bf16x8 At[4][2], B0[2][2], B1[2][2];
    unsigned cao[2][2];
    LAS u32x4* const naol = (LAS u32x4*)(lds + STAGE_BYTES + 1024) + tid;
    PG8_AOFFS(cur, cao);
    const char* cB = cur.bb;
    PG8_STAGE(PG8_SB(0, 0), cB, voffB); PG8_STAGE(PG8_SB(0, 1), cB + bh, voffB); PG8_STAGE(PG8_SA(0, 0), Ab, cao[0]); PG8_STAGE(PG8_SA(0, 1), Ab, cao[1]);
    if (wr == 1) PG8_BAR;
    PG8_WAIT_V(2); PG8_BAR;
    PG8_STAGE(PG8_SB(1, 0), cB + kstep, voffB); PG8_STAGE(PG8_SA(1, 0), Ab + kstep, cao[0]); PG8_STAGE(PG8_SB(1, 1), cB + bh + kstep, voffB);
    PG8_WAIT_V(6); PG8_BAR;
    for (;;) {
        const bool has_next = S.next(ui + 1, nxt);
        const char* nB = cB;
        { unsigned nao[2][2];
          if (has_next) { PG8_AOFFS(nxt, nao); nB = nxt.bb; }
          else {
#pragma unroll
            for (int h = 0; h < 2; ++h)
#pragma unroll
                for (int i = 0; i < 2; ++i) nao[h][i] = cao[h][i];
          }
          *naol = (u32x4){nao[0][0], nao[0][1], nao[1][0], nao[1][1]}; }
#pragma unroll 1
        for (int t = 0; t < nt; t += 2) {
            const bool last = (t == nt - 2);
            const char* a1 = Ab + (size_t)(t + 1) * kstep;
            const char* a2 = last ? Ab : Ab + (size_t)(t + 2) * kstep;
            const char* a3 = a2 + kstep;
            const char* b2 = last ? nB : cB + PG8_BKO(cur, t + 2);
            const char* b3 = last ? nB + kstep : cB + PG8_BKO(cur, t + 3);
            unsigned ao2[2][2];
#pragma unroll
            for (int h = 0; h < 2; ++h)
#pragma unroll
                for (int i = 0; i < 2; ++i) ao2[h][i] = cao[h][i];
            if (last) { const u32x4 v = *naol; ao2[0][0] = v.x; ao2[0][1] = v.y; ao2[1][0] = v.z; ao2[1][1] = v.w; }
            PG8_LDB(B0, 0, 0); PG8_LDB(B1, 0, 1); PG8_SCHED; PG8_LDA(At, 0, 0); PG8_STAGE(PG8_SA(1, 1), a1, cao[1]);
            PG8_WAIT_V(8); PG8_WAIT_L(0); PG8_BAR; PG8_MMA(0, 0, At, B0); PG8_MMA(0, 1, At, B1); PG8_BAR; PG8_SCHED;
            PG8_LDA(At, 0, 1); PG8_STAGE(PG8_SB(0, 0), b2, voffB); PG8_STAGE(PG8_SB(0, 1), b2 + bh, voffB); PG8_STAGE(PG8_SA(0, 0), a2, ao2[0]);
            PG8_WAIT_V(8); PG8_WAIT_L(0); PG8_BAR; PG8_MMA(1, 0, At, B0); PG8_MMA(1, 1, At, B1); PG8_BAR; PG8_SCHED;
            PG8_LDB(B0, 1, 0); PG8_LDB(B1, 1, 1); PG8_SCHED; PG8_LDA(At, 1, 0); PG8_STAGE(PG8_SA(0, 1), a2, ao2[1]);
            PG8_WAIT_V(8); PG8_WAIT_L(0); PG8_BAR; PG8_MMA(0, 0, At, B0); PG8_MMA(0, 1, At, B1); PG8_BAR; PG8_SCHED;
            PG8_LDA(At, 1, 1); PG8_STAGE(PG8_SB(1, 0), b3, voffB); PG8_STAGE(PG8_SB(1, 1), b3 + bh, voffB); PG8_STAGE(PG8_SA(1, 0), a3, ao2[0]);
            PG8_WAIT_V(8); PG8_WAIT_L(0); PG8_BAR; PG8_MMA(1, 0, At, B0); PG8_MMA(1, 1, At, B1); PG8_BAR; PG8_SCHED;
        }
        if constexpr (ALIGN_EPI) { if (wr == 0) PG8_BAR; }
        { int t2_ = tid; asm volatile("" : "+v"(t2_)); const int l2_ = t2_ & 63; E(acc, cur, wr, wc, l2_ & 15, l2_ >> 4); }
        if (!has_next) break;
#pragma unroll
        for (int a = 0; a < 2; ++a)
#pragma unroll
            for (int b = 0; b < 2; ++b)
#pragma unroll
                for (int m = 0; m < 4; ++m)
#pragma unroll
                    for (int n = 0; n < 2; ++n) acc[a][b][m][n] = (f32x4){0.f, 0.f, 0.f, 0.f};
        cur = nxt; cB = nB; ++ui;
        { const u32x4 v = *naol; cao[0][0] = v.x; cao[0][1] = v.y; cao[1][0] = v.z; cao[1][1] = v.w; }
        if constexpr (ALIGN_EPI) { if (wr == 1) PG8_BAR; }
    }
    PG8_WAIT_V(0);
    if constexpr (!ALIGN_EPI) { if (wr == 0) PG8_BAR; }
    PG8_BAR;
#undef PG8_SA
#undef PG8_SB
#undef PG8_STAGE
#undef PG8_LDA
#undef PG8_LDB
#undef PG8_MMA
#undef PG8_WAIT_V
#undef PG8_WAIT_L
#undef PG8_BAR
#undef PG8_SCHED
#undef PG8_AOFFS
#undef PG8_BKO
}
}

constexpr int BATCH = 16, SEQ = 2048, T = BATCH * SEQ, D = 1024, NIN = 2304, NL = 2;
constexpr int CC = 256, CP = 256, CA = 512, NH = 4, DH = 64, DV = 128, CW = 31;
constexpr int NE = 16, DE = 256, NBKT = 24;
constexpr float EPS = 1e-6f;
constexpr float QSCALE = 0.125f * 1.4426950408889634f;
constexpr int NWAVES = 8, NTHREADS = 512;

constexpr size_t MiB = 1u << 20, KiB = 1u << 10;
constexpr size_t WS_CTL = 0, CTL_ZERO_BYTES = 1 * MiB;
constexpr size_t WS_SS = 2 * MiB;
constexpr size_t WS_SS1 = 4 * MiB;
constexpr size_t WS_RS1 = 6 * MiB;
constexpr size_t WS_WTS = 6 * MiB + 256 * KiB;
constexpr size_t WS_TOKB = 6 * MiB + 512 * KiB;
constexpr size_t WS_LIST = 7 * MiB;
constexpr size_t WS_WR = 10 * MiB;
constexpr size_t WS_WPW = 10 * MiB + 512 * KiB;
constexpr size_t WS_WPOOL = 10 * MiB + 768 * KiB;
constexpr size_t WS_ERR = 11 * MiB;
constexpr size_t WS_WIN = 16 * MiB;
constexpr size_t WS_WOUT = 25 * MiB;
constexpr size_t WS_WGU = 29 * MiB;
constexpr size_t WS_WD = 61 * MiB;
constexpr size_t WS_XB = 80 * MiB;
constexpr size_t WS_X1B = 144 * MiB;
constexpr size_t WS_MIX = 208 * MiB;
constexpr size_t WS_U = 272 * MiB;
constexpr size_t WS_PIN = 288 * MiB;
constexpr size_t WS_Q = 304 * MiB;
constexpr size_t WS_K = 336 * MiB;
constexpr size_t WS_V = 368 * MiB;
constexpr size_t WS_ACT = 400 * MiB;
constexpr size_t WS_DBG = 440 * MiB;
constexpr size_t WS_END = 512 * MiB;
constexpr int CW_BAR = 4096;
constexpr int CW_CNT = 16384;
constexpr int RING_BYTES = 131072;
constexpr int MISC_OFF = RING_BYTES;
constexpr int LDS_EXTRA = RING_BYTES + 1024;
constexpr int LDS_BYTES = 163840;

#define LDS_WAIT() asm volatile("s_waitcnt lgkmcnt(0)" ::: "memory")
#define VM_WAIT() asm volatile("s_waitcnt vmcnt(0)" ::: "memory")

#define XB_TMO      128
#define XB_XCNT(j)  (256  + 64 * (j))
#define XB_XSUB(j)  (1280 + 64 * (j))
#define XB_XGEN(j)  (2304 + 64 * (j))
#define XB_TOP      3328
#define XB_TOPGEN   3392
#define XCD_BAR_WORDS 3456
#define XB_SPIN_CAP (1u << 22)
__device__ __forceinline__ unsigned xb_ld(unsigned* p)              { return __hip_atomic_load(p, __ATOMIC_RELAXED, __HIP_MEMORY_SCOPE_AGENT); }
__device__ __forceinline__ unsigned xb_add(unsigned* p, unsigned v) { return __hip_atomic_fetch_add(p, v, __ATOMIC_RELAXED, __HIP_MEMORY_SCOPE_AGENT); }
__device__ __forceinline__ unsigned xb_xcc_id() { return (unsigned)__builtin_amdgcn_s_getreg((3 << 11) | 20) & 0xFu; }
#define XB_SPIN(cond, bar) do { unsigned _sp = 0; while (cond) { __builtin_amdgcn_s_sleep(1); \
    if ((++_sp & 255u) == 0u) { if (xb_ld(&(bar)[XB_TMO])) break; if (_sp > XB_SPIN_CAP) { atomicAdd(&(bar)[XB_TMO], 1u); break; } } } } while (0)
struct XcdBarrier { unsigned* bar; unsigned x; volatile LAS unsigned* st; };
__device__ __forceinline__ XcdBarrier xcd_barrier_post(unsigned* bar, volatile LAS unsigned* st) {
    XcdBarrier b; b.bar = bar; b.x = xb_xcc_id(); b.st = st;
    if (threadIdx.x == 0) (void)xb_add(&bar[XB_XCNT(b.x)], 1u);
    return b;
}
__device__ __forceinline__ void xcd_barrier_complete(unsigned* bar, unsigned x, unsigned& nloc, unsigned& nx) {
    const unsigned G = gridDim.x * gridDim.y * gridDim.z;
    unsigned sum, cnt, mine, sp = 0u;
    for (;;) {
        sum = 0u; cnt = 0u; mine = 0u;
#pragma unroll
        for (unsigned j = 0; j < 16; ++j) { const unsigned c = xb_ld(&bar[XB_XCNT(j)]); sum += c; cnt += (c > 0u) ? 1u : 0u; mine = (j == x) ? c : mine; }
        if (sum == G) break;
        __builtin_amdgcn_s_sleep(1);
        if ((++sp & 255u) == 0u) { if (xb_ld(&bar[XB_TMO])) break; if (sp > XB_SPIN_CAP) { atomicAdd(&bar[XB_TMO], 1u); break; } }
    }
    nloc = mine > 0u ? mine : 1u; nx = cnt > 0u ? cnt : 1u;
}
__device__ __forceinline__ void xcd_barrier(const XcdBarrier& b) {
    asm volatile("s_waitcnt vmcnt(0)" ::: "memory");
    __syncthreads();
    if (threadIdx.x == 0) {
        unsigned* bar = b.bar;
        __builtin_amdgcn_s_waitcnt(0);
        unsigned nloc = b.st[0], nx = b.st[1];
        if (nloc == 0u) { xcd_barrier_complete(bar, b.x, nloc, nx); b.st[0] = nloc; b.st[1] = nx; }
        const unsigned old = xb_add(&bar[XB_XSUB(b.x)], 1u);
        const unsigned gen = old / nloc;
        if (old + 1u == (gen + 1u) * nloc) {
            __builtin_amdgcn_fence(__ATOMIC_RELEASE, "agent");
            asm volatile("s_waitcnt vmcnt(0)" ::: "memory");
            const unsigned og = xb_add(&bar[XB_TOP], 1u);
            const unsigned tg = og / nx;
            if (og + 1u == (tg + 1u) * nx) xb_add(&bar[XB_TOPGEN], 1u);
            else XB_SPIN(xb_ld(&bar[XB_TOPGEN]) == tg, bar);
            __builtin_amdgcn_fence(__ATOMIC_ACQUIRE, "agent");
            xb_add(&bar[XB_XGEN(b.x)], 1u);
            asm volatile("s_waitcnt vmcnt(0)" ::: "memory");
        } else {
            XB_SPIN(xb_ld(&bar[XB_XGEN(b.x)]) == gen, bar);
            __builtin_amdgcn_fence(__ATOMIC_ACQUIRE, "agent");
            asm volatile("s_waitcnt vmcnt(0)" ::: "memory");
        }
    }
    __syncthreads();
}

struct Args { const float* in[27]; float* out; unsigned char* ws; int ph_lo, ph_hi; };
enum { I_X = 0, I_ANG, I_WIN, I_CW, I_CB, I_CLG, I_CLB, I_CPW, I_CPB, I_PW, I_PS, I_QG, I_KG, I_LQ1, I_LK1, I_LQ2, I_LK2, I_ASG, I_WOUT, I_FNG, I_RGW, I_RGB, I_REW, I_REB, I_WG, I_WU, I_WDN };

struct Frame {
    LAS unsigned char* lds;
    int tid, lane, wave, vcu, G;
#ifdef PROBE_KIND
    unsigned long long pk_prev, pk_acc;
#endif
};
#ifdef PROBE_KIND
#define PK_SUB(F, kind) do { const unsigned long long t_ = __builtin_amdgcn_s_memrealtime(); if ((kind) == PROBE_KIND) (F).pk_acc += t_ - (F).pk_prev; (F).pk_prev = t_; } while (0)
#else
#define PK_SUB(F, kind) do { } while (0)
#endif

template <bool HASG> __device__ __forceinline__ void tr_item(const float* S, int ldS, int scol, int k0, const float* gk, bf16_t* Dst, int ldD, int prow0, LAS unsigned char* scr, int lane) {
    const float* sp = S + (size_t)k0 * ldS + scol;
    float v[64]; f32x4 g4[16];
    if (HASG) {
#pragma unroll
        for (int i = 0; i < 16; ++i) g4[i] = *(const f32x4*)(gk + k0 + 4 * i);
    }
#pragma unroll
    for (int i = 0; i < 64; ++i) v[i] = sp[(size_t)i * ldS];
    asm volatile("" ::: "memory");
    unsigned w[32];
#pragma unroll
    for (int i = 0; i < 32; ++i) { float a = v[2 * i], b = v[2 * i + 1]; if (HASG) { a *= g4[i >> 1][(2 * i) & 3]; b *= g4[i >> 1][(2 * i + 1) & 3]; } w[i] = pk2(a, b); }
#pragma unroll
    for (int j = 0; j < 8; ++j) *(LAS u32x4*)(scr + lane * 144 + j * 16) = (u32x4){w[4 * j], w[4 * j + 1], w[4 * j + 2], w[4 * j + 3]};
    LDS_WAIT(); asm volatile("" ::: "memory");
#pragma unroll
    for (int j = 0; j < 8; ++j) { const int r = 8 * j + (lane >> 3), c = lane & 7; const u32x4 v = *(const LAS u32x4*)(scr + r * 144 + c * 16);
        *(u32x4*)(Dst + (size_t)(prow0 + r) * ldD + k0 + 8 * c) = v; }
    LDS_WAIT(); asm volatile("" ::: "memory");
}
__device__ __forceinline__ int win_logical(int p0) {
    const int pn = p0 >> 8, c = p0 & 255;
    if (pn < 2) return (c < 128) ? (pn * 128 + c) : (256 + pn * 128 + (c - 128));
    if (pn == 2) return 512 + c;
    if (pn < 7) { const int bj = c >> 7, wc = (c >> 5) & 3; return 768 + (pn - 3) * 256 + 64 * wc + 32 * bj; }
    return 1792 + (pn - 7) * 256 + c;
}
__device__ __forceinline__ void p0_prologue(const Args& args, Frame& F) {
    unsigned char* ws = args.ws;
    const int gw = F.vcu * NWAVES + F.wave, NGW = F.G * NWAVES, lane = F.lane;
    LAS unsigned char* scr = F.lds + F.wave * 16384;
    constexpr int I_IN = 16 * 36, I_OUT = 16 * 16, I_GU = 16 * 8 * 16, I_DN = 4 * 16 * 16, I_PWI = 4 * 4, I_PL = 4;
    constexpr int PER_L = I_IN + I_OUT + I_GU + I_DN + I_PWI + I_PL;
    for (int it = gw; it < NL * PER_L; it += NGW) {
        const int itu = __builtin_amdgcn_readfirstlane(it); const int l = itu / PER_L; int r = itu % PER_L;
        if (r < I_IN) { const int kb = r / 36, pb = r % 36; const int p = pb * 64 + lane;
            tr_item<true>(args.in[I_WIN] + (size_t)l * D * NIN, NIN, win_logical(p & ~31) + (p & 31), kb * 64, args.in[I_ANG] + l * D, (bf16_t*)(ws + WS_WIN) + (size_t)l * NIN * D, D, pb * 64, scr, lane); continue; }
        r -= I_IN;
        if (r < I_OUT) { const int kb = r / 16, pb = r % 16; const int p = pb * 64 + lane;
            tr_item<false>(args.in[I_WOUT] + (size_t)l * D * D, D, p, kb * 64, nullptr, (bf16_t*)(ws + WS_WOUT) + (size_t)l * D * D, D, pb * 64, scr, lane); continue; }
        r -= I_OUT;
        if (r < I_GU) { const int e = r / 128, q = r % 128, kb = q / 8, pb = q % 8; const int p = pb * 64 + lane;
            const int half = p >> 8, gu = (p >> 7) & 1, i0 = p & 127; const float* src = (gu ? args.in[I_WU] : args.in[I_WG]) + (size_t)(l * NE + e) * D * DE;
            tr_item<true>(src, DE, half * 128 + i0, kb * 64, args.in[I_FNG] + l * D, (bf16_t*)(ws + WS_WGU) + (size_t)(l * NE + e) * 512 * D, D, pb * 64, scr, lane); continue; }
        r -= I_GU;
        if (r < I_DN) { const int e = r / 64, q = r % 64, kb = q / 16, pb = q % 16; const int p = pb * 64 + lane;
            tr_item<false>(args.in[I_WDN] + (size_t)(l * NE + e) * DE * D, D, p, kb * 64, nullptr, (bf16_t*)(ws + WS_WD) + (size_t)(l * NE + e) * D * DE, DE, pb * 64, scr, lane); continue; }
        r -= I_DN;
        if (r < I_PWI) { const int kb = r / 4, pb = r % 4; const int p = pb * 64 + lane;
            tr_item<false>(args.in[I_CPW] + (size_t)l * CC * CC, CC, p, kb * 64, nullptr, (bf16_t*)(ws + WS_WPW) + (size_t)l * CC * CC, CC, pb * 64, scr, lane); continue; }
        r -= I_PWI;
        { const int gi = r;
            tr_item<false>(args.in[I_PW] + (size_t)(l * 4 + gi) * 64 * 64, 64, lane, 0, nullptr, (bf16_t*)(ws + WS_WPOOL) + (size_t)(l * 4 + gi) * 64 * 64, 64, 0, scr, lane); }
    }
    PK_SUB(F, 7);
    for (int i = (F.vcu * NTHREADS + F.tid); i < NL * 32 * D; i += F.G * NTHREADS) {
        const int l = i / (32 * D), j = (i / D) % 32, k = i % D;
        float w = 0.f; if (j < 4) w = args.in[I_RGW][(size_t)(l * D + k) * 4 + j]; else if (j < 20) w = args.in[I_REW][(size_t)(l * D + k) * 16 + (j - 4)];
        w *= args.in[I_FNG][l * D + k];
        const unsigned h = f2bf(w); const unsigned lo = f2bf(w - bf2f(h));
        bf16_t* base = (bf16_t*)(ws + WS_WR) + (size_t)l * 2 * 32 * D;
        base[(size_t)j * D + k] = (bf16_t)h; base[(size_t)(32 + j) * D + k] = (bf16_t)lo;
    }
    PK_SUB(F, 8);
    for (int m0 = gw * 4; m0 < T; m0 += NGW * 4) {
        f32x4 v[4][4];
#pragma unroll
        for (int r = 0; r < 4; ++r) { const GAS f32x4* xr = (const GAS f32x4*)(args.in[I_X] + (size_t)(m0 + r) * D) + lane;
#pragma unroll
            for (int j = 0; j < 4; ++j) v[r][j] = xr[64 * j]; }
#pragma unroll
        for (int r = 0; r < 4; ++r) { const int m = m0 + r; GAS unsigned long long* o8 = (GAS unsigned long long*)((bf16_t*)(ws + WS_XB) + (size_t)m * D) + lane; float s = 0.f;
#pragma unroll
            for (int j = 0; j < 4; ++j) { const f32x4 x = v[r][j]; s += (x.x * x.x + x.y * x.y) + (x.z * x.z + x.w * x.w); o8[64 * j] = (unsigned long long)pk2(x.x, x.y) | ((unsigned long long)pk2(x.z, x.w) << 32); }
            s = wave_sum(s);
            if (lane < 16) ((float*)(ws + WS_SS))[(size_t)m * 16 + lane] = (lane == 0) ? s : 0.f; }
    }
}

struct DenseOrder {
    int nM, nN, nwg, G, c; const char* Bt; size_t btile;
    __device__ void init(int M, int N, int G_, int c_, const void* Bt_, int ldb) { nM = M / 256; nN = N / 256; nwg = nM * nN; G = G_; c = c_; Bt = (const char*)Bt_; btile = (size_t)256 * ldb * 2; }
    __device__ __forceinline__ bool next(int i, pg8::Unit& u) const {
        const long L = (long)i * G + c; if (L >= nwg) return false;
        int wgid = (int)L; { const int q = nwg / 8, r = nwg % 8, xcd = wgid % 8, off = wgid / 8; wgid = (xcd < r ? xcd * (q + 1) : r * (q + 1) + (xcd - r) * q) + off; }
        const int nig = 8 * nN, gid = wgid / nig, fm = gid * 8, gsz = (nM - fm) < 8 ? (nM - fm) : 8;
        u.pm = fm + ((wgid % nig) % gsz); u.pn = (wgid % nig) / gsz;
        u.bb = Bt + (size_t)u.pn * btile; u.bjump = 0; u.arow0 = u.pm * 256; u.acount = 256; u.aux = 0; return true;
    }
};
struct MoeOrder {
    const LAS int* ti; int G, c, l, mode; const char* W;
    __device__ __forceinline__ bool next(int i, pg8::Unit& u) const {
        const int NT = __builtin_amdgcn_readfirstlane(ti[0]); const int nwg = NT * 4;
        const long L = (long)i * G + c; if (L >= nwg) return false;
        int wgid = (int)L; { const int q = nwg / 8, r = nwg % 8, xcd = wgid % 8, off = wgid / 8; wgid = (xcd < r ? xcd * (q + 1) : r * (q + 1) + (xcd - r) * q) + off; }
        const int rt = wgid >> 2, pn = wgid & 3;
        const int inf = __builtin_amdgcn_readfirstlane(ti[2 + 2 * rt]); const int b = inf & 255, lt = inf >> 8;
        const int grp = b / 6, pi = b % 6;
        const int lo = (pi < 3) ? 0 : (pi < 5 ? 1 : 2), hi = (pi < 3) ? pi + 1 : (pi < 5 ? pi - 1 : 3);
        const int e0 = grp * 4 + lo, e1 = grp * 4 + hi;
        u.pm = rt; u.pn = pn; u.acount = __builtin_amdgcn_readfirstlane(ti[3 + 2 * rt]);
        if (mode == 1) { const int e = (pn < 2) ? e0 : e1; u.bb = W + ((size_t)(l * NE + e) * 512 + (size_t)(pn & 1) * 256) * D * 2; u.bjump = 0; u.arow0 = b * T + lt * 256; u.aux = b; }
        else { u.bb = W + ((size_t)(l * NE + e0) * D + (size_t)pn * 256) * DE * 2; u.bjump = (long)(e1 - e0) * D * DE * 2 - 4 * 128; u.arow0 = rt * 256; u.aux = b * T + lt * 256; }
        return true;
    }
};

__device__ __forceinline__ float sigmoidf_(float x) { return __frcp_rn(1.f + __expf(-x)); }
__device__ __forceinline__ float row_rstd16(const float* p) {
    const f32x4 a = ((const f32x4*)p)[0], b = ((const f32x4*)p)[1], c = ((const f32x4*)p)[2], d = ((const f32x4*)p)[3];
    const float s = ((a.x + a.y) + (a.z + a.w)) + ((b.x + b.y) + (b.z + b.w)) + ((c.x + c.y) + (c.z + c.w)) + ((d.x + d.y) + (d.z + d.w));
    return rsqrtf(s * (1.f / D) + EPS);
}
__device__ __forceinline__ u32x4 pack8(const f32x4 a, const f32x4 b) { u32x4 w; w.x = pg8::cvt_pk_bf16(a[0], a[1]); w.y = pg8::cvt_pk_bf16(a[2], a[3]); w.z = pg8::cvt_pk_bf16(b[0], b[1]); w.w = pg8::cvt_pk_bf16(b[2], b[3]); return w; }

struct EpiInProj {
    static constexpr bool PERM = true;
    const float* SS; bf16_t *U, *PIN, *Q, *Kb, *V; const float *qg, *kg;
    __device__ __forceinline__ void operator()(const f32x4 (&acc)[2][2][4][2], const pg8::Unit& u, int wr, int wc, int fr, int fq) const {
        const int row0 = u.pm * 256 + wr * 64 + fr, pn = u.pn;
        if (pn < 2) {
#pragma unroll
            for (int ai = 0; ai < 2; ++ai)
#pragma unroll
                for (int m = 0; m < 4; ++m) { const int row = row0 + ai * 128 + m * 16; const float rs = row_rstd16(SS + (size_t)row * 16);
                    f32x4 o[2];
#pragma unroll
                    for (int n = 0; n < 2; ++n) { const f32x4 v = acc[ai][0][m][n] * rs, g = acc[ai][1][m][n] * rs;
                        o[n] = (f32x4){v[0] * sigmoidf_(g[0]), v[1] * sigmoidf_(g[1]), v[2] * sigmoidf_(g[2]), v[3] * sigmoidf_(g[3])}; }
                    *(u32x4*)(U + (size_t)row * CC + pn * 128 + wc * 32 + 8 * fq) = pack8(o[0], o[1]); }
        } else if (pn == 2 || pn >= 7) {
            bf16_t* dst = (pn == 2) ? PIN : V; const int ld = (pn == 2) ? CP : CA; const int cb = (pn == 2) ? 0 : (pn - 7) * 256;
#pragma unroll
            for (int ai = 0; ai < 2; ++ai)
#pragma unroll
                for (int m = 0; m < 4; ++m) { const int row = row0 + ai * 128 + m * 16; const float rs = row_rstd16(SS + (size_t)row * 16);
#pragma unroll
                    for (int bj = 0; bj < 2; ++bj) *(u32x4*)(dst + (size_t)row * ld + cb + bj * 128 + wc * 32 + 8 * fq) = pack8(acc[ai][bj][m][0] * rs, acc[ai][bj][m][1] * rs); }
        } else {
            const bool isq = pn < 5; bf16_t* dst = isq ? Q : Kb; const float* gn = isq ? qg : kg; const int hs = (isq ? (pn - 3) : (pn - 5)) * 4 + wc;
            f32x4 gv[2][2];
#pragma unroll
            for (int bj = 0; bj < 2; ++bj)
#pragma unroll
                for (int n = 0; n < 2; ++n) gv[bj][n] = *(const f32x4*)(gn + 32 * bj + 8 * fq + 4 * n);
#pragma unroll
            for (int ai = 0; ai < 2; ++ai)
#pragma unroll
                for (int m = 0; m < 4; ++m) { const int row = row0 + ai * 128 + m * 16; const float rs = row_rstd16(SS + (size_t)row * 16);
                    f32x4 z[2][2]; float ss = 0.f;
#pragma unroll
                    for (int bj = 0; bj < 2; ++bj)
#pragma unroll
                        for (int n = 0; n < 2; ++n) { z[bj][n] = acc[ai][bj][m][n] * rs; const f32x4 q = z[bj][n] * z[bj][n]; ss += (q[0] + q[1]) + (q[2] + q[3]); }
                    ss += __shfl_xor(ss, 16); ss += __shfl_xor(ss, 32);
                    const float r = rsqrtf(ss * (1.f / DH) + EPS) * (isq ? QSCALE : 1.f);
#pragma unroll
                    for (int bj = 0; bj < 2; ++bj) *(u32x4*)(dst + (size_t)row * CA + hs * 64 + 32 * bj + 8 * fq) = pack8(z[bj][0] * r * gv[bj][0], z[bj][1] * r * gv[bj][1]); }
        }
    }
};

struct EpiOutProj {
    static constexpr bool PERM = true;
    const bf16_t* XB; bf16_t* X1B; float* SS1;
    __device__ __forceinline__ void operator()(const f32x4 (&acc)[2][2][4][2], const pg8::Unit& u, int wr, int wc, int fr, int fq) const {
        const int row0 = u.pm * 256 + wr * 64 + fr, col0 = u.pn * 256 + wc * 32 + 8 * fq;
#pragma unroll
        for (int ai = 0; ai < 2; ++ai)
#pragma unroll
            for (int m = 0; m < 4; ++m) { const int row = row0 + ai * 128 + m * 16; float ss = 0.f;
#pragma unroll
                for (int bj = 0; bj < 2; ++bj) { const size_t off = (size_t)row * D + col0 + bj * 128; const u32x4 xi = *(const u32x4*)(XB + off);
                    const f32x4 a = acc[ai][bj][m][0], b = acc[ai][bj][m][1]; u32x4 w;
                    w.x = pg8::cvt_pk_bf16(bf2f(xi.x & 0xffffu) + a[0], __uint_as_float(xi.x & 0xffff0000u) + a[1]); w.y = pg8::cvt_pk_bf16(bf2f(xi.y & 0xffffu) + a[2], __uint_as_float(xi.y & 0xffff0000u) + a[3]);
                    w.z = pg8::cvt_pk_bf16(bf2f(xi.z & 0xffffu) + b[0], __uint_as_float(xi.z & 0xffff0000u) + b[1]); w.w = pg8::cvt_pk_bf16(bf2f(xi.w & 0xffffu) + b[2], __uint_as_float(xi.w & 0xffff0000u) + b[3]);
                    *(u32x4*)(X1B + off) = w;
#pragma unroll
                    for (int q = 0; q < 4; ++q) { const float lo = bf2f(w[q] & 0xffffu), hi = __uint_as_float(w[q] & 0xffff0000u); ss += lo * lo + hi * hi; } }
                ss += __shfl_xor(ss, 16); ss += __shfl_xor(ss, 32);
                if (fq == 0) SS1[(size_t)row * 16 + u.pn * 4 + wc] = ss; }
    }
};

struct EpiMoe1 {
    static constexpr bool PERM = true;
    const int* LIST; const float* RS1; const float* WTS; bf16_t* ACT;
    __device__ __forceinline__ void operator()(const f32x4 (&acc)[2][2][4][2], const pg8::Unit& u, int wr, int wc, int fr, int fq) const {
        const int pn = u.pn;
#pragma unroll
        for (int ai = 0; ai < 2; ++ai)
#pragma unroll
            for (int m = 0; m < 4; ++m) { const int r = ai * 128 + wr * 64 + m * 16 + fr; const int tok = (r < u.acount) ? LIST[u.arow0 + r] : 0;
                const float rs = RS1[tok], w = WTS[tok * 2 + (pn >> 1)];
                f32x4 o[2];
#pragma unroll
                for (int n = 0; n < 2; ++n) { const f32x4 g = acc[ai][0][m][n] * rs, uu = acc[ai][1][m][n] * (rs * w);
                    o[n] = (f32x4){g[0] * sigmoidf_(g[0]) * uu[0], g[1] * sigmoidf_(g[1]) * uu[1], g[2] * sigmoidf_(g[2]) * uu[2], g[3] * sigmoidf_(g[3]) * uu[3]}; }
                *(u32x4*)(ACT + (size_t)(u.pm * 256 + r) * 512 + (pn >> 1) * 256 + (pn & 1) * 128 + wc * 32 + 8 * fq) = pack8(o[0], o[1]); }
    }
};

struct EpiMoe2 {
    static constexpr bool PERM = true;
    const int* LIST; const bf16_t* X1B; float* out; bf16_t* XB; float* SS; int last;
    __device__ __forceinline__ void operator()(const f32x4 (&acc)[2][2][4][2], const pg8::Unit& u, int wr, int wc, int fr, int fq) const {
        const int col0 = u.pn * 256 + wc * 32 + 8 * fq;
#pragma unroll
        for (int ai = 0; ai < 2; ++ai)
#pragma unroll
            for (int m = 0; m < 4; ++m) { const int r = ai * 128 + wr * 64 + m * 16 + fr; const bool valid = r < u.acount; float ss = 0.f; int tok = 0;
                if (valid) { tok = LIST[u.aux + r];
#pragma unroll
                    for (int bj = 0; bj < 2; ++bj) { const size_t off = (size_t)tok * D + col0 + bj * 128; const u32x4 xi = *(const u32x4*)(X1B + off);
                        const f32x4 a = acc[ai][bj][m][0], b = acc[ai][bj][m][1];
                        const f32x4 xa = (f32x4){bf2f(xi.x & 0xffffu) + a[0], __uint_as_float(xi.x & 0xffff0000u) + a[1], bf2f(xi.y & 0xffffu) + a[2], __uint_as_float(xi.y & 0xffff0000u) + a[3]};
                        const f32x4 xb = (f32x4){bf2f(xi.z & 0xffffu) + b[0], __uint_as_float(xi.z & 0xffff0000u) + b[1], bf2f(xi.w & 0xffffu) + b[2], __uint_as_float(xi.w & 0xffff0000u) + b[3]};
                        if (last) { *(f32x4*)(out + off) = xa; *(f32x4*)(out + off + 4) = xb; }
                        else { const u32x4 w = pack8(xa, xb); *(u32x4*)(XB + off) = w;
#pragma unroll
                            for (int q = 0; q < 4; ++q) { const float lo = bf2f(w[q] & 0xffffu), hi = __uint_as_float(w[q] & 0xffff0000u); ss += lo * lo + hi * hi; } } } }
                ss += __shfl_xor(ss, 16); ss += __shfl_xor(ss, 32);
                if (valid && fq == 0 && !last) SS[(size_t)tok * 16 + u.pn * 4 + wc] = ss;
                asm volatile("" ::: "memory"); }
    }
};

__device__ __forceinline__ int crow(int r, int hi) { return (r & 3) + 8 * (r >> 2) + 4 * hi; }
typedef short v4i16_t __attribute__((ext_vector_type(4)));
__device__ __forceinline__ s16x4 vtr(const LAS unsigned char* p) { return __builtin_bit_cast(s16x4, __builtin_amdgcn_ds_read_tr16_b64_v4i16((LAS v4i16_t*)p)); }
constexpr int AT_K = 0, AT_V = 32768;

__device__ __forceinline__ void attn_unit(const Args& args, Frame& F, int l, int b, int h, int qb, float lam, float lam_init) {
    int tid = F.tid; asm volatile("" : "+v"(tid)); const int lane = tid & 63, wave = F.wave, r32 = lane & 31, hi = lane >> 5;
    const int mp = wave >> 2, rg = wave & 3;
    LAS unsigned char* lds = F.lds;
    const bf16_t* Qg = (const bf16_t*)(args.ws + WS_Q); const bf16_t* Kg = (const bf16_t*)(args.ws + WS_K); const bf16_t* Vg = (const bf16_t*)(args.ws + WS_V);
    bf16_t* MIX = (bf16_t*)(args.ws + WS_MIX);
    const int q0 = qb * 128, nt = 2 * qb + 2;
    const int qpos = q0 + 32 * rg + r32;
    const size_t rowb = (size_t)b * SEQ;
    const float slope = (h == 0) ? 0.25f : (h == 1) ? 0.0625f : (h == 2) ? 0.015625f : 0.00390625f;
    const float sl2 = slope * 1.4426950408889634f;
    int srow[2], sch[2]; unsigned kdst[2], vdst[2];
#pragma unroll
    for (int i = 0; i < 2; ++i) { const int c = tid + 512 * i; srow[i] = c >> 4; sch[i] = c & 15; const int row = srow[i], ch = sch[i];
        kdst[i] = (unsigned)(AT_K + (ch >> 3) * 8192 + row * 128 + (((ch & 7) ^ ((row >> 1) & 7)) << 4));
        vdst[i] = (unsigned)(AT_V + 256 * row + 16 * (ch ^ (((row & 3) << 2) | ((row >> 2) & 3)))); }
    u32x4 kst[2], vst[2];
#define AT_LOAD(j) do { _Pragma("unroll") for (int i = 0; i < 2; ++i) { const size_t g_ = ((rowb + (size_t)(j) * 64 + srow[i]) * CA + h * 128) * 2 + sch[i] * 16; \
        kst[i] = *(const u32x4*)((const char*)Kg + g_); vst[i] = *(const u32x4*)((const char*)Vg + g_); } } while (0)
#define AT_STORE(buf) do { _Pragma("unroll") for (int i = 0; i < 2; ++i) { *(LAS u32x4*)(lds + (buf) * 16384 + kdst[i]) = kst[i]; *(LAS u32x4*)(lds + (buf) * 16384 + vdst[i]) = vst[i]; } } while (0)
    AT_LOAD(0);
    bf16x8 qr[4];
    { const bf16_t* qp = Qg + (rowb + qpos) * CA + h * 128 + mp * 64 + 8 * hi;
#pragma unroll
      for (int ks = 0; ks < 4; ++ks) qr[ks] = *(const bf16x8*)(qp + 16 * ks); }
    f32x16 o[4];
#pragma unroll
    for (int d = 0; d < 4; ++d) o[d] = f32x16{};
    float m_run = -INFINITY, l_run = 0.f;
    unsigned vaddr[4][2];
#pragma unroll
    for (int db = 0; db < 4; ++db)
#pragma unroll
        for (int sub = 0; sub < 2; ++sub) { const int rb = 4 * hi + 8 * sub + ((lane & 15) >> 2); const int ch = 4 * db + 2 * ((lane >> 4) & 1) + ((lane >> 1) & 1); const int x = ((rb & 3) << 2) | ((rb >> 2) & 3);
            vaddr[db][sub] = (unsigned)(AT_V + 256 * rb + 16 * (ch ^ x) + 8 * (lane & 1)); }
    AT_STORE(0);
    __syncthreads();
    for (int j = 0; j < nt; ++j) {
        const int buf = j & 1;
        if (j + 1 < nt) AT_LOAD(j + 1);
        if (64 * j <= q0 + 32 * rg + 31) {
            const LAS unsigned char* KB = lds + buf * 16384 + AT_K + mp * 8192;
            f32x16 p0, p1;
            { const float base = sl2 * (float)(64 * j - qpos + 4 * hi);
#pragma unroll
              for (int r = 0; r < 16; ++r) { p0[r] = __builtin_fmaf(sl2, (float)((r & 3) + 8 * (r >> 2)), base); p1[r] = p0[r] + 32.f * sl2; } }
#pragma unroll
            for (int ks = 0; ks < 4; ++ks) { const int cc = 2 * ks + hi;
                const bf16x8 k0 = *(const LAS bf16x8*)(KB + r32 * 128 + ((cc ^ ((r32 >> 1) & 7)) << 4));
                const bf16x8 k1 = *(const LAS bf16x8*)(KB + (r32 + 32) * 128 + ((cc ^ (((r32 + 32) >> 1) & 7)) << 4));
                p0 = __builtin_amdgcn_mfma_f32_32x32x16_bf16(k0, qr[ks], p0, 0, 0, 0);
                p1 = __builtin_amdgcn_mfma_f32_32x32x16_bf16(k1, qr[ks], p1, 0, 0, 0); }
            if (64 * j + 63 > q0 + 32 * rg) {
#pragma unroll
                for (int r = 0; r < 16; ++r) { const int kv = 64 * j + crow(r, hi); if (kv > qpos) p0[r] = -INFINITY; if (kv + 32 > qpos) p1[r] = -INFINITY; }
            }
            float mx = fmaxf(p0[0], p1[0]);
#pragma unroll
            for (int r = 1; r < 16; ++r) mx = fmaxf(mx, fmaxf(p0[r], p1[r]));
            mx = fmaxf(mx, __shfl_xor(mx, 32));
            const float m_new = fmaxf(m_run, mx);
            const float alpha = __builtin_amdgcn_exp2f(m_run - m_new);
            m_run = m_new;
            float rsum = 0.f;
#pragma unroll
            for (int r = 0; r < 16; ++r) { p0[r] = __builtin_amdgcn_exp2f(p0[r] - m_new); p1[r] = __builtin_amdgcn_exp2f(p1[r] - m_new); rsum += p0[r] + p1[r]; }
            l_run = l_run * alpha + rsum;
#pragma unroll
            for (int d = 0; d < 4; ++d)
#pragma unroll
                for (int r = 0; r < 16; ++r) o[d][r] *= alpha;
            bf16x8 pb[4];
            { u32x4 w;
              w.x = pg8::cvt_pk_bf16(p0[0], p0[1]); w.y = pg8::cvt_pk_bf16(p0[2], p0[3]); w.z = pg8::cvt_pk_bf16(p0[4], p0[5]); w.w = pg8::cvt_pk_bf16(p0[6], p0[7]); pb[0] = __builtin_bit_cast(bf16x8, w);
              w.x = pg8::cvt_pk_bf16(p0[8], p0[9]); w.y = pg8::cvt_pk_bf16(p0[10], p0[11]); w.z = pg8::cvt_pk_bf16(p0[12], p0[13]); w.w = pg8::cvt_pk_bf16(p0[14], p0[15]); pb[1] = __builtin_bit_cast(bf16x8, w);
              w.x = pg8::cvt_pk_bf16(p1[0], p1[1]); w.y = pg8::cvt_pk_bf16(p1[2], p1[3]); w.z = pg8::cvt_pk_bf16(p1[4], p1[5]); w.w = pg8::cvt_pk_bf16(p1[6], p1[7]); pb[2] = __builtin_bit_cast(bf16x8, w);
              w.x = pg8::cvt_pk_bf16(p1[8], p1[9]); w.y = pg8::cvt_pk_bf16(p1[10], p1[11]); w.z = pg8::cvt_pk_bf16(p1[12], p1[13]); w.w = pg8::cvt_pk_bf16(p1[14], p1[15]); pb[3] = __builtin_bit_cast(bf16x8, w); }
            const LAS unsigned char* VB = lds + buf * 16384;
#pragma unroll
            for (int db = 0; db < 4; ++db)
#pragma unroll
                for (int ks = 0; ks < 4; ++ks) { const s16x4 lo = vtr(VB + vaddr[db][0] + ks * 4096), h4 = vtr(VB + vaddr[db][1] + ks * 4096);
                    const bf16x8 vf = (bf16x8){lo[0], lo[1], lo[2], lo[3], h4[0], h4[1], h4[2], h4[3]};
                    o[db] = __builtin_amdgcn_mfma_f32_32x32x16_bf16(vf, pb[ks], o[db], 0, 0, 0); }
        }
        if (j + 1 < nt) AT_STORE(buf ^ 1);
        __syncthreads();
    }
#undef AT_LOAD
#undef AT_STORE
    l_run += __shfl_xor(l_run, 32);
    const float inv = 1.f / l_run;
    LAS float* X = (LAS float*)lds + rg * 4096;
    if (mp == 1) { const float f = lam * inv;
#pragma unroll
        for (int db = 0; db < 4; ++db)
#pragma unroll
            for (int r = 0; r < 16; ++r) X[(32 * db + crow(r, hi)) * 32 + r32] = o[db][r] * f; }
    __syncthreads();
    if (mp == 0) { float ss = 0.f;
#pragma unroll
        for (int db = 0; db < 4; ++db)
#pragma unroll
            for (int r = 0; r < 16; ++r) { const float v = o[db][r] * inv - X[(32 * db + crow(r, hi)) * 32 + r32]; o[db][r] = v; ss += v * v; }
        ss += __shfl_xor(ss, 32);
        const float rn = rsqrtf(ss * (1.f / DV) + EPS) * (1.f - lam_init);
        const float* gs = args.in[I_ASG] + l * DV;
        bf16_t* orow = MIX + (rowb + qpos) * D + 512 + h * 128;
#pragma unroll
        for (int db = 0; db < 4; ++db)
#pragma unroll
            for (int rr = 0; rr < 4; ++rr) { const int d0 = 32 * db + 8 * rr + 4 * hi; const f32x4 g = *(const f32x4*)(gs + d0);
                u32x2 w; w.x = pg8::cvt_pk_bf16(o[db][4 * rr] * rn * g[0], o[db][4 * rr + 1] * rn * g[1]); w.y = pg8::cvt_pk_bf16(o[db][4 * rr + 2] * rn * g[2], o[db][4 * rr + 3] * rn * g[3]);
                *(u32x2*)(orow + d0) = w; } }
    __syncthreads();
}

constexpr int LM_UH = 0, LM_Y = 49152, LM_A = 0, LM_PH = 49152, LM_D = 0;
__device__ __forceinline__ void local_unit(const Args& args, Frame& F, int l, int tile) {
    int tid = F.tid; asm volatile("" : "+v"(tid)); int lane = tid & 63; const int wave = F.wave;
#define LM_RELAUNDER() do { asm volatile("" : "+v"(tid)); lane = tid & 63; } while (0)
    LAS unsigned char* lds = F.lds;
    const int b = tile / 32, t0 = (tile % 32) * 64; const size_t row0 = (size_t)b * SEQ + t0;
    const bf16_t* U = (const bf16_t*)(args.ws + WS_U); const bf16_t* PIN = (const bf16_t*)(args.ws + WS_PIN); bf16_t* MIX = (bf16_t*)(args.ws + WS_MIX);
    u32x4 hu[6], hp[5];
#pragma unroll
    for (int q = 0; q < 6; ++q) { const int c = tid + q * NTHREADS; const int i = c >> 5, ch = c & 31; const int t = t0 - 30 + i;
        hu[q] = (u32x4){0u, 0u, 0u, 0u}; if (c < 94 * 32 && t >= 0) hu[q] = *(const u32x4*)(U + ((size_t)b * SEQ + t) * CC + ch * 8); }
#pragma unroll
    for (int q = 0; q < 5; ++q) { const int c = tid + q * NTHREADS; const int i = c >> 5, ch = c & 31; const int t = t0 - 15 + i;
        hp[q] = (u32x4){0u, 0u, 0u, 0u}; if (c < 79 * 32 && t >= 0) hp[q] = *(const u32x4*)(PIN + ((size_t)b * SEQ + t) * CP + ch * 8); }
#pragma unroll
    for (int q = 0; q < 6; ++q) { const int c = tid + q * NTHREADS; const int i = c >> 5, ch = c & 31; if (c < 94 * 32) *(LAS u32x4*)(lds + LM_UH + i * 512 + ch * 16) = hu[q]; }
    LM_RELAUNDER();
    int c2 = tid & 127, tg = tid >> 7;
    float w0[CW], w1[CW];
#pragma unroll
    for (int j = 0; j < CW; ++j) { const f32x2 w = *(const f32x2*)(args.in[I_CW] + (size_t)(l * CW + j) * CC + 2 * c2); w0[j] = w.x; w1[j] = w.y; }
    float y0[16], y1[16];
    { const f32x2 bb = *(const f32x2*)(args.in[I_CB] + l * CC + 2 * c2);
#pragma unroll
      for (int k = 0; k < 16; ++k) { y0[k] = bb.x; y1[k] = bb.y; } }
    __syncthreads();
#pragma unroll
    for (int ii = 0; ii < 46; ++ii) { const unsigned uu = *(const LAS unsigned*)(lds + LM_UH + (16 * tg + ii) * 512 + c2 * 4); const float u0 = bf2f(uu & 0xffffu), u1 = bf2f(uu >> 16);
#pragma unroll
        for (int k = 0; k < 16; ++k) if (ii - k >= 0 && ii - k <= 30) { y0[k] += w0[ii - k] * u0; y1[k] += w1[ii - k] * u1; } }
#pragma unroll
    for (int k = 0; k < 16; ++k) *(LAS f32x2*)(lds + LM_Y + ((16 * tg + k) * 256 + 2 * c2) * 4) = (f32x2){y0[k], y1[k]};
    bf16x8 pwb[2][8];
    { const bf16_t* Wp = (const bf16_t*)(args.ws + WS_WPW) + (size_t)l * CC * CC;
#pragma unroll
      for (int nf = 0; nf < 2; ++nf)
#pragma unroll
          for (int ks = 0; ks < 8; ++ks) pwb[nf][ks] = *(const bf16x8*)(Wp + (size_t)(32 * wave + 16 * nf + (lane & 15)) * CC + 32 * ks + 8 * (lane >> 4)); }
    __syncthreads();
    PK_SUB(F, 20);
    LM_RELAUNDER();
    { const f32x4 lg = *(const f32x4*)(args.in[I_CLG] + l * CC + 4 * lane), lb = *(const f32x4*)(args.in[I_CLB] + l * CC + 4 * lane);
#pragma unroll 2
      for (int i = 0; i < 8; ++i) { const int row = wave * 8 + i; const f32x4 x = *(const LAS f32x4*)(lds + LM_Y + (row * 256 + 4 * lane) * 4);
        const float mean = wave_sum((x[0] + x[1]) + (x[2] + x[3])) * (1.f / CC); const f32x4 dx = x - mean;
        const float var = wave_sum((dx[0] * dx[0] + dx[1] * dx[1]) + (dx[2] * dx[2] + dx[3] * dx[3])) * (1.f / CC); const float rstd = rsqrtf(var + EPS);
        f32x4 yv = dx * rstd * lg + lb; yv = (f32x4){yv[0] * sigmoidf_(yv[0]), yv[1] * sigmoidf_(yv[1]), yv[2] * sigmoidf_(yv[2]), yv[3] * sigmoidf_(yv[3])};
        u32x2 w; w.x = pg8::cvt_pk_bf16(yv[0], yv[1]); w.y = pg8::cvt_pk_bf16(yv[2], yv[3]);
        *(LAS u32x2*)(lds + LM_A + row * 512 + (((lane >> 1) ^ (row & 15)) << 4) + 8 * (lane & 1)) = w; } }
    __syncthreads();
    PK_SUB(F, 21);
    LM_RELAUNDER();
    { const int fr = lane & 15, fq = lane >> 4;
      f32x4 acc[4][2];
#pragma unroll
      for (int mf = 0; mf < 4; ++mf)
#pragma unroll
          for (int nf = 0; nf < 2; ++nf) acc[mf][nf] = (f32x4){0.f, 0.f, 0.f, 0.f};
#pragma unroll
      for (int ks = 0; ks < 8; ++ks) {
          bf16x8 af[4];
#pragma unroll
          for (int mf = 0; mf < 4; ++mf) { const int arow = 16 * mf + fr; af[mf] = *(const LAS bf16x8*)(lds + LM_A + arow * 512 + (((4 * ks + fq) ^ (arow & 15)) << 4)); }
#pragma unroll
          for (int mf = 0; mf < 4; ++mf)
#pragma unroll
              for (int nf = 0; nf < 2; ++nf) acc[mf][nf] = __builtin_amdgcn_mfma_f32_16x16x32_bf16(pwb[nf][ks], af[mf], acc[mf][nf], 0, 0, 0);
      }
      const float* bp = args.in[I_CPB] + l * CC;
#pragma unroll
      for (int nf = 0; nf < 2; ++nf) { const int n0 = 32 * wave + 16 * nf + 4 * fq; const f32x4 bv = *(const f32x4*)(bp + n0);
#pragma unroll
          for (int mf = 0; mf < 4; ++mf) { const f32x4 a = acc[mf][nf] + bv; u32x2 w; w.x = pg8::cvt_pk_bf16(a[0], a[1]); w.y = pg8::cvt_pk_bf16(a[2], a[3]);
              *(u32x2*)(MIX + (row0 + 16 * mf + fr) * D + n0) = w; } }
    }
    PK_SUB(F, 22);
#pragma unroll
    for (int q = 0; q < 5; ++q) { const int c = tid + q * NTHREADS; const int i = c >> 5, ch = c & 31; if (c < 79 * 32) *(LAS u32x4*)(lds + LM_PH + i * 512 + ch * 16) = hp[q]; }
    __syncthreads();
    bf16x8 plb[4][2];
    { const bf16_t* Wq = (const bf16_t*)(args.ws + WS_WPOOL) + (size_t)(l * 4 + (wave >> 1)) * 64 * 64;
#pragma unroll
      for (int nf = 0; nf < 4; ++nf)
#pragma unroll
          for (int ks = 0; ks < 2; ++ks) plb[nf][ks] = *(const bf16x8*)(Wq + (size_t)(16 * nf + (lane & 15)) * 64 + 32 * ks + 8 * (lane >> 4)); }
    LM_RELAUNDER(); c2 = tid & 127; tg = tid >> 7;
    { const int gi = c2 >> 5, win = 2 << gi; const int r0 = 15 + 16 * tg;
      float s0 = 0.f, s1 = 0.f;
      for (int i = r0 - win + 1; i < r0; ++i) { const unsigned uu = *(const LAS unsigned*)(lds + LM_PH + i * 512 + c2 * 4); s0 += bf2f(uu & 0xffffu); s1 += bf2f(uu >> 16); }
#pragma unroll
      for (int k = 0; k < 16; ++k) { const unsigned uu = *(const LAS unsigned*)(lds + LM_PH + (r0 + k) * 512 + c2 * 4); const float u0 = bf2f(uu & 0xffffu), u1 = bf2f(uu >> 16);
        s0 += u0; s1 += u1; const int tpos = t0 + 16 * tg + k; const float cnt = (float)((tpos + 1 < win) ? (tpos + 1) : win); const float ic = 1.f / cnt;
        const int row = 16 * tg + k;
        *(LAS unsigned*)(lds + LM_D + row * 512 + (((c2 >> 2) ^ (row & 15)) << 4) + 4 * (c2 & 3)) = pg8::cvt_pk_bf16(s0 * ic - u0, s1 * ic - u1);
        const unsigned ul = *(const LAS unsigned*)(lds + LM_PH + (r0 + k - win + 1) * 512 + c2 * 4); s0 -= bf2f(ul & 0xffffu); s1 -= bf2f(ul >> 16); } }
    __syncthreads();
    PK_SUB(F, 23);
    LM_RELAUNDER();
    { const int gi = wave >> 1, fr = lane & 15, fq = lane >> 4;
      const float* sc = args.in[I_PS] + l * CP + 64 * gi;
#pragma unroll
      for (int mf = 0; mf < 2; ++mf) { const int arow = 32 * (wave & 1) + 16 * mf + fr;
        bf16x8 af[2];
#pragma unroll
        for (int ks = 0; ks < 2; ++ks) af[ks] = *(const LAS bf16x8*)(lds + LM_D + arow * 512 + (((8 * gi + 4 * ks + fq) ^ (arow & 15)) << 4));
#pragma unroll
        for (int nf = 0; nf < 4; ++nf) { f32x4 acc = (f32x4){0.f, 0.f, 0.f, 0.f};
#pragma unroll
            for (int ks = 0; ks < 2; ++ks) acc = __builtin_amdgcn_mfma_f32_16x16x32_bf16(plb[nf][ks], af[ks], acc, 0, 0, 0);
            const int d0 = 16 * nf + 4 * fq; const f32x4 sv = *(const f32x4*)(sc + d0); acc = acc * sv;
            u32x2 w; w.x = pg8::cvt_pk_bf16(acc[0], acc[1]); w.y = pg8::cvt_pk_bf16(acc[2], acc[3]);
            *(u32x2*)(MIX + (row0 + arow) * D + 256 + 64 * gi + d0) = w; } } }
    __syncthreads();
    PK_SUB(F, 24);
#undef LM_RELAUNDER
}

__device__ __forceinline__ void router_phase(const Args& args, Frame& F, int l) {
    const int tid = F.tid, lane = F.lane, wave = F.wave, fr = lane & 15, fq = lane >> 4;
    LAS unsigned char* lds = F.lds;
    LAS float* lgs = (LAS float*)lds + wave * (16 * 24);
    LAS int* bk = (LAS int*)(lds + 16384);
    LAS int* base = (LAS int*)(lds + 16384 + 512);
    const bf16_t* WRh = (const bf16_t*)(args.ws + WS_WR) + (size_t)l * 2 * 32 * D; const bf16_t* WRl = WRh + 32 * D;
    const bf16_t* X1B = (const bf16_t*)(args.ws + WS_X1B); const float* SS1 = (const float*)(args.ws + WS_SS1);
    float* RS1 = (float*)(args.ws + WS_RS1); float* WTS = (float*)(args.ws + WS_WTS); int* TOKB = (int*)(args.ws + WS_TOKB); int* LIST = (int*)(args.ws + WS_LIST);
    unsigned* gcnt = (unsigned*)(args.ws + WS_CTL) + CW_CNT + l * 64;
    const float* bgp = args.in[I_RGB] + l * 4; const float* bep = args.in[I_REB] + l * 16;
    for (int blk = F.vcu; blk < T / 128; blk += F.G) {
        const int row = blk * 128 + wave * 16 + fr;
        const bf16_t* xp = X1B + (size_t)row * D + 8 * fq;
        f32x4 acc0 = (f32x4){0.f, 0.f, 0.f, 0.f}, acc1 = acc0;
#pragma unroll 8
        for (int ks = 0; ks < 32; ++ks) {
            const bf16x8 xh = *(const bf16x8*)(xp + 32 * ks);
            const size_t wo = (size_t)fr * D + 32 * ks + 8 * fq;
            const bf16x8 wh0 = *(const bf16x8*)(WRh + wo), wl0 = *(const bf16x8*)(WRl + wo), wh1 = *(const bf16x8*)(WRh + 16 * D + wo), wl1 = *(const bf16x8*)(WRl + 16 * D + wo);
            acc0 = __builtin_amdgcn_mfma_f32_16x16x32_bf16(wl0, xh, acc0, 0, 0, 0); acc0 = __builtin_amdgcn_mfma_f32_16x16x32_bf16(wh0, xh, acc0, 0, 0, 0);
            acc1 = __builtin_amdgcn_mfma_f32_16x16x32_bf16(wl1, xh, acc1, 0, 0, 0); acc1 = __builtin_amdgcn_mfma_f32_16x16x32_bf16(wh1, xh, acc1, 0, 0, 0);
        }
        *(LAS f32x4*)(lgs + fr * 24 + 4 * fq) = acc0; if (fq == 0) *(LAS f32x4*)(lgs + fr * 24 + 16) = acc1;
        LDS_WAIT(); asm volatile("" ::: "memory");
        if (lane < 16) {
            const float rstd = row_rstd16(SS1 + (size_t)row * 16);
            float lg[20];
#pragma unroll
            for (int q = 0; q < 5; ++q) { const f32x4 v = *(const LAS f32x4*)(lgs + lane * 24 + 4 * q); lg[4 * q] = v[0] * rstd; lg[4 * q + 1] = v[1] * rstd; lg[4 * q + 2] = v[2] * rstd; lg[4 * q + 3] = v[3] * rstd; }
            float g4[4];
#pragma unroll
            for (int j = 0; j < 4; ++j) g4[j] = lg[j] + bgp[j];
            int gidx = 0; float gm = g4[0];
#pragma unroll
            for (int j = 1; j < 4; ++j) if (g4[j] > gm) { gm = g4[j]; gidx = j; }
            float gs = 0.f;
#pragma unroll
            for (int j = 0; j < 4; ++j) gs += __expf(g4[j] - gm);
            const float gp = 1.f / gs;
            float le[4];
#pragma unroll
            for (int j = 0; j < 4; ++j) { const float v = (gidx == 0) ? lg[4 + j] : (gidx == 1) ? lg[8 + j] : (gidx == 2) ? lg[12 + j] : lg[16 + j];
                const float bb = (gidx == 0) ? bep[j] : (gidx == 1) ? bep[4 + j] : (gidx == 2) ? bep[8 + j] : bep[12 + j]; le[j] = v + bb; }
            int ia = 0; float la = le[0];
#pragma unroll
            for (int j = 1; j < 4; ++j) if (le[j] > la) { la = le[j]; ia = j; }
            int ib = -1; float lb = -INFINITY;
#pragma unroll
            for (int j = 0; j < 4; ++j) if (j != ia && le[j] > lb) { lb = le[j]; ib = j; }
            const float pa = 1.f / (1.f + __expf(lb - la)), pbv = 1.f - pa;
            const float wa = gp * pa, wb = gp * pbv;
            const int lo2 = ia < ib ? ia : ib, hi2 = ia < ib ? ib : ia; const float wlo = ia < ib ? wa : wb, whi = ia < ib ? wb : wa;
            const int pi = (lo2 == 0) ? (hi2 - 1) : (lo2 == 1) ? (hi2 + 1) : 5;
            RS1[row] = rstd; WTS[row * 2] = wlo; WTS[row * 2 + 1] = whi; bk[wave * 16 + lane] = gidx * 6 + pi;
        }
        __syncthreads();
        int mybk = 0, lpos = 0;
        if (tid < 128) { mybk = bk[tid]; for (int r = 0; r < tid; ++r) lpos += (bk[r] == mybk) ? 1 : 0; }
        if (tid >= 128 && tid < 128 + NBKT) { const int bq = tid - 128; int c = 0; for (int r = 0; r < 128; ++r) c += (bk[r] == bq) ? 1 : 0;
            base[bq] = (int)__hip_atomic_fetch_add(gcnt + bq, (unsigned)c, __ATOMIC_RELAXED, __HIP_MEMORY_SCOPE_AGENT); }
        __syncthreads();
        if (tid < 128) { const int r2 = blk * 128 + tid; const int pos = base[mybk] + lpos; LIST[(size_t)mybk * T + pos] = r2; TOKB[r2 * 2] = mybk; TOKB[r2 * 2 + 1] = pos; }
        __syncthreads();
    }
}

constexpr int N_PHASES = 1 + 6 * NL;
__global__ void __launch_bounds__(NTHREADS, 2) mega_fwd(Args args) {
    extern __shared__ __attribute__((aligned(16))) unsigned char lds_[];
    Frame F;
    F.lds = (LAS unsigned char*)lds_;
    F.tid = threadIdx.x; F.lane = F.tid & 63; F.wave = __builtin_amdgcn_readfirstlane(F.tid >> 6);
    F.G = gridDim.x; { const int bx = blockIdx.x; F.vcu = (F.G % 8 == 0) ? (bx % 8) * (F.G / 8) + bx / 8 : bx; }
    volatile LAS unsigned* MISC = (volatile LAS unsigned*)(F.lds + MISC_OFF);
    for (int u = F.tid; u < 256; u += NTHREADS) MISC[u] = 0u;
    __syncthreads();
    unsigned char* ws = args.ws;
    unsigned* ctl = (unsigned*)(ws + WS_CTL);
    const int lo = args.ph_lo, hi = args.ph_hi;
    XcdBarrier bar; bar.bar = ctl + CW_BAR; bar.x = 0; bar.st = nullptr;
    if (hi - lo > 1) bar = xcd_barrier_post(ctl + CW_BAR, MISC + 8);
#ifdef ONLY_KIND
#define IN(k) ((((k)==0?0:(((k)-1)%6)+1))==ONLY_KIND && lo <= (k) && (k) < hi)
#else
#define IN(k) (lo <= (k) && (k) < hi)
#endif
#ifdef PROBE_KIND
    F.pk_prev = __builtin_amdgcn_s_memrealtime(); F.pk_acc = 0ull;
#define PK_STAMP(k) do { const unsigned long long t_ = __builtin_amdgcn_s_memrealtime(); if ((((k) == 0) ? 0 : ((((k) - 1) % 6) + 1)) == PROBE_KIND) F.pk_acc += t_ - F.pk_prev; F.pk_prev = t_; } while (0)
#else
#define PK_STAMP(k) do { } while (0)
#endif
#define SEAM(k) do { if (IN(k) && IN((k) + 1)) xcd_barrier(bar); PK_STAMP(k); } while (0)
#define RELAUNDER() do { int t_ = threadIdx.x; asm volatile("" : "+v"(t_)); F.tid = t_; F.lane = t_ & 63; } while (0)
    if (IN(0)) { p0_prologue(args, F); SEAM(0); }
    for (int l = 0; l < NL; ++l) {
        const int pb = 1 + 6 * l;
        if (IN(pb)) { RELAUNDER();
            pg8::Gemm g{(const char*)(ws + WS_XB), D, nullptr, D, D, 1 << 30};
            DenseOrder S; S.init(T, NIN, F.G, (int)blockIdx.x, (const bf16_t*)(ws + WS_WIN) + (size_t)l * NIN * D, D);
            EpiInProj E{(const float*)(ws + WS_SS), (bf16_t*)(ws + WS_U), (bf16_t*)(ws + WS_PIN), (bf16_t*)(ws + WS_Q), (bf16_t*)(ws + WS_K), (bf16_t*)(ws + WS_V), args.in[I_QG] + l * DH, args.in[I_KG] + l * DH};
            pg8::gemm_phase<EpiInProj, DenseOrder, true>(F.lds, g, S, E, F.tid);
            SEAM(pb);
        }
        if (IN(pb + 1)) { RELAUNDER(); PK_SUB(F, 11);
            const float lam_init = 0.8f - 0.6f * expf(-0.3f * (float)l);
            float lam;
            { const float a = args.in[I_LQ1][l * DH + F.lane] * args.in[I_LK1][l * DH + F.lane], b2 = args.in[I_LQ2][l * DH + F.lane] * args.in[I_LK2][l * DH + F.lane];
              lam = expf(wave_sum(a)) - expf(wave_sum(b2)) + lam_init; }
            for (int v = F.vcu; v < 256; v += F.G) {
                const int bh = v >> 2, s = v & 3;
                for (int i = 0; i < 4; ++i) { const int qb = (i == 0) ? (15 - s) : (i == 1) ? (8 + s) : (i == 2) ? (7 - s) : s;
                    attn_unit(args, F, l, bh >> 2, bh & 3, qb, lam, lam_init); }
            }
            PK_SUB(F, 9);
            for (int tl = F.vcu; tl < T / 64; tl += F.G) local_unit(args, F, l, tl);
            PK_SUB(F, 10);
            SEAM(pb + 1);
        }
        if (IN(pb + 2)) { RELAUNDER();
            pg8::Gemm g{(const char*)(ws + WS_MIX), D, nullptr, D, D, 1 << 30};
            DenseOrder S; S.init(T, D, F.G, (int)blockIdx.x, (const bf16_t*)(ws + WS_WOUT) + (size_t)l * D * D, D);
            EpiOutProj E{(const bf16_t*)(ws + WS_XB), (bf16_t*)(ws + WS_X1B), (float*)(ws + WS_SS1)};
            pg8::gemm_phase<EpiOutProj, DenseOrder, true>(F.lds, g, S, E, F.tid);
            SEAM(pb + 2);
        }
        if (IN(pb + 3)) { RELAUNDER(); router_phase(args, F, l); SEAM(pb + 3); }
        if (IN(pb + 4) || IN(pb + 5)) { RELAUNDER();
            LAS int* ti = (LAS int*)(F.lds + LDS_EXTRA + 8192);
            LAS int* tb = ti + 512;
            const unsigned* gc = ctl + CW_CNT + l * 64;
            if (F.tid == 0) { int a = 0; for (int b = 0; b < NBKT; ++b) { const int c = (int)__hip_atomic_load(gc + b, __ATOMIC_RELAXED, __HIP_MEMORY_SCOPE_AGENT); tb[b] = a; a += (c + 255) >> 8; } tb[NBKT] = a; ti[0] = a; }
            __syncthreads();
            if (F.tid < NBKT) { const int b = F.tid; const int c = (int)__hip_atomic_load(gc + b, __ATOMIC_RELAXED, __HIP_MEMORY_SCOPE_AGENT); const int t0 = tb[b], n = tb[b + 1] - t0;
                for (int lt = 0; lt < n; ++lt) { ti[2 + 2 * (t0 + lt)] = b | (lt << 8); ti[3 + 2 * (t0 + lt)] = (c - lt * 256) < 256 ? (c - lt * 256) : 256; } }
            __syncthreads();
            if (IN(pb + 4)) { RELAUNDER();
                pg8::Gemm g{(const char*)(ws + WS_X1B), D, (const int*)(ws + WS_LIST), D, D, 1 << 30};
                MoeOrder S{ti, F.G, (int)blockIdx.x, l, 1, (const char*)(ws + WS_WGU)};
                EpiMoe1 E{(const int*)(ws + WS_LIST), (const float*)(ws + WS_RS1), (const float*)(ws + WS_WTS), (bf16_t*)(ws + WS_ACT)};
                pg8::gemm_phase<EpiMoe1, MoeOrder, true>(F.lds, g, S, E, F.tid);
                SEAM(pb + 4);
            }
            if (IN(pb + 5)) { RELAUNDER();
                pg8::Gemm g{(const char*)(ws + WS_ACT), 512, nullptr, DE, 512, 4};
                MoeOrder S{ti, F.G, (int)blockIdx.x, l, 2, (const char*)(ws + WS_WD)};
                EpiMoe2 E{(const int*)(ws + WS_LIST), (const bf16_t*)(ws + WS_X1B), args.out, (bf16_t*)(ws + WS_XB), (float*)(ws + WS_SS), (l == NL - 1) ? 1 : 0};
                pg8::gemm_phase<EpiMoe2, MoeOrder, true>(F.lds, g, S, E, F.tid);
                SEAM(pb + 5);
            }
        }
    }
#ifdef PROBE_KIND
    { const unsigned long long t0_ = __builtin_amdgcn_s_memrealtime(); while (__builtin_amdgcn_s_memrealtime() - t0_ < F.pk_acc) __builtin_amdgcn_s_sleep(8); }
#endif
#undef IN
#undef SEAM
#undef RELAUNDER
}

#ifdef DBG_CHECK
__device__ __forceinline__ int sample_row(int s) {
    const int tbl[24] = {0, 1, 2, 14, 15, 16, 29, 30, 31, 32, 63, 64, 65, 127, 128, 2047, 2048, 2049, 2063, 2078, 2079, 4095, 4096, 32767};
    if (s < 24) return tbl[s];
    return (int)(((unsigned)s * 2654435761u) % (unsigned)T);
}
__device__ __forceinline__ void rec_err(float* errs, int idx, float e) { if (!(e == e)) e = 1e30f; atomicMax((int*)errs + idx, __float_as_int(e)); }
__device__ __forceinline__ float blk_max(float v, float* sh) {
    __syncthreads(); sh[threadIdx.x] = v; __syncthreads();
    for (int s = 128; s > 0; s >>= 1) { if ((int)threadIdx.x < s) sh[threadIdx.x] = fmaxf(sh[threadIdx.x], sh[threadIdx.x + s]); __syncthreads(); }
    const float r = sh[0]; __syncthreads(); return r;
}
__device__ __forceinline__ float blk_sum(float v, float* sh) {
    __syncthreads(); sh[threadIdx.x] = v; __syncthreads();
    for (int s = 128; s > 0; s >>= 1) { if ((int)threadIdx.x < s) sh[threadIdx.x] += sh[threadIdx.x + s]; __syncthreads(); }
    const float r = sh[0]; __syncthreads(); return r;
}
__global__ void chk_prologue(Args a, float* errs) {
    __shared__ float sh[256];
    const int r = sample_row(blockIdx.x); const float* x = a.in[I_X] + (size_t)r * D; const bf16_t* xb = (const bf16_t*)(a.ws + WS_XB) + (size_t)r * D;
    float e = 0.f, s = 0.f;
    for (int k = threadIdx.x; k < D; k += 256) { e = fmaxf(e, fabsf(bf2f(xb[k]) - x[k]) / (fabsf(x[k]) + 1.f)); s += x[k] * x[k]; }
    s = blk_sum(s, sh); const float* ss = (const float*)(a.ws + WS_SS) + (size_t)r * 16; float s2 = 0.f; for (int i = 0; i < 16; ++i) s2 += ss[i];
    e = fmaxf(e, fabsf(s2 - s) / (s + 1.f) * 10.f);
    for (int l = 0; l < NL; ++l) { const unsigned hsh = (blockIdx.x * 256u + threadIdx.x) * 2654435761u + l * 97u;
        { const int n = hsh % D, k = (hsh >> 10) % D; const float w = a.in[I_WOUT][(size_t)l * D * D + (size_t)k * D + n]; const float g = bf2f(((const bf16_t*)(a.ws + WS_WOUT))[(size_t)l * D * D + (size_t)n * D + k]); e = fmaxf(e, fabsf(g - w) * 20.f); }
        { const int ee = hsh % NE, n = (hsh >> 4) % D, k = (hsh >> 14) % DE; const float w = a.in[I_WDN][((size_t)(l * NE + ee) * DE + k) * D + n]; const float g = bf2f(((const bf16_t*)(a.ws + WS_WD))[((size_t)(l * NE + ee) * D + n) * DE + k]); e = fmaxf(e, fabsf(g - w) * 20.f); }
        { const int ee = hsh % NE, j = (hsh >> 4) % DE, k = (hsh >> 12) % D, gu = (hsh >> 22) & 1; const float w = (gu ? a.in[I_WU] : a.in[I_WG])[((size_t)(l * NE + ee) * D + k) * DE + j] * a.in[I_FNG][l * D + k];
          const int p = (j >> 7) * 256 + gu * 128 + (j & 127); const float g = bf2f(((const bf16_t*)(a.ws + WS_WGU))[((size_t)(l * NE + ee) * 512 + p) * D + k]); e = fmaxf(e, fabsf(g - w) * 20.f); }
        { const int j = hsh % 20, k = (hsh >> 5) % D; const float w = ((j < 4) ? a.in[I_RGW][(size_t)(l * D + k) * 4 + j] : a.in[I_REW][(size_t)(l * D + k) * 16 + j - 4]) * a.in[I_FNG][l * D + k];
          const bf16_t* wr = (const bf16_t*)(a.ws + WS_WR) + (size_t)l * 2 * 32 * D; const float g = bf2f(wr[(size_t)j * D + k]) + bf2f(wr[(size_t)(32 + j) * D + k]); e = fmaxf(e, fabsf(g - w) * 1000.f); }
    }
    e = blk_max(e, sh); if (threadIdx.x == 0) rec_err(errs, 0, e);
}
__global__ void chk_inproj(Args a, int l, float* errs) {
    __shared__ float z[NIN]; __shared__ float sh[256];
    const int r = sample_row(blockIdx.x); const bf16_t* xb = (const bf16_t*)(a.ws + WS_XB) + (size_t)r * D;
    const float* ss = (const float*)(a.ws + WS_SS) + (size_t)r * 16; float s2 = 0.f; for (int i = 0; i < 16; ++i) s2 += ss[i];
    const float rstd = rsqrtf(s2 / D + EPS); const float* W = a.in[I_WIN] + (size_t)l * D * NIN; const float* g = a.in[I_ANG] + l * D;
    for (int c = threadIdx.x; c < NIN; c += 256) { float acc = 0.f; for (int k = 0; k < D; ++k) acc += bf2f(xb[k]) * g[k] * W[(size_t)k * NIN + c]; z[c] = acc * rstd; }
    __syncthreads();
    float e = 0.f; const int t = threadIdx.x;
    { const float ex = z[t] * (1.f / (1.f + expf(-z[256 + t]))); e = fmaxf(e, fabsf(ex - bf2f(((const bf16_t*)(a.ws + WS_U))[(size_t)r * CC + t]))); }
    { e = fmaxf(e, fabsf(z[512 + t] - bf2f(((const bf16_t*)(a.ws + WS_PIN))[(size_t)r * CP + t]))); }
    for (int c = t; c < CA; c += 256) {
        e = fmaxf(e, fabsf(z[1792 + c] - bf2f(((const bf16_t*)(a.ws + WS_V))[(size_t)r * CA + c])));
        const int hs = c >> 6, d = c & 63; float sq = 0.f, sk = 0.f; for (int i = 0; i < 64; ++i) { const float q = z[768 + hs * 64 + i], k = z[1280 + hs * 64 + i]; sq += q * q; sk += k * k; }
        const float eq = z[768 + c] * rsqrtf(sq / 64.f + EPS) * a.in[I_QG][l * DH + d] * QSCALE, ek = z[1280 + c] * rsqrtf(sk / 64.f + EPS) * a.in[I_KG][l * DH + d];
        e = fmaxf(e, fabsf(eq - bf2f(((const bf16_t*)(a.ws + WS_Q))[(size_t)r * CA + c])) * 4.f);
        e = fmaxf(e, fabsf(ek - bf2f(((const bf16_t*)(a.ws + WS_K))[(size_t)r * CA + c])));
    }
    e = blk_max(e, sh); if (t == 0) rec_err(errs, l * 8 + 1, e);
}
__global__ void chk_attn(Args a, int l, float* errs) {
    __shared__ float p[2][SEQ]; __shared__ float sh[256]; __shared__ float ov[DV];
    const int qt[16] = {0, 1, 31, 32, 63, 64, 65, 127, 128, 129, 191, 192, 500, 1023, 1024, 2047};
    const int q = qt[blockIdx.x & 15], h = (blockIdx.x >> 4) & 3, b = (blockIdx.x >> 6) ? 13 : 0; const int t = threadIdx.x;
    const bf16_t* Q = (const bf16_t*)(a.ws + WS_Q); const bf16_t* K = (const bf16_t*)(a.ws + WS_K); const bf16_t* V = (const bf16_t*)(a.ws + WS_V);
    const size_t rb = (size_t)b * SEQ; const float slope = exp2f(-2.f * (h + 1)); const float sl2 = slope * 1.4426950408889634f;
    const float lam_init = 0.8f - 0.6f * expf(-0.3f * (float)l); float s1 = 0.f, s2 = 0.f;
    for (int d = 0; d < DH; ++d) { s1 += a.in[I_LQ1][l * DH + d] * a.in[I_LK1][l * DH + d]; s2 += a.in[I_LQ2][l * DH + d] * a.in[I_LK2][l * DH + d]; }
    const float lam = expf(s1) - expf(s2) + lam_init;
    for (int m = 0; m < 2; ++m) {
        float mx = -INFINITY;
        for (int kv = t; kv <= q; kv += 256) { float s = 0.f; for (int d = 0; d < DH; ++d) s += bf2f(Q[(rb + q) * CA + h * 128 + m * 64 + d]) * bf2f(K[(rb + kv) * CA + h * 128 + m * 64 + d]); s -= sl2 * (float)(q - kv); p[m][kv] = s; mx = fmaxf(mx, s); }
        mx = blk_max(mx, sh); float sm = 0.f;
        for (int kv = t; kv <= q; kv += 256) { const float e_ = exp2f(p[m][kv] - mx); p[m][kv] = e_; sm += e_; }
        sm = blk_sum(sm, sh);
        for (int kv = t; kv <= q; kv += 256) p[m][kv] /= sm;
        __syncthreads();
    }
    float o = 0.f;
    if (t < DV) { for (int kv = 0; kv <= q; ++kv) o += (p[0][kv] - lam * p[1][kv]) * bf2f(V[(rb + kv) * CA + h * 128 + t]); }
    const float ssq = blk_sum(t < DV ? o * o : 0.f, sh);
    float e = 0.f;
    if (t < DV) { const float ex = o * rsqrtf(ssq / DV + EPS) * a.in[I_ASG][l * DV + t] * (1.f - lam_init); e = fabsf(ex - bf2f(((const bf16_t*)(a.ws + WS_MIX))[(rb + q) * D + 512 + h * 128 + t])); }
    e = blk_max(e, sh); if (t == 0) rec_err(errs, l * 8 + 2, e);
}
__global__ void chk_local(Args a, int l, float* errs) {
    __shared__ float sv[CC]; __shared__ float sh[256];
    const int r = sample_row(blockIdx.x); const int b = r / SEQ, tp = r % SEQ; const int t = threadIdx.x;
    const bf16_t* U = (const bf16_t*)(a.ws + WS_U); const bf16_t* PIN = (const bf16_t*)(a.ws + WS_PIN); const bf16_t* MIX = (const bf16_t*)(a.ws + WS_MIX);
    float y = a.in[I_CB][l * CC + t];
    for (int j = 0; j < CW; ++j) { const int tt = tp - 30 + j; if (tt >= 0) y += a.in[I_CW][(size_t)(l * CW + j) * CC + t] * bf2f(U[((size_t)b * SEQ + tt) * CC + t]); }
    const float mean = blk_sum(y, sh) / CC; const float dv = y - mean; const float var = blk_sum(dv * dv, sh) / CC;
    float yn = dv * rsqrtf(var + EPS) * a.in[I_CLG][l * CC + t] + a.in[I_CLB][l * CC + t]; yn = yn / (1.f + expf(-yn));
    sv[t] = yn; __syncthreads();
    float o = a.in[I_CPB][l * CC + t]; for (int c = 0; c < CC; ++c) o += sv[c] * a.in[I_CPW][(size_t)l * CC * CC + (size_t)c * CC + t];
    float e = fabsf(o - bf2f(MIX[(size_t)r * D + t]));
    __syncthreads();
    { const int gi = t >> 6, win = 2 << gi; float s = 0.f; for (int i = 0; i < win; ++i) { const int tt = tp - i; if (tt >= 0) s += bf2f(PIN[((size_t)b * SEQ + tt) * CP + t]); }
      const float cnt = (float)((tp + 1 < win) ? tp + 1 : win); sv[t] = s / cnt - bf2f(PIN[(size_t)r * CP + t]); }
    __syncthreads();
    { const int gi = t >> 6, dd = t & 63; float o2 = 0.f; for (int c = 0; c < 64; ++c) o2 += sv[gi * 64 + c] * a.in[I_PW][((size_t)(l * 4 + gi) * 64 + c) * 64 + dd];
      o2 *= a.in[I_PS][l * CP + t]; e = fmaxf(e, fabsf(o2 - bf2f(MIX[(size_t)r * D + 256 + t]))); }
    e = blk_max(e, sh); if (t == 0) rec_err(errs, l * 8 + 3, e);
}
__global__ void chk_outproj(Args a, int l, float* errs) {
    __shared__ float sh[256];
    const int r = sample_row(blockIdx.x); const int t = threadIdx.x; const bf16_t* MIX = (const bf16_t*)(a.ws + WS_MIX) + (size_t)r * D;
    float e = 0.f, ssq = 0.f;
    for (int n = t; n < D; n += 256) { float acc = 0.f; for (int k = 0; k < D; ++k) acc += bf2f(MIX[k]) * a.in[I_WOUT][(size_t)l * D * D + (size_t)k * D + n];
        const float xin = bf2f(((const bf16_t*)(a.ws + WS_XB))[(size_t)r * D + n]);
        const float got = bf2f(((const bf16_t*)(a.ws + WS_X1B))[(size_t)r * D + n]); e = fmaxf(e, fabsf(xin + acc - got)); ssq += got * got; }
    ssq = blk_sum(ssq, sh); const float* ss = (const float*)(a.ws + WS_SS1) + (size_t)r * 16; float s2 = 0.f; for (int i = 0; i < 16; ++i) s2 += ss[i];
    e = fmaxf(e, fabsf(s2 - ssq) / (ssq + 1.f) * 10.f);
    e = blk_max(e, sh); if (t == 0) rec_err(errs, l * 8 + 4, e);
}
__global__ void chk_router_moe(Args a, int l, float* errs) {
    __shared__ float sh[256]; __shared__ float hf[D]; __shared__ float lgs[20]; __shared__ float act[2][DE]; __shared__ int eid[2]; __shared__ float wv[2];
    const int r = sample_row(blockIdx.x); const int t = threadIdx.x; const bf16_t* x1b = (const bf16_t*)(a.ws + WS_X1B) + (size_t)r * D;
    __shared__ float x1[D]; for (int k = t; k < D; k += 256) x1[k] = bf2f(x1b[k]); __syncthreads();
    float s = 0.f; for (int k = t; k < D; k += 256) s += x1[k] * x1[k];
    s = blk_sum(s, sh); const float rstd = rsqrtf(s / D + EPS);
    for (int k = t; k < D; k += 256) hf[k] = x1[k] * rstd * a.in[I_FNG][l * D + k];
    __syncthreads();
    if (t < 20) { double acc = 0.0; for (int k = 0; k < D; ++k) acc += (double)hf[k] * (double)((t < 4) ? a.in[I_RGW][(size_t)(l * D + k) * 4 + t] : a.in[I_REW][(size_t)(l * D + k) * 16 + t - 4]);
        lgs[t] = (float)acc + ((t < 4) ? a.in[I_RGB][l * 4 + t] : a.in[I_REB][l * 16 + t - 4]); }
    __syncthreads();
    float e = 0.f;
    if (t == 0) {
        int gi = 0; for (int j = 1; j < 4; ++j) if (lgs[j] > lgs[gi]) gi = j;
        float gs = 0.f; for (int j = 0; j < 4; ++j) gs += expf(lgs[j] - lgs[gi]); const float gp = 1.f / gs;
        const float* le = lgs + 4 + 4 * gi; int ia = 0; for (int j = 1; j < 4; ++j) if (le[j] > le[ia]) ia = j;
        int ib = -1; for (int j = 0; j < 4; ++j) if (j != ia && (ib < 0 || le[j] > le[ib])) ib = j;
        const float pa = 1.f / (1.f + expf(le[ib] - le[ia])); const float wa = gp * pa, wb = gp * (1.f - pa);
        const int lo = ia < ib ? ia : ib, hi = ia < ib ? ib : ia; const float wlo = ia < ib ? wa : wb, whi = ia < ib ? wb : wa;
        const int pi = (lo == 0) ? hi - 1 : (lo == 1) ? hi + 1 : 5; const int bkt = gi * 6 + pi;
        const int* TOKB = (const int*)(a.ws + WS_TOKB); const float* WTS = (const float*)(a.ws + WS_WTS); const int* LIST = (const int*)(a.ws + WS_LIST);
        if (TOKB[r * 2] != bkt) e = 1000.f;
        else { const int pos = TOKB[r * 2 + 1]; const unsigned cnt = ((const unsigned*)(a.ws + WS_CTL))[CW_CNT + l * 64 + bkt];
            if (pos < 0 || (unsigned)pos >= cnt || LIST[(size_t)bkt * T + pos] != r) e = 500.f; }
        e = fmaxf(e, fabsf(WTS[r * 2] - wlo) * 10.f); e = fmaxf(e, fabsf(WTS[r * 2 + 1] - whi) * 10.f);
        e = fmaxf(e, fabsf(((const float*)(a.ws + WS_RS1))[r] - rstd) * 10.f);
        eid[0] = gi * 4 + lo; eid[1] = gi * 4 + hi; wv[0] = wlo; wv[1] = whi;
    }
    __syncthreads();
    for (int s2 = 0; s2 < 2; ++s2) { const int ee = eid[s2]; const float* Wg = a.in[I_WG] + (size_t)(l * NE + ee) * D * DE; const float* Wu = a.in[I_WU] + (size_t)(l * NE + ee) * D * DE;
        float g = 0.f, u = 0.f; for (int k = 0; k < D; ++k) { g += hf[k] * Wg[(size_t)k * DE + t]; u += hf[k] * Wu[(size_t)k * DE + t]; }
        act[s2][t] = g / (1.f + expf(-g)) * u * wv[s2]; }
    __syncthreads();
    float* exp_out = (float*)(a.ws + WS_DBG) + (size_t)blockIdx.x * D;
    for (int n = t; n < D; n += 256) { float y = 0.f; for (int s2 = 0; s2 < 2; ++s2) { const float* Wd = a.in[I_WDN] + (size_t)(l * NE + eid[s2]) * DE * D; for (int j = 0; j < DE; ++j) y += act[s2][j] * Wd[(size_t)j * D + n]; }
        exp_out[n] = x1[n] + y; }
    e = blk_max(e, sh); if (t == 0) rec_err(errs, l * 8 + 5, e);
}
__global__ void chk_moe_post(Args a, int l, float* errs) {
    __shared__ float sh[256];
    const int r = sample_row(blockIdx.x); const int t = threadIdx.x; const float* exp_out = (const float*)(a.ws + WS_DBG) + (size_t)blockIdx.x * D;
    float e = 0.f, ssq = 0.f;
    for (int n = t; n < D; n += 256) { const float got = (l < NL - 1) ? bf2f(((const bf16_t*)(a.ws + WS_XB))[(size_t)r * D + n]) : a.out[(size_t)r * D + n]; e = fmaxf(e, fabsf(got - exp_out[n])); ssq += got * got; }
    ssq = blk_sum(ssq, sh);
    if (l < NL - 1) { const float* ss = (const float*)(a.ws + WS_SS) + (size_t)r * 16; float s2 = 0.f; for (int i = 0; i < 16; ++i) s2 += ss[i]; e = fmaxf(e, fabsf(s2 - ssq) / (ssq + 1.f) * 10.f); }
    e = blk_max(e, sh); if (t == 0) rec_err(errs, l * 8 + 6, e);
}
#ifndef DBG_SHOW
#define DBG_SHOW -2
#endif
__global__ void chk_report(Args a, const float* errs) {
    const float tol[8] = {0.05f, 0.06f, 0.05f, 0.06f, 0.08f, 0.05f, 0.08f, 1e30f};
    int bad = -1; for (int i = 0; i < 16; ++i) if (errs[i] > tol[i & 7]) { bad = i; break; }
    float val = 0.f; bool over = false;
    if (DBG_SHOW == -1) { val = 16.f; over = true; }
    else if (DBG_SHOW >= 0) { val = 1000.f * errs[DBG_SHOW]; over = true; }
    else if (bad >= 0) { val = 8.f * exp2f((float)bad); over = true; }
    if (over) for (size_t i = (size_t)blockIdx.x * blockDim.x + threadIdx.x; i < (size_t)T * D; i += (size_t)gridDim.x * blockDim.x) a.out[i] = val;
}
#endif

extern "C" void kernel_launch(void* const* d_in, const int* in_sizes, int n_in, void* d_out, int out_size, void* d_ws, size_t ws_size, hipStream_t stream) {
    static int grid = 0;
    if (grid == 0) {
        if (n_in != 27 || out_size != T * D || ws_size < WS_END) { fprintf(stderr, "kernel_launch: unexpected shapes (n_in %d out %d ws %zu)\n", n_in, out_size, ws_size); grid = -1; return; }
        int dev = 0, cus = 0, per_cu = 0;
        if (hipGetDevice(&dev) != hipSuccess || hipDeviceGetAttribute(&cus, hipDeviceAttributeMultiprocessorCount, dev) != hipSuccess) { grid = -1; return; }
        if (hipFuncSetAttribute((const void*)mega_fwd, hipFuncAttributeMaxDynamicSharedMemorySize, LDS_BYTES) != hipSuccess) { fprintf(stderr, "kernel_launch: hipFuncSetAttribute failed\n"); grid = -1; return; }
        if (hipOccupancyMaxActiveBlocksPerMultiprocessor(&per_cu, (const void*)mega_fwd, NTHREADS, LDS_BYTES) != hipSuccess || per_cu < 1) fprintf(stderr, "kernel_launch: occupancy query reports %d\n", per_cu);
        (void)hipGetLastError();
        grid = cus;
    }
    if (grid < 0) return;
    (void)hipMemsetAsync((char*)d_ws + WS_CTL, 0, CTL_ZERO_BYTES, stream);
    Args a{};
    for (int i = 0; i < 27; ++i) a.in[i] = (const float*)d_in[i];
    a.out = (float*)d_out; a.ws = (unsigned char*)d_ws;
#ifdef DBG_CHECK
    float* errs = (float*)((char*)d_ws + WS_ERR);
    (void)hipMemsetAsync(errs, 0, 4096, stream);
    auto run = [&](int lo, int hi) { a.ph_lo = lo; a.ph_hi = hi; hipLaunchKernelGGL(mega_fwd, dim3(grid), dim3(NTHREADS), LDS_BYTES, stream, a); };
    run(0, 1); chk_prologue<<<48, 256, 0, stream>>>(a, errs);
    for (int l = 0; l < NL; ++l) { const int pb = 1 + 6 * l;
        run(pb, pb + 1); chk_inproj<<<48, 256, 0, stream>>>(a, l, errs);
        run(pb + 1, pb + 2); chk_attn<<<128, 256, 0, stream>>>(a, l, errs); chk_local<<<48, 256, 0, stream>>>(a, l, errs);
        run(pb + 2, pb + 3); chk_outproj<<<48, 256, 0, stream>>>(a, l, errs);
        run(pb + 3, pb + 4); chk_router_moe<<<48, 256, 0, stream>>>(a, l, errs);
        run(pb + 4, pb + 5); run(pb + 5, pb + 6); chk_moe_post<<<48, 256, 0, stream>>>(a, l, errs);
    }
    chk_report<<<1024, 256, 0, stream>>>(a, errs);
#else
#ifndef N_SPLIT
#define N_SPLIT 0
#endif
    if (N_SPLIT) { for (int p = 0; p < N_PHASES; ++p) { a.ph_lo = p; a.ph_hi = p + 1; hipLaunchKernelGGL(mega_fwd, dim3(grid), dim3(NTHREADS), LDS_BYTES, stream, a); } }
    else { a.ph_lo = 0; a.ph_hi = N_PHASES; hipLaunchKernelGGL(mega_fwd, dim3(grid), dim3(NTHREADS), LDS_BYTES, stream, a); }
#endif
}
```

```cpp
#include <hip/hip_runtime.h>
#include <cstdio>
#include <cstdint>

#define GAS __attribute__((address_space(1)))
#define LAS __attribute__((address_space(3)))
typedef unsigned short bf16_t;
typedef short bf16x8 __attribute__((ext_vector_type(8)));
typedef short s16x4 __attribute__((ext_vector_type(4)));
typedef float f32x4 __attribute__((ext_vector_type(4)));
typedef float f32x2 __attribute__((ext_vector_type(2)));
typedef float f32x16 __attribute__((ext_vector_type(16)));
typedef unsigned u32x4 __attribute__((ext_vector_type(4)));
typedef unsigned u32x2 __attribute__((ext_vector_type(2)));

__device__ __forceinline__ float bf2f(unsigned v) { return __uint_as_float(v << 16); }
__device__ __forceinline__ unsigned f2bf(float f) { unsigned u = __float_as_uint(f); return (u + 0x7fffu + ((u >> 16) & 1u)) >> 16; }
__device__ __forceinline__ unsigned pk2(float lo, float hi) { return f2bf(lo) | (f2bf(hi) << 16); }
__device__ __forceinline__ float wave_sum(float v) {
#define WS_DPP(ctrl, rmask) __builtin_bit_cast(float, __builtin_amdgcn_update_dpp(0, __builtin_bit_cast(int, v), (ctrl), (rmask), 0xf, true))
    v += WS_DPP(0xB1, 0xf);
    v += WS_DPP(0x4E, 0xf);
    v += WS_DPP(0x141, 0xf);
    v += WS_DPP(0x140, 0xf);
    v += WS_DPP(0x142, 0xa);
    v += WS_DPP(0x143, 0xc);
#undef WS_DPP
    return __builtin_bit_cast(float, __builtin_amdgcn_readlane(__builtin_bit_cast(int, v), 63));
}

namespace pg8 {
constexpr int BM = 256, BK = 64, HALF = 128, HTB = HALF * BK * 2, STAGE_BYTES = 8 * HTB;
__host__ __device__ __forceinline__ int lds_byte(int r, int c) { const int st = (r >> 4) * 2 + (c >> 5), rr = r & 15, cc = c & 31, ob = rr * 64 + cc * 2; return st * 1024 + (ob ^ (((ob >> 9) & 1) << 5)); }
__host__ __device__ __forceinline__ void stage_rc(int b, int& R, int& C) { const int st = b / 1024, sb = b % 1024, swz = sb ^ (((sb >> 9) & 1) << 5); R = (st >> 1) * 16 + swz / 64; C = (st & 1) * 32 + (swz % 64) / 2; }
__host__ __device__ __forceinline__ int perm32(int rho) { const int n = rho >> 4, i = rho & 15; return 8 * (i >> 2) + 4 * n + (i & 3); }

struct Unit { int pm, pn; const char* bb; long bjump; int arow0; int acount; int aux; };
struct Gemm { const char* A; int lda; const int* gather; int ldb; int K; int bsplit; };

__device__ __forceinline__ unsigned cvt_pk_bf16(float lo, float hi) { unsigned r; asm volatile("v_cvt_pk_bf16_f32 %0, %1, %2" : "=v"(r) : "v"(lo), "v"(hi)); return r; }

template <class Epi, class Sched, bool ALIGN_EPI>
__device__ __forceinline__ void gemm_phase(LAS unsigned char* lds, const Gemm g, const Sched& S, const Epi& E, const int tid) {
    const int wid = __builtin_amdgcn_readfirstlane(tid >> 6), lane = tid & 63, wr = wid >> 2, wc = wid & 3, fr = lane & 15, fq = lane >> 4;
    const int K = g.K, nt = K / BK;
    unsigned voffB[2];
#pragma unroll
    for (int i = 0; i < 2; ++i) { int R, C; stage_rc(tid * 16 + i * 8192, R, C); const int Rb = Epi::PERM ? ((R & ~31) + perm32(R & 31)) : R; voffB[i] = (unsigned)(Rb * g.ldb + C) * 2u; }
    const size_t kstep = (size_t)(BK * 2);
    const size_t bh = (size_t)HALF * g.ldb * 2;
    const unsigned ldsw = (unsigned)wid * 1024u;
    const int aoff = lds_byte(wr * 64 + fr, fq * 8), boff = lds_byte(wc * 32 + fr, fq * 8);
    const char* const Ab = g.A;
#define PG8_SA(b, h) (((b) * 2 + (h)) * HTB)
#define PG8_SB(b, h) ((4 + (b) * 2 + (h)) * HTB)
#define PG8_STAGE(bufoff, gbase, voff) do { _Pragma("unroll") for (int _i = 0; _i < 2; ++_i) \
        __builtin_amdgcn_global_load_lds((const unsigned*)((const char*)(gbase) + (voff)[_i]), (LAS unsigned*)(lds + (bufoff) + ldsw + _i * 8192), 16, 0, 0); } while (0)
#define PG8_LDA(dst, b, h) do { _Pragma("unroll") for (int m = 0; m < 4; ++m) _Pragma("unroll") for (int k = 0; k < 2; ++k) dst[m][k] = *(const LAS bf16x8*)(lds + PG8_SA(b, h) + aoff + m * 2048 + k * 1024); } while (0)
#define PG8_LDB(dst, b, h) do { _Pragma("unroll") for (int n = 0; n < 2; ++n) _Pragma("unroll") for (int k = 0; k < 2; ++k) dst[n][k] = *(const LAS bf16x8*)(lds + PG8_SB(b, h) + boff + n * 2048 + k * 1024); } while (0)
#define PG8_MMA(ai, bj, At, Bt) do { __builtin_amdgcn_s_setprio(1); _Pragma("unroll") for (int m = 0; m < 4; ++m) _Pragma("unroll") for (int n = 0; n < 2; ++n) _Pragma("unroll") for (int k = 0; k < 2; ++k) \
        acc[ai][bj][m][n] = __builtin_amdgcn_mfma_f32_16x16x32_bf16(Bt[n][k], At[m][k], acc[ai][bj][m][n], 0, 0, 0); __builtin_amdgcn_s_setprio(0); } while (0)
#define PG8_WAIT_V(n) asm volatile("s_waitcnt vmcnt(" #n ")" ::: "memory")
#define PG8_WAIT_L(n) asm volatile("s_waitcnt lgkmcnt(" #n ")" ::: "memory")
#define PG8_BAR __builtin_amdgcn_s_barrier()
#define PG8_SCHED __builtin_amdgcn_sched_barrier(0)
#define PG8_AOFFS(u, o) do { _Pragma("unroll") for (int _h = 0; _h < 2; ++_h) _Pragma("unroll") for (int _i = 0; _i < 2; ++_i) { int _R, _C; stage_rc(tid * 16 + _i * 8192, _R, _C); const int _r = _h * HALF + _R; \
        int _row; if (g.gather) { _row = (_r < (u).acount) ? g.gather[(u).arow0 + _r] : 0; } else { _row = (u).arow0 + _r; } (o)[_h][_i] = (unsigned)(_row * g.lda + _C) * 2u; } } while (0)
#define PG8_BKO(u, tt) ((size_t)(tt) * kstep + (((tt) >= g.bsplit) ? (size_t)(u).bjump : (size_t)0))
    Unit cur, nxt; int ui = 0;
    if (!S.next(0, cur)) return;
    f32x4 acc[2][2][4][2];
#pragma unroll
    for (int a = 0; a < 2; ++a)
#pragma unroll
        for (int b = 0; b < 2; ++b)
#pragma unroll
            for (int m = 0; m < 4; ++m)
#pragma unroll
                for (int n = 0; n < 2; ++n) acc[a][b][m][n] = (f32x4){0.f, 0.f, 0.f, 0.f};
    bf16x8 At[4][2], B0[2][2], B1[2][2];
    unsigned cao[2][2];
    LAS u32x4* const naol = (LAS u32x4*)(lds + STAGE_BYTES + 1024) + tid;
    PG8_AOFFS(cur, cao);
    const char* cB = cur.bb;
    PG8_STAGE(PG8_SB(0, 0), cB, voffB); PG8_STAGE(PG8_SB(0, 1), cB + bh, voffB); PG8_STAGE(PG8_SA(0, 0), Ab, cao[0]); PG8_STAGE(PG8_SA(0, 1), Ab, cao[1]);
    if (wr == 1) PG8_BAR;
    PG8_WAIT_V(2); PG8_BAR;
    PG8_STAGE(PG8_SB(1, 0), cB + kstep, voffB); PG8_STAGE(PG8_SA(1, 0), Ab + kstep, cao[0]); PG8_STAGE(PG8_SB(1, 1), cB + bh + kstep, voffB);
    PG8_WAIT_V(6); PG8_BAR;
    for (;;) {
        const bool has_next = S.next(ui + 1, nxt);
        const char* nB = cB;
        { unsigned nao[2][2];
          if (has_next) { PG8_AOFFS(nxt, nao); nB = nxt.bb; }
          else {
#pragma unroll
            for (int h = 0; h < 2; ++h)
#pragma unroll
                for (int i = 0; i < 2; ++i) nao[h][i] = cao[h][i];
          }
          *naol = (u32x4){nao[0][0], nao[0][1], nao[1][0], nao[1][1]}; }
#pragma unroll 1
        for (int t = 0; t < nt; t += 2) {
            const bool last = (t == nt - 2);
            const char* a1 = Ab + (size_t)(t + 1) * kstep;
            const char* a2 = last ? Ab : Ab + (size_t)(t + 2) * kstep;
            const char* a3 = a2 + kstep;
            const char* b2 = last ? nB : cB + PG8_BKO(cur, t + 2);
            const char* b3 = last ? nB + kstep : cB + PG8_BKO(cur, t + 3);
            unsigned ao2[2][2];
#pragma unroll
            for (int h = 0; h < 2; ++h)
#pragma unroll
                for (int i = 0; i < 2; ++i) ao2[h][i] = cao[h][i];
            if (last) { const u32x4 v = *naol; ao2[0][0] = v.x; ao2[0][1] = v.y; ao2[1][0] = v.z; ao2[1][1] = v.w; }
            PG8_LDB(B0, 0, 0); PG8_LDB(B1, 0, 1); PG8_SCHED; PG8_LDA(At, 0, 0); PG8_STAGE(PG8_SA(1, 1), a1, cao[1]);
            PG8_WAIT_V(8); PG8_WAIT_L(0); PG8_BAR; PG8_MMA(0, 0, At, B0); PG8_MMA(0, 1, At, B1); PG8_BAR; PG8_SCHED;
            PG8_LDA(At, 0, 1); PG8_STAGE(PG8_SB(0, 0), b2, voffB); PG8_STAGE(PG8_SB(0, 1), b2 + bh, voffB); PG8_STAGE(PG8_SA(0, 0), a2, ao2[0]);
            PG8_WAIT_V(8); PG8_WAIT_L(0); PG8_BAR; PG8_MMA(1, 0, At, B0); PG8_MMA(1, 1, At, B1); PG8_BAR; PG8_SCHED;
            PG8_LDB(B0, 1, 0); PG8_LDB(B1, 1, 1); PG8_SCHED; PG8_LDA(At, 1, 0); PG8_STAGE(PG8_SA(0, 1), a2, ao2[1]);
            PG8_WAIT_V(8); PG8_WAIT_L(0); PG8_BAR; PG8_MMA(0, 0, At, B0); PG8_MMA(0, 1, At, B1); PG8_BAR; PG8_SCHED;
            PG8_LDA(At, 1, 1); PG8_STAGE(PG8_SB(1, 0), b3, voffB); PG8_STAGE(PG8_SB(1, 1), b3 + bh, voffB); PG8_STAGE(PG8_SA(1, 0), a3, ao2[0]);
            PG8_WAIT_V(8); PG8_WAIT_L(0); PG8_BAR; PG8_MMA(1, 0, At, B0); PG8_MMA(1, 1, At, B1); PG8_BAR; PG8_SCHED;
        }
        if constexpr (ALIGN_EPI) { if (wr == 0) PG8_BAR; }
        { int t2_ = tid; asm volatile("" : "+v"(t2_)); const int l2_ = t2_ & 63; E(acc, cur, wr, wc, l2_ & 15, l2_ >> 4); }
        if (!has_next) break;
#pragma unroll
        for (int a = 0; a < 2; ++a)
#pragma unroll
            for (int b = 0; b < 2; ++b)
#pragma unroll
                for (int m = 0; m < 4; ++m)
#pragma unroll
                    for (int n = 0; n < 2; ++n) acc[a][b][m][n] = (f32x4){0.f, 0.f, 0.f, 0.f};
        cur = nxt; cB = nB; ++ui;
        { const u32x4 v = *naol; cao[0][0] = v.x; cao[0][1] = v.y; cao[1][0] = v.z; cao[1][1] = v.w; }
        if constexpr (ALIGN_EPI) { if (wr == 1) PG8_BAR; }
    }
    PG8_WAIT_V(0);
    if constexpr (!ALIGN_EPI) { if (wr == 0) PG8_BAR; }
    PG8_BAR;
#undef PG8_SA
#undef PG8_SB
#undef PG8_STAGE
#undef PG8_LDA
#undef PG8_LDB
#undef PG8_MMA
#undef PG8_WAIT_V
#undef PG8_WAIT_L
#undef PG8_BAR
#undef PG8_SCHED
#undef PG8_AOFFS
#undef PG8_BKO
}
}

constexpr int BATCH = 16, SEQ = 2048, T = BATCH * SEQ, D = 1024, NIN = 2304, NL = 2;
constexpr int CC = 256, CP = 256, CA = 512, NH = 4, DH = 64, DV = 128, CW = 31;
constexpr int NE = 16, DE = 256, NBKT = 24;
constexpr float EPS = 1e-6f;
constexpr float QSCALE = 0.125f * 1.4426950408889634f;
constexpr int NWAVES = 8, NTHREADS = 512;

constexpr size_t MiB = 1u << 20, KiB = 1u << 10;
constexpr size_t WS_CTL = 0, CTL_ZERO_BYTES = 1 * MiB;
constexpr size_t WS_SS = 2 * MiB;
constexpr size_t WS_SS1 = 4 * MiB;
constexpr size_t WS_RS1 = 6 * MiB;
constexpr size_t WS_WTS = 6 * MiB + 256 * KiB;
constexpr size_t WS_TOKB = 6 * MiB + 512 * KiB;
constexpr size_t WS_LIST = 7 * MiB;
constexpr size_t WS_WR = 10 * MiB;
constexpr size_t WS_WPW = 10 * MiB + 512 * KiB;
constexpr size_t WS_WPOOL = 10 * MiB + 768 * KiB;
constexpr size_t WS_ERR = 11 * MiB;
constexpr size_t WS_WIN = 16 * MiB;
constexpr size_t WS_WOUT = 25 * MiB;
constexpr size_t WS_WGU = 29 * MiB;
constexpr size_t WS_WD = 61 * MiB;
constexpr size_t WS_XB = 80 * MiB;
constexpr size_t WS_X1B = 144 * MiB;
constexpr size_t WS_MIX = 208 * MiB;
constexpr size_t WS_U = 272 * MiB;
constexpr size_t WS_PIN = 288 * MiB;
constexpr size_t WS_Q = 304 * MiB;
constexpr size_t WS_K = 336 * MiB;
constexpr size_t WS_V = 368 * MiB;
constexpr size_t WS_ACT = 400 * MiB;
constexpr size_t WS_DBG = 440 * MiB;
constexpr size_t WS_END = 512 * MiB;
constexpr int CW_BAR = 4096;
constexpr int CW_CNT = 16384;
constexpr int RING_BYTES = 131072;
constexpr int MISC_OFF = RING_BYTES;
constexpr int LDS_EXTRA = RING_BYTES + 1024;
constexpr int LDS_BYTES = 163840;

#define LDS_WAIT() asm volatile("s_waitcnt lgkmcnt(0)" ::: "memory")
#define VM_WAIT() asm volatile("s_waitcnt vmcnt(0)" ::: "memory")

#define XB_TMO      128
#define XB_XCNT(j)  (256  + 64 * (j))
#define XB_XSUB(j)  (1280 + 64 * (j))
#define XB_XGEN(j)  (2304 + 64 * (j))
#define XB_TOP      3328
#define XB_TOPGEN   3392
#define XCD_BAR_WORDS 3456
#define XB_SPIN_CAP (1u << 22)
__device__ __forceinline__ unsigned xb_ld(unsigned* p)              { return __hip_atomic_load(p, __ATOMIC_RELAXED, __HIP_MEMORY_SCOPE_AGENT); }
__device__ __forceinline__ unsigned xb_add(unsigned* p, unsigned v) { return __hip_atomic_fetch_add(p, v, __ATOMIC_RELAXED, __HIP_MEMORY_SCOPE_AGENT); }
__device__ __forceinline__ unsigned xb_xcc_id() { return (unsigned)__builtin_amdgcn_s_getreg((3 << 11) | 20) & 0xFu; }
#define XB_SPIN(cond, bar) do { unsigned _sp = 0; while (cond) { __builtin_amdgcn_s_sleep(1); \
    if ((++_sp & 255u) == 0u) { if (xb_ld(&(bar)[XB_TMO])) break; if (_sp > XB_SPIN_CAP) { atomicAdd(&(bar)[XB_TMO], 1u); break; } } } } while (0)
struct XcdBarrier { unsigned* bar; unsigned x; volatile LAS unsigned* st; };
__device__ __forceinline__ XcdBarrier xcd_barrier_post(unsigned* bar, volatile LAS unsigned* st) {
    XcdBarrier b; b.bar = bar; b.x = xb_xcc_id(); b.st = st;
    if (threadIdx.x == 0) (void)xb_add(&bar[XB_XCNT(b.x)], 1u);
    return b;
}
__device__ __forceinline__ void xcd_barrier_complete(unsigned* bar, unsigned x, unsigned& nloc, unsigned& nx) {
    const unsigned G = gridDim.x * gridDim.y * gridDim.z;
    unsigned sum, cnt, mine, sp = 0u;
    for (;;) {
        sum = 0u; cnt = 0u; mine = 0u;
#pragma unroll
        for (unsigned j = 0; j < 16; ++j) { const unsigned c = xb_ld(&bar[XB_XCNT(j)]); sum += c; cnt += (c > 0u) ? 1u : 0u; mine = (j == x) ? c : mine; }
        if (sum == G) break;
        __builtin_amdgcn_s_sleep(1);
        if ((++sp & 255u) == 0u) { if (xb_ld(&bar[XB_TMO])) break; if (sp > XB_SPIN_CAP) { atomicAdd(&bar[XB_TMO], 1u); break; } }
    }
    nloc = mine > 0u ? mine : 1u; nx = cnt > 0u ? cnt : 1u;
}
__device__ __forceinline__ void xcd_barrier(const XcdBarrier& b) {
    asm volatile("s_waitcnt vmcnt(0)" ::: "memory");
    __syncthreads();
    if (threadIdx.x == 0) {
        unsigned* bar = b.bar;
        __builtin_amdgcn_s_waitcnt(0);
        unsigned nloc = b.st[0], nx = b.st[1];
        if (nloc == 0u) { xcd_barrier_complete(bar, b.x, nloc, nx); b.st[0] = nloc; b.st[1] = nx; }
        const unsigned old = xb_add(&bar[XB_XSUB(b.x)], 1u);
        const unsigned gen = old / nloc;
        if (old + 1u == (gen + 1u) * nloc) {
            __builtin_amdgcn_fence(__ATOMIC_RELEASE, "agent");
            asm volatile("s_waitcnt vmcnt(0)" ::: "memory");
            const unsigned og = xb_add(&bar[XB_TOP], 1u);
            const unsigned tg = og / nx;
            if (og + 1u == (tg + 1u) * nx) xb_add(&bar[XB_TOPGEN], 1u);
            else XB_SPIN(xb_ld(&bar[XB_TOPGEN]) == tg, bar);
            __builtin_amdgcn_fence(__ATOMIC_ACQUIRE, "agent");
            xb_add(&bar[XB_XGEN(b.x)], 1u);
            asm volatile("s_waitcnt vmcnt(0)" ::: "memory");
        } else {
            XB_SPIN(xb_ld(&bar[XB_XGEN(b.x)]) == gen, bar);
            __builtin_amdgcn_fence(__ATOMIC_ACQUIRE, "agent");
            asm volatile("s_waitcnt vmcnt(0)" ::: "memory");
        }
    }
    __syncthreads();
}

struct Args { const float* in[27]; float* out; unsigned char* ws; int ph_lo, ph_hi; };
enum { I_X = 0, I_ANG, I_WIN, I_CW, I_CB, I_CLG, I_CLB, I_CPW, I_CPB, I_PW, I_PS, I_QG, I_KG, I_LQ1, I_LK1, I_LQ2, I_LK2, I_ASG, I_WOUT, I_FNG, I_RGW, I_RGB, I_REW, I_REB, I_WG, I_WU, I_WDN };

struct Frame {
    LAS unsigned char* lds;
    int tid, lane, wave, vcu, G;
#ifdef PROBE_KIND
    unsigned long long pk_prev, pk_acc;
#endif
};
#ifdef PROBE_KIND
#define PK_SUB(F, kind) do { const unsigned long long t_ = __builtin_amdgcn_s_memrealtime(); if ((kind) == PROBE_KIND) (F).pk_acc += t_ - (F).pk_prev; (F).pk_prev = t_; } while (0)
#else
#define PK_SUB(F, kind) do { } while (0)
#endif

template <bool HASG> __device__ __forceinline__ void tr_item(const float* S, int ldS, int scol, int k0, const float* gk, bf16_t* Dst, int ldD, int prow0, LAS unsigned char* scr, int lane) {
    const float* sp = S + (size_t)k0 * ldS + scol;
    float v[64]; f32x4 g4[16];
    if (HASG) {
#pragma unroll
        for (int i = 0; i < 16; ++i) g4[i] = *(const f32x4*)(gk + k0 + 4 * i);
    }
#pragma unroll
    for (int i = 0; i < 64; ++i) v[i] = sp[(size_t)i * ldS];
    asm volatile("" ::: "memory");
    unsigned w[32];
#pragma unroll
    for (int i = 0; i < 32; ++i) { float a = v[2 * i], b = v[2 * i + 1]; if (HASG) { a *= g4[i >> 1][(2 * i) & 3]; b *= g4[i >> 1][(2 * i + 1) & 3]; } w[i] = pk2(a, b); }
#pragma unroll
    for (int j = 0; j < 8; ++j) *(LAS u32x4*)(scr + lane * 144 + j * 16) = (u32x4){w[4 * j], w[4 * j + 1], w[4 * j + 2], w[4 * j + 3]};
    LDS_WAIT(); asm volatile("" ::: "memory");
#pragma unroll
    for (int j = 0; j < 8; ++j) { const int r = 8 * j + (lane >> 3), c = lane & 7; const u32x4 v = *(const LAS u32x4*)(scr + r * 144 + c * 16);
        *(u32x4*)(Dst + (size_t)(prow0 + r) * ldD + k0 + 8 * c) = v; }
    LDS_WAIT(); asm volatile("" ::: "memory");
}
__device__ __forceinline__ int win_logical(int p0) {
    const int pn = p0 >> 8, c = p0 & 255;
    if (pn < 2) return (c < 128) ? (pn * 128 + c) : (256 + pn * 128 + (c - 128));
    if (pn == 2) return 512 + c;
    if (pn < 7) { const int bj = c >> 7, wc = (c >> 5) & 3; return 768 + (pn - 3) * 256 + 64 * wc + 32 * bj; }
    return 1792 + (pn - 7) * 256 + c;
}
__device__ __forceinline__ void p0_prologue(const Args& args, Frame& F) {
    unsigned char* ws = args.ws;
    const int gw = F.vcu * NWAVES + F.wave, NGW = F.G * NWAVES, lane = F.lane;
    LAS unsigned char* scr = F.lds + F.wave * 16384;
    constexpr int I_IN = 16 * 36, I_OUT = 16 * 16, I_GU = 16 * 8 * 16, I_DN = 4 * 16 * 16, I_PWI = 4 * 4, I_PL = 4;
    constexpr int PER_L = I_IN + I_OUT + I_GU + I_DN + I_PWI + I_PL;
    for (int it = gw; it < NL * PER_L; it += NGW) {
        const int itu = __builtin_amdgcn_readfirstlane(it); const int l = itu / PER_L; int r = itu % PER_L;
        if (r < I_IN) { const int kb = r / 36, pb = r % 36; const int p = pb * 64 + lane;
            tr_item<true>(args.in[I_WIN] + (size_t)l * D * NIN, NIN, win_logical(p & ~31) + (p & 31), kb * 64, args.in[I_ANG] + l * D, (bf16_t*)(ws + WS_WIN) + (size_t)l * NIN * D, D, pb * 64, scr, lane); continue; }
        r -= I_IN;
        if (r < I_OUT) { const int kb = r / 16, pb = r % 16; const int p = pb * 64 + lane;
            tr_item<false>(args.in[I_WOUT] + (size_t)l * D * D, D, p, kb * 64, nullptr, (bf16_t*)(ws + WS_WOUT) + (size_t)l * D * D, D, pb * 64, scr, lane); continue; }
        r -= I_OUT;
        if (r < I_GU) { const int e = r / 128, q = r % 128, kb = q / 8, pb = q % 8; const int p = pb * 64 + lane;
            const int half = p >> 8, gu = (p >> 7) & 1, i0 = p & 127; const float* src = (gu ? args.in[I_WU] : args.in[I_WG]) + (size_t)(l * NE + e) * D * DE;
            tr_item<true>(src, DE, half * 128 + i0, kb * 64, args.in[I_FNG] + l * D, (bf16_t*)(ws + WS_WGU) + (size_t)(l * NE + e) * 512 * D, D, pb * 64, scr, lane); continue; }
        r -= I_GU;
        if (r < I_DN) { const int e = r / 64, q = r % 64, kb = q / 16, pb = q % 16; const int p = pb * 64 + lane;
            tr_item<false>(args.in[I_WDN] + (size_t)(l * NE + e) * DE * D, D, p, kb * 64, nullptr, (bf16_t*)(ws + WS_WD) + (size_t)(l * NE + e) * D * DE, DE, pb * 64, scr, lane); continue; }
        r -= I_DN;
        if (r < I_PWI) { const int kb = r / 4, pb = r % 4; const int p = pb * 64 + lane;
            tr_item<false>(args.in[I_CPW] + (size_t)l * CC * CC, CC, p, kb * 64, nullptr, (bf16_t*)(ws + WS_WPW) + (size_t)l * CC * CC, CC, pb * 64, scr, lane); continue; }
        r -= I_PWI;
        { const int gi = r;
            tr_item<false>(args.in[I_PW] + (size_t)(l * 4 + gi) * 64 * 64, 64, lane, 0, nullptr, (bf16_t*)(ws + WS_WPOOL) + (size_t)(l * 4 + gi) * 64 * 64, 64, 0, scr, lane); }
    }
    PK_SUB(F, 7);
    for (int i = (F.vcu * NTHREADS + F.tid); i < NL * 32 * D; i += F.G * NTHREADS) {
        const int l = i / (32 * D), j = (i / D) % 32, k = i % D;
        float w = 0.f; if (j < 4) w = args.in[I_RGW][(size_t)(l * D + k) * 4 + j]; else if (j < 20) w = args.in[I_REW][(size_t)(l * D + k) * 16 + (j - 4)];
        w *= args.in[I_FNG][l * D + k];
        const unsigned h = f2bf(w); const unsigned lo = f2bf(w - bf2f(h));
        bf16_t* base = (bf16_t*)(ws + WS_WR) + (size_t)l * 2 * 32 * D;
        base[(size_t)j * D + k] = (bf16_t)h; base[(size_t)(32 + j) * D + k] = (bf16_t)lo;
    }
    PK_SUB(F, 8);
    for (int m0 = gw * 4; m0 < T; m0 += NGW * 4) {
        f32x4 v[4][4];
#pragma unroll
        for (int r = 0; r < 4; ++r) { const GAS f32x4* xr = (const GAS f32x4*)(args.in[I_X] + (size_t)(m0 + r) * D) + lane;
#pragma unroll
            for (int j = 0; j < 4; ++j) v[r][j] = xr[64 * j]; }
#pragma unroll
        for (int r = 0; r < 4; ++r) { const int m = m0 + r; GAS unsigned long long* o8 = (GAS unsigned long long*)((bf16_t*)(ws + WS_XB) + (size_t)m * D) + lane; float s = 0.f;
#pragma unroll
            for (int j = 0; j < 4; ++j) { const f32x4 x = v[r][j]; s += (x.x * x.x + x.y * x.y) + (x.z * x.z + x.w * x.w); o8[64 * j] = (unsigned long long)pk2(x.x, x.y) | ((unsigned long long)pk2(x.z, x.w) << 32); }
            s = wave_sum(s);
            if (lane < 16) ((float*)(ws + WS_SS))[(size_t)m * 16 + lane] = (lane == 0) ? s : 0.f; }
    }
}

struct DenseOrder {
    int nM, nN, nwg, G, c; const char* Bt; size_t btile;
    __device__ void init(int M, int N, int G_, int c_, const void* Bt_, int ldb) { nM = M / 256; nN = N / 256; nwg = nM * nN; G = G_; c = c_; Bt = (const char*)Bt_; btile = (size_t)256 * ldb * 2; }
    __device__ __forceinline__ bool next(int i, pg8::Unit& u) const {
        const long L = (long)i * G + c; if (L >= nwg) return false;
        int wgid = (int)L; { const int q = nwg / 8, r = nwg % 8, xcd = wgid % 8, off = wgid / 8; wgid = (xcd < r ? xcd * (q + 1) : r * (q + 1) + (xcd - r) * q) + off; }
        const int nig = 8 * nN, gid = wgid / nig, fm = gid * 8, gsz = (nM - fm) < 8 ? (nM - fm) : 8;
        u.pm = fm + ((wgid % nig) % gsz); u.pn = (wgid % nig) / gsz;
        u.bb = Bt + (size_t)u.pn * btile; u.bjump = 0; u.arow0 = u.pm * 256; u.acount = 256; u.aux = 0; return true;
    }
};
struct MoeOrder {
    const LAS int* ti; int G, c, l, mode; const char* W;
    __device__ __forceinline__ bool next(int i, pg8::Unit& u) const {
        const int NT = __builtin_amdgcn_readfirstlane(ti[0]); const int nwg = NT * 4;
        const long L = (long)i * G + c; if (L >= nwg) return false;
        int wgid = (int)L; { const int q = nwg / 8, r = nwg % 8, xcd = wgid % 8, off = wgid / 8; wgid = (xcd < r ? xcd * (q + 1) : r * (q + 1) + (xcd - r) * q) + off; }
        const int rt = wgid >> 2, pn = wgid & 3;
        const int inf = __builtin_amdgcn_readfirstlane(ti[2 + 2 * rt]); const int b = inf & 255, lt = inf >> 8;
        const int grp = b / 6, pi = b % 6;
        const int lo = (pi < 3) ? 0 : (pi < 5 ? 1 : 2), hi = (pi < 3) ? pi + 1 : (pi < 5 ? pi - 1 : 3);
        const int e0 = grp * 4 + lo, e1 = grp * 4 + hi;
        u.pm = rt; u.pn = pn; u.acount = __builtin_amdgcn_readfirstlane(ti[3 + 2 * rt]);
        if (mode == 1) { const int e = (pn < 2) ? e0 : e1; u.bb = W + ((size_t)(l * NE + e) * 512 + (size_t)(pn & 1) * 256) * D * 2; u.bjump = 0; u.arow0 = b * T + lt * 256; u.aux = b; }
        else { u.bb = W + ((size_t)(l * NE + e0) * D + (size_t)pn * 256) * DE * 2; u.bjump = (long)(e1 - e0) * D * DE * 2 - 4 * 128; u.arow0 = rt * 256; u.aux = b * T + lt * 256; }
        return true;
    }
};

__device__ __forceinline__ float sigmoidf_(float x) { return __frcp_rn(1.f + __expf(-x)); }
__device__ __forceinline__ float row_rstd16(const float* p) {
    const f32x4 a = ((const f32x4*)p)[0], b = ((const f32x4*)p)[1], c = ((const f32x4*)p)[2], d = ((const f32x4*)p)[3];
    const float s = ((a.x + a.y) + (a.z + a.w)) + ((b.x + b.y) + (b.z + b.w)) + ((c.x + c.y) + (c.z + c.w)) + ((d.x + d.y) + (d.z + d.w));
    return rsqrtf(s * (1.f / D) + EPS);
}
__device__ __forceinline__ u32x4 pack8(const f32x4 a, const f32x4 b) { u32x4 w; w.x = pg8::cvt_pk_bf16(a[0], a[1]); w.y = pg8::cvt_pk_bf16(a[2], a[3]); w.z = pg8::cvt_pk_bf16(b[0], b[1]); w.w = pg8::cvt_pk_bf16(b[2], b[3]); return w; }

struct EpiInProj {
    static constexpr bool PERM = true;
    const float* SS; bf16_t *U, *PIN, *Q, *Kb, *V; const float *qg, *kg;
    __device__ __forceinline__ void operator()(const f32x4 (&acc)[2][2][4][2], const pg8::Unit& u, int wr, int wc, int fr, int fq) const {
        const int row0 = u.pm * 256 + wr * 64 + fr, pn = u.pn;
        if (pn < 2) {
#pragma unroll
            for (int ai = 0; ai < 2; ++ai)
#pragma unroll
                for (int m = 0; m < 4; ++m) { const int row = row0 + ai * 128 + m * 16; const float rs = row_rstd16(SS + (size_t)row * 16);
                    f32x4 o[2];
#pragma unroll
                    for (int n = 0; n < 2; ++n) { const f32x4 v = acc[ai][0][m][n] * rs, g = acc[ai][1][m][n] * rs;
                        o[n] = (f32x4){v[0] * sigmoidf_(g[0]), v[1] * sigmoidf_(g[1]), v[2] * sigmoidf_(g[2]), v[3] * sigmoidf_(g[3])}; }
                    *(u32x4*)(U + (size_t)row * CC + pn * 128 + wc * 32 + 8 * fq) = pack8(o[0], o[1]); }
        } else if (pn == 2 || pn >= 7) {
            bf16_t* dst = (pn == 2) ? PIN : V; const int ld = (pn == 2) ? CP : CA; const int cb = (pn == 2) ? 0 : (pn - 7) * 256;
#pragma unroll
            for (int ai = 0; ai < 2; ++ai)
#pragma unroll
                for (int m = 0; m < 4; ++m) { const int row = row0 + ai * 128 + m * 16; const float rs = row_rstd16(SS + (size_t)row * 16);
#pragma unroll
                    for (int bj = 0; bj < 2; ++bj) *(u32x4*)(dst + (size_t)row * ld + cb + bj * 128 + wc * 32 + 8 * fq) = pack8(acc[ai][bj][m][0] * rs, acc[ai][bj][m][1] * rs); }
        } else {
            const bool isq = pn < 5; bf16_t* dst = isq ? Q : Kb; const float* gn = isq ? qg : kg; const int hs = (isq ? (pn - 3) : (pn - 5)) * 4 + wc;
            f32x4 gv[2][2];
#pragma unroll
            for (int bj = 0; bj < 2; ++bj)
#pragma unroll
                for (int n = 0; n < 2; ++n) gv[bj][n] = *(const f32x4*)(gn + 32 * bj + 8 * fq + 4 * n);
#pragma unroll
            for (int ai = 0; ai < 2; ++ai)
#pragma unroll
                for (int m = 0; m < 4; ++m) { const int row = row0 + ai * 128 + m * 16; const float rs = row_rstd16(SS + (size_t)row * 16);
                    f32x4 z[2][2]; float ss = 0.f;
#pragma unroll
                    for (int bj = 0; bj < 2; ++bj)
#pragma unroll
                        for (int n = 0; n < 2; ++n) { z[bj][n] = acc[ai][bj][m][n] * rs; const f32x4 q = z[bj][n] * z[bj][n]; ss += (q[0] + q[1]) + (q[2] + q[3]); }
                    ss += __shfl_xor(ss, 16); ss += __shfl_xor(ss, 32);
                    const float r = rsqrtf(ss * (1.f / DH) + EPS) * (isq ? QSCALE : 1.f);
#pragma unroll
                    for (int bj = 0; bj < 2; ++bj) *(u32x4*)(dst + (size_t)row * CA + hs * 64 + 32 * bj + 8 * fq) = pack8(z[bj][0] * r * gv[bj][0], z[bj][1] * r * gv[bj][1]); }
        }
    }
};

struct EpiOutProj {
    static constexpr bool PERM = true;
    const bf16_t* XB; bf16_t* X1B; float* SS1;
    __device__ __forceinline__ void operator()(const f32x4 (&acc)[2][2][4][2], const pg8::Unit& u, int wr, int wc, int fr, int fq) const {
        const int row0 = u.pm * 256 + wr * 64 + fr, col0 = u.pn * 256 + wc * 32 + 8 * fq;
#pragma unroll
        for (int ai = 0; ai < 2; ++ai)
#pragma unroll
            for (int m = 0; m < 4; ++m) { const int row = row0 + ai * 128 + m * 16; float ss = 0.f;
#pragma unroll
                for (int bj = 0; bj < 2; ++bj) { const size_t off = (size_t)row * D + col0 + bj * 128; const u32x4 xi = *(const u32x4*)(XB + off);
                    const f32x4 a = acc[ai][bj][m][0], b = acc[ai][bj][m][1]; u32x4 w;
                    w.x = pg8::cvt_pk_bf16(bf2f(xi.x & 0xffffu) + a[0], __uint_as_float(xi.x & 0xffff0000u) + a[1]); w.y = pg8::cvt_pk_bf16(bf2f(xi.y & 0xffffu) + a[2], __uint_as_float(xi.y & 0xffff0000u) + a[3]);
                    w.z = pg8::cvt_pk_bf16(bf2f(xi.z & 0xffffu) + b[0], __uint_as_float(xi.z & 0xffff0000u) + b[1]); w.w = pg8::cvt_pk_bf16(bf2f(xi.w & 0xffffu) + b[2], __uint_as_float(xi.w & 0xffff0000u) + b[3]);
                    *(u32x4*)(X1B + off) = w;
#pragma unroll
                    for (int q = 0; q < 4; ++q) { const float lo = bf2f(w[q] & 0xffffu), hi = __uint_as_float(w[q] & 0xffff0000u); ss += lo * lo + hi * hi; } }
                ss += __shfl_xor(ss, 16); ss += __shfl_xor(ss, 32);
                if (fq == 0) SS1[(size_t)row * 16 + u.pn * 4 + wc] = ss; }
    }
};

struct EpiMoe1 {
    static constexpr bool PERM = true;
    const int* LIST; const float* RS1; const float* WTS; bf16_t* ACT;
    __device__ __forceinline__ void operator()(const f32x4 (&acc)[2][2][4][2], const pg8::Unit& u, int wr, int wc, int fr, int fq) const {
        const int pn = u.pn;
#pragma unroll
        for (int ai = 0; ai < 2; ++ai)
#pragma unroll
            for (int m = 0; m < 4; ++m) { const int r = ai * 128 + wr * 64 + m * 16 + fr; const int tok = (r < u.acount) ? LIST[u.arow0 + r] : 0;
                const float rs = RS1[tok], w = WTS[tok * 2 + (pn >> 1)];
                f32x4 o[2];
#pragma unroll
                for (int n = 0; n < 2; ++n) { const f32x4 g = acc[ai][0][m][n] * rs, uu = acc[ai][1][m][n] * (rs * w);
                    o[n] = (f32x4){g[0] * sigmoidf_(g[0]) * uu[0], g[1] * sigmoidf_(g[1]) * uu[1], g[2] * sigmoidf_(g[2]) * uu[2], g[3] * sigmoidf_(g[3]) * uu[3]}; }
                *(u32x4*)(ACT + (size_t)(u.pm * 256 + r) * 512 + (pn >> 1) * 256 + (pn & 1) * 128 + wc * 32 + 8 * fq) = pack8(o[0], o[1]); }
    }
};

struct EpiMoe2 {
    static constexpr bool PERM = true;
    const int* LIST; const bf16_t* X1B; float* out; bf16_t* XB; float* SS; int last;
    __device__ __forceinline__ void operator()(const f32x4 (&acc)[2][2][4][2], const pg8::Unit& u, int wr, int wc, int fr, int fq) const {
        const int col0 = u.pn * 256 + wc * 32 + 8 * fq;
#pragma unroll
        for (int ai = 0; ai < 2; ++ai)
#pragma unroll
            for (int m = 0; m < 4; ++m) { const int r = ai * 128 + wr * 64 + m * 16 + fr; const bool valid = r < u.acount; float ss = 0.f; int tok = 0;
                if (valid) { tok = LIST[u.aux + r];
#pragma unroll
                    for (int bj = 0; bj < 2; ++bj) { const size_t off = (size_t)tok * D + col0 + bj * 128; const u32x4 xi = *(const u32x4*)(X1B + off);
                        const f32x4 a = acc[ai][bj][m][0], b = acc[ai][bj][m][1];
                        const f32x4 xa = (f32x4){bf2f(xi.x & 0xffffu) + a[0], __uint_as_float(xi.x & 0xffff0000u) + a[1], bf2f(xi.y & 0xffffu) + a[2], __uint_as_float(xi.y & 0xffff0000u) + a[3]};
                        const f32x4 xb = (f32x4){bf2f(xi.z & 0xffffu) + b[0], __uint_as_float(xi.z & 0xffff0000u) + b[1], bf2f(xi.w & 0xffffu) + b[2], __uint_as_float(xi.w & 0xffff0000u) + b[3]};
                        if (last) { *(f32x4*)(out + off) = xa; *(f32x4*)(out + off + 4) = xb; }
                        else { const u32x4 w = pack8(xa, xb); *(u32x4*)(XB + off) = w;
#pragma unroll
                            for (int q = 0; q < 4; ++q) { const float lo = bf2f(w[q] & 0xffffu), hi = __uint_as_float(w[q] & 0xffff0000u); ss += lo * lo + hi * hi; } } } }
                ss += __shfl_xor(ss, 16); ss += __shfl_xor(ss, 32);
                if (valid && fq == 0 && !last) SS[(size_t)tok * 16 + u.pn * 4 + wc] = ss;
                asm volatile("" ::: "memory"); }
    }
};

__device__ __forceinline__ int crow(int r, int hi) { return (r & 3) + 8 * (r >> 2) + 4 * hi; }
typedef short v4i16_t __attribute__((ext_vector_type(4)));
__device__ __forceinline__ s16x4 vtr(const LAS unsigned char* p) { return __builtin_bit_cast(s16x4, __builtin_amdgcn_ds_read_tr16_b64_v4i16((LAS v4i16_t*)p)); }
constexpr int AT_K = 0, AT_V = 32768;

__device__ __forceinline__ void attn_unit(const Args& args, Frame& F, int l, int b, int h, int qb, float lam, float lam_init, float smax2) {
    int tid = F.tid; asm volatile("" : "+v"(tid)); const int lane = tid & 63, wave = F.wave, r32 = lane & 31, hi = lane >> 5;
    const int mp = wave >> 2, rg = wave & 3;
    LAS unsigned char* lds = F.lds;
    const bf16_t* Qg = (const bf16_t*)(args.ws + WS_Q); const bf16_t* Kg = (const bf16_t*)(args.ws + WS_K); const bf16_t* Vg = (const bf16_t*)(args.ws + WS_V);
    bf16_t* MIX = (bf16_t*)(args.ws + WS_MIX);
    const int q0 = qb * 128, nt = 2 * qb + 2; const int q0x = q0;
    const int qpos = q0 + 32 * rg + r32;
    const size_t rowb = (size_t)b * SEQ;
    const float slope = (h == 0) ? 0.25f : (h == 1) ? 0.0625f : (h == 2) ? 0.015625f : 0.00390625f;
    const float sl2 = slope * 1.4426950408889634f;
    const int dcut = (int)((smax2 + 34.f) / sl2) + 1; const int j_lo = (q0x - dcut > 0) ? ((q0x - dcut) >> 6) : 0;
    int srow[2], sch[2]; unsigned kdst[2], vdst[2];
#pragma unroll
    for (int i = 0; i < 2; ++i) { const int c = tid + 512 * i; srow[i] = c >> 4; sch[i] = c & 15; const int row = srow[i], ch = sch[i];
        kdst[i] = (unsigned)(AT_K + (ch >> 3) * 8192 + row * 128 + (((ch & 7) ^ ((row >> 1) & 7)) << 4));
        vdst[i] = (unsigned)(AT_V + 256 * row + 16 * (ch ^ (((row & 3) << 2) | ((row >> 2) & 3)))); }
    u32x4 kst[2], vst[2];
#define AT_LOAD(j) do { _Pragma("unroll") for (int i = 0; i < 2; ++i) { const size_t g_ = ((rowb + (size_t)(j) * 64 + srow[i]) * CA + h * 128) * 2 + sch[i] * 16; \
        kst[i] = *(const u32x4*)((const char*)Kg + g_); vst[i] = *(const u32x4*)((const char*)Vg + g_); } } while (0)
#define AT_STORE(buf) do { _Pragma("unroll") for (int i = 0; i < 2; ++i) { *(LAS u32x4*)(lds + (buf) * 16384 + kdst[i]) = kst[i]; *(LAS u32x4*)(lds + (buf) * 16384 + vdst[i]) = vst[i]; } } while (0)
    AT_LOAD(j_lo);
    bf16x8 qr[4];
    { const bf16_t* qp = Qg + (rowb + qpos) * CA + h * 128 + mp * 64 + 8 * hi;
#pragma unroll
      for (int ks = 0; ks < 4; ++ks) qr[ks] = *(const bf16x8*)(qp + 16 * ks); }
    f32x16 o[4];
#pragma unroll
    for (int d = 0; d < 4; ++d) o[d] = f32x16{};
    float m_run = -INFINITY, l_run = 0.f;
    unsigned vaddr[4][2];
#pragma unroll
    for (int db = 0; db < 4; ++db)
#pragma unroll
        for (int sub = 0; sub < 2; ++sub) { const int rb = 4 * hi + 8 * sub + ((lane & 15) >> 2); const int ch = 4 * db + 2 * ((lane >> 4) & 1) + ((lane >> 1) & 1); const int x = ((rb & 3) << 2) | ((rb >> 2) & 3);
            vaddr[db][sub] = (unsigned)(AT_V + 256 * rb + 16 * (ch ^ x) + 8 * (lane & 1)); }
    AT_STORE(j_lo & 1);
    __syncthreads();
    for (int j = j_lo; j < nt; ++j) {
        const int buf = j & 1;
        if (j + 1 < nt) AT_LOAD(j + 1);
        if (64 * j <= q0 + 32 * rg + 31) {
            const LAS unsigned char* KB = lds + buf * 16384 + AT_K + mp * 8192;
            f32x16 p0, p1;
            { const float base = sl2 * (float)(64 * j - qpos + 4 * hi);
#pragma unroll
              for (int r = 0; r < 16; ++r) { p0[r] = __builtin_fmaf(sl2, (float)((r & 3) + 8 * (r >> 2)), base); p1[r] = p0[r] + 32.f * sl2; } }
#pragma unroll
            for (int ks = 0; ks < 4; ++ks) { const int cc = 2 * ks + hi;
                const bf16x8 k0 = *(const LAS bf16x8*)(KB + r32 * 128 + ((cc ^ ((r32 >> 1) & 7)) << 4));
                const bf16x8 k1 = *(const LAS bf16x8*)(KB + (r32 + 32) * 128 + ((cc ^ (((r32 + 32) >> 1) & 7)) << 4));
                p0 = __builtin_amdgcn_mfma_f32_32x32x16_bf16(k0, qr[ks], p0, 0, 0, 0);
                p1 = __builtin_amdgcn_mfma_f32_32x32x16_bf16(k1, qr[ks], p1, 0, 0, 0); }
            if (64 * j + 63 > q0 + 32 * rg) {
#pragma unroll
                for (int r = 0; r < 16; ++r) { const int kv = 64 * j + crow(r, hi); if (kv > qpos) p0[r] = -INFINITY; if (kv + 32 > qpos) p1[r] = -INFINITY; }
            }
            float mx = fmaxf(p0[0], p1[0]);
#pragma unroll
            for (int r = 1; r < 16; ++r) mx = fmaxf(mx, fmaxf(p0[r], p1[r]));
            mx = fmaxf(mx, __shfl_xor(mx, 32));
            const float m_new = fmaxf(m_run, mx);
            const float alpha = __builtin_amdgcn_exp2f(m_run - m_new);
            m_run = m_new;
            float rsum = 0.f;
#pragma unroll
            for (int r = 0; r < 16; ++r) { p0[r] = __builtin_amdgcn_exp2f(p0[r] - m_new); p1[r] = __builtin_amdgcn_exp2f(p1[r] - m_new); rsum += p0[r] + p1[r]; }
            l_run = l_run * alpha + rsum;
#pragma unroll
            for (int d = 0; d < 4; ++d)
#pragma unroll
                for (int r = 0; r < 16; ++r) o[d][r] *= alpha;
            bf16x8 pb[4];
            { u32x4 w;
              w.x = pg8::cvt_pk_bf16(p0[0], p0[1]); w.y = pg8::cvt_pk_bf16(p0[2], p0[3]); w.z = pg8::cvt_pk_bf16(p0[4], p0[5]); w.w = pg8::cvt_pk_bf16(p0[6], p0[7]); pb[0] = __builtin_bit_cast(bf16x8, w);
              w.x = pg8::cvt_pk_bf16(p0[8], p0[9]); w.y = pg8::cvt_pk_bf16(p0[10], p0[11]); w.z = pg8::cvt_pk_bf16(p0[12], p0[13]); w.w = pg8::cvt_pk_bf16(p0[14], p0[15]); pb[1] = __builtin_bit_cast(bf16x8, w);
              w.x = pg8::cvt_pk_bf16(p1[0], p1[1]); w.y = pg8::cvt_pk_bf16(p1[2], p1[3]); w.z = pg8::cvt_pk_bf16(p1[4], p1[5]); w.w = pg8::cvt_pk_bf16(p1[6], p1[7]); pb[2] = __builtin_bit_cast(bf16x8, w);
              w.x = pg8::cvt_pk_bf16(p1[8], p1[9]); w.y = pg8::cvt_pk_bf16(p1[10], p1[11]); w.z = pg8::cvt_pk_bf16(p1[12], p1[13]); w.w = pg8::cvt_pk_bf16(p1[14], p1[15]); pb[3] = __builtin_bit_cast(bf16x8, w); }
            const LAS unsigned char* VB = lds + buf * 16384;
#pragma unroll
            for (int db = 0; db < 4; ++db)
#pragma unroll
                for (int ks = 0; ks < 4; ++ks) { const s16x4 lo = vtr(VB + vaddr[db][0] + ks * 4096), h4 = vtr(VB + vaddr[db][1] + ks * 4096);
                    const bf16x8 vf = (bf16x8){lo[0], lo[1], lo[2], lo[3], h4[0], h4[1], h4[2], h4[3]};
                    o[db] = __builtin_amdgcn_mfma_f32_32x32x16_bf16(vf, pb[ks], o[db], 0, 0, 0); }
        }
        if (j + 1 < nt) AT_STORE(buf ^ 1);
        __syncthreads();
    }
#undef AT_LOAD
#undef AT_STORE
    l_run += __shfl_xor(l_run, 32);
    const float inv = 1.f / l_run;
    LAS float* X = (LAS float*)lds + rg * 4096;
    if (mp == 1) { const float f = lam * inv;
#pragma unroll
        for (int db = 0; db < 4; ++db)
#pragma unroll
            for (int r = 0; r < 16; ++r) X[(32 * db + crow(r, hi)) * 32 + r32] = o[db][r] * f; }
    __syncthreads();
    if (mp == 0) { float ss = 0.f;
#pragma unroll
        for (int db = 0; db < 4; ++db)
#pragma unroll
            for (int r = 0; r < 16; ++r) { const float v = o[db][r] * inv - X[(32 * db + crow(r, hi)) * 32 + r32]; o[db][r] = v; ss += v * v; }
        ss += __shfl_xor(ss, 32);
        const float rn = rsqrtf(ss * (1.f / DV) + EPS) * (1.f - lam_init);
        const float* gs = args.in[I_ASG] + l * DV;
        bf16_t* orow = MIX + (rowb + qpos) * D + 512 + h * 128;
#pragma unroll
        for (int db = 0; db < 4; ++db)
#pragma unroll
            for (int rr = 0; rr < 4; ++rr) { const int d0 = 32 * db + 8 * rr + 4 * hi; const f32x4 g = *(const f32x4*)(gs + d0);
                u32x2 w; w.x = pg8::cvt_pk_bf16(o[db][4 * rr] * rn * g[0], o[db][4 * rr + 1] * rn * g[1]); w.y = pg8::cvt_pk_bf16(o[db][4 * rr + 2] * rn * g[2], o[db][4 * rr + 3] * rn * g[3]);
                *(u32x2*)(orow + d0) = w; } }
    __syncthreads();
}

constexpr int LM_UH = 0, LM_Y = 49152, LM_A = 0, LM_PH = 49152, LM_D = 0;
__device__ __forceinline__ void local_unit(const Args& args, Frame& F, int l, int tile) {
    int tid = F.tid; asm volatile("" : "+v"(tid)); int lane = tid & 63; const int wave = F.wave;
#define LM_RELAUNDER() do { asm volatile("" : "+v"(tid)); lane = tid & 63; } while (0)
    LAS unsigned char* lds = F.lds;
    const int b = tile / 32, t0 = (tile % 32) * 64; const size_t row0 = (size_t)b * SEQ + t0;
    const bf16_t* U = (const bf16_t*)(args.ws + WS_U); const bf16_t* PIN = (const bf16_t*)(args.ws + WS_PIN); bf16_t* MIX = (bf16_t*)(args.ws + WS_MIX);
    u32x4 hu[6], hp[5];
#pragma unroll
    for (int q = 0; q < 6; ++q) { const int c = tid + q * NTHREADS; const int i = c >> 5, ch = c & 31; const int t = t0 - 30 + i;
        hu[q] = (u32x4){0u, 0u, 0u, 0u}; if (c < 94 * 32 && t >= 0) hu[q] = *(const u32x4*)(U + ((size_t)b * SEQ + t) * CC + ch * 8); }
#pragma unroll
    for (int q = 0; q < 5; ++q) { const int c = tid + q * NTHREADS; const int i = c >> 5, ch = c & 31; const int t = t0 - 15 + i;
        hp[q] = (u32x4){0u, 0u, 0u, 0u}; if (c < 79 * 32 && t >= 0) hp[q] = *(const u32x4*)(PIN + ((size_t)b * SEQ + t) * CP + ch * 8); }
#pragma unroll
    for (int q = 0; q < 6; ++q) { const int c = tid + q * NTHREADS; const int i = c >> 5, ch = c & 31; if (c < 94 * 32) *(LAS u32x4*)(lds + LM_UH + i * 512 + ch * 16) = hu[q]; }
    LM_RELAUNDER();
    int c2 = tid & 127, tg = tid >> 7;
    float w0[CW], w1[CW];
#pragma unroll
    for (int j = 0; j < CW; ++j) { const f32x2 w = *(const f32x2*)(args.in[I_CW] + (size_t)(l * CW + j) * CC + 2 * c2); w0[j] = w.x; w1[j] = w.y; }
    float y0[16], y1[16];
    { const f32x2 bb = *(const f32x2*)(args.in[I_CB] + l * CC + 2 * c2);
#pragma unroll
      for (int k = 0; k < 16; ++k) { y0[k] = bb.x; y1[k] = bb.y; } }
    __syncthreads();
#pragma unroll
    for (int ii = 0; ii < 46; ++ii) { const unsigned uu = *(const LAS unsigned*)(lds + LM_UH + (16 * tg + ii) * 512 + c2 * 4); const float u0 = bf2f(uu & 0xffffu), u1 = bf2f(uu >> 16);
#pragma unroll
        for (int k = 0; k < 16; ++k) if (ii - k >= 0 && ii - k <= 30) { y0[k] += w0[ii - k] * u0; y1[k] += w1[ii - k] * u1; } }
#pragma unroll
    for (int k = 0; k < 16; ++k) *(LAS f32x2*)(lds + LM_Y + ((16 * tg + k) * 256 + 2 * c2) * 4) = (f32x2){y0[k], y1[k]};
    bf16x8 pwb[2][8];
    { const bf16_t* Wp = (const bf16_t*)(args.ws + WS_WPW) + (size_t)l * CC * CC;
#pragma unroll
      for (int nf = 0; nf < 2; ++nf)
#pragma unroll
          for (int ks = 0; ks < 8; ++ks) pwb[nf][ks] = *(const bf16x8*)(Wp + (size_t)(32 * wave + 16 * nf + (lane & 15)) * CC + 32 * ks + 8 * (lane >> 4)); }
    __syncthreads();
    PK_SUB(F, 20);
    LM_RELAUNDER();
    { const f32x4 lg = *(const f32x4*)(args.in[I_CLG] + l * CC + 4 * lane), lb = *(const f32x4*)(args.in[I_CLB] + l * CC + 4 * lane);
#pragma unroll 2
      for (int i = 0; i < 8; ++i) { const int row = wave * 8 + i; const f32x4 x = *(const LAS f32x4*)(lds + LM_Y + (row * 256 + 4 * lane) * 4);
        const float mean = wave_sum((x[0] + x[1]) + (x[2] + x[3])) * (1.f / CC); const f32x4 dx = x - mean;
        const float var = wave_sum((dx[0] * dx[0] + dx[1] * dx[1]) + (dx[2] * dx[2] + dx[3] * dx[3])) * (1.f / CC); const float rstd = rsqrtf(var + EPS);
        f32x4 yv = dx * rstd * lg + lb; yv = (f32x4){yv[0] * sigmoidf_(yv[0]), yv[1] * sigmoidf_(yv[1]), yv[2] * sigmoidf_(yv[2]), yv[3] * sigmoidf_(yv[3])};
        u32x2 w; w.x = pg8::cvt_pk_bf16(yv[0], yv[1]); w.y = pg8::cvt_pk_bf16(yv[2], yv[3]);
        *(LAS u32x2*)(lds + LM_A + row * 512 + (((lane >> 1) ^ (row & 15)) << 4) + 8 * (lane & 1)) = w; } }
    __syncthreads();
    PK_SUB(F, 21);
    LM_RELAUNDER();
    { const int fr = lane & 15, fq = lane >> 4;
      f32x4 acc[4][2];
#pragma unroll
      for (int mf = 0; mf < 4; ++mf)
#pragma unroll
          for (int nf = 0; nf < 2; ++nf) acc[mf][nf] = (f32x4){0.f, 0.f, 0.f, 0.f};
#pragma unroll
      for (int ks = 0; ks < 8; ++ks) {
          bf16x8 af[4];
#pragma unroll
          for (int mf = 0; mf < 4; ++mf) { const int arow = 16 * mf + fr; af[mf] = *(const LAS bf16x8*)(lds + LM_A + arow * 512 + (((4 * ks + fq) ^ (arow & 15)) << 4)); }
#pragma unroll
          for (int mf = 0; mf < 4; ++mf)
#pragma unroll
              for (int nf = 0; nf < 2; ++nf) acc[mf][nf] = __builtin_amdgcn_mfma_f32_16x16x32_bf16(pwb[nf][ks], af[mf], acc[mf][nf], 0, 0, 0);
      }
      const float* bp = args.in[I_CPB] + l * CC;
#pragma unroll
      for (int nf = 0; nf < 2; ++nf) { const int n0 = 32 * wave + 16 * nf + 4 * fq; const f32x4 bv = *(const f32x4*)(bp + n0);
#pragma unroll
          for (int mf = 0; mf < 4; ++mf) { const f32x4 a = acc[mf][nf] + bv; u32x2 w; w.x = pg8::cvt_pk_bf16(a[0], a[1]); w.y = pg8::cvt_pk_bf16(a[2], a[3]);
              *(u32x2*)(MIX + (row0 + 16 * mf + fr) * D + n0) = w; } }
    }
    PK_SUB(F, 22);
#pragma unroll
    for (int q = 0; q < 5; ++q) { const int c = tid + q * NTHREADS; const int i = c >> 5, ch = c & 31; if (c < 79 * 32) *(LAS u32x4*)(lds + LM_PH + i * 512 + ch * 16) = hp[q]; }
    __syncthreads();
    bf16x8 plb[4][2];
    { const bf16_t* Wq = (const bf16_t*)(args.ws + WS_WPOOL) + (size_t)(l * 4 + (wave >> 1)) * 64 * 64;
#pragma unroll
      for (int nf = 0; nf < 4; ++nf)
#pragma unroll
          for (int ks = 0; ks < 2; ++ks) plb[nf][ks] = *(const bf16x8*)(Wq + (size_t)(16 * nf + (lane & 15)) * 64 + 32 * ks + 8 * (lane >> 4)); }
    LM_RELAUNDER(); c2 = tid & 127; tg = tid >> 7;
    { const int gi = c2 >> 5, win = 2 << gi; const int r0 = 15 + 16 * tg;
      float s0 = 0.f, s1 = 0.f;
      for (int i = r0 - win + 1; i < r0; ++i) { const unsigned uu = *(const LAS unsigned*)(lds + LM_PH + i * 512 + c2 * 4); s0 += bf2f(uu & 0xffffu); s1 += bf2f(uu >> 16); }
#pragma unroll
      for (int k = 0; k < 16; ++k) { const unsigned uu = *(const LAS unsigned*)(lds + LM_PH + (r0 + k) * 512 + c2 * 4); const float u0 = bf2f(uu & 0xffffu), u1 = bf2f(uu >> 16);
        s0 += u0; s1 += u1; const int tpos = t0 + 16 * tg + k; const float cnt = (float)((tpos + 1 < win) ? (tpos + 1) : win); const float ic = 1.f / cnt;
        const int row = 16 * tg + k;
        *(LAS unsigned*)(lds + LM_D + row * 512 + (((c2 >> 2) ^ (row & 15)) << 4) + 4 * (c2 & 3)) = pg8::cvt_pk_bf16(s0 * ic - u0, s1 * ic - u1);
        const unsigned ul = *(const LAS unsigned*)(lds + LM_PH + (r0 + k - win + 1) * 512 + c2 * 4); s0 -= bf2f(ul & 0xffffu); s1 -= bf2f(ul >> 16); } }
    __syncthreads();
    PK_SUB(F, 23);
    LM_RELAUNDER();
    { const int gi = wave >> 1, fr = lane & 15, fq = lane >> 4;
      const float* sc = args.in[I_PS] + l * CP + 64 * gi;
#pragma unroll
      for (int mf = 0; mf < 2; ++mf) { const int arow = 32 * (wave & 1) + 16 * mf + fr;
        bf16x8 af[2];
#pragma unroll
        for (int ks = 0; ks < 2; ++ks) af[ks] = *(const LAS bf16x8*)(lds + LM_D + arow * 512 + (((8 * gi + 4 * ks + fq) ^ (arow & 15)) << 4));
#pragma unroll
        for (int nf = 0; nf < 4; ++nf) { f32x4 acc = (f32x4){0.f, 0.f, 0.f, 0.f};
#pragma unroll
            for (int ks = 0; ks < 2; ++ks) acc = __builtin_amdgcn_mfma_f32_16x16x32_bf16(plb[nf][ks], af[ks], acc, 0, 0, 0);
            const int d0 = 16 * nf + 4 * fq; const f32x4 sv = *(const f32x4*)(sc + d0); acc = acc * sv;
            u32x2 w; w.x = pg8::cvt_pk_bf16(acc[0], acc[1]); w.y = pg8::cvt_pk_bf16(acc[2], acc[3]);
            *(u32x2*)(MIX + (row0 + arow) * D + 256 + 64 * gi + d0) = w; } } }
    __syncthreads();
    PK_SUB(F, 24);
#undef LM_RELAUNDER
}

__device__ __forceinline__ void router_phase(const Args& args, Frame& F, int l) {
    const int tid = F.tid, lane = F.lane, wave = F.wave, fr = lane & 15, fq = lane >> 4;
    LAS unsigned char* lds = F.lds;
    LAS unsigned char* WL = lds;
    LAS float* lgs = (LAS float*)(lds + 131072 + 1024) + wave * (16 * 24);
    LAS int* bk = (LAS int*)(lds + 131072 + 1024 + 12288);
    LAS int* base = bk + 128;
    { const bf16_t* WR = (const bf16_t*)(args.ws + WS_WR) + (size_t)l * 2 * 32 * D;
      for (int c = tid; c < 2 * 32 * 128; c += NTHREADS) { const int rown = c >> 7, ch = c & 127; const u32x4 v = *(const u32x4*)(WR + (size_t)rown * D + ch * 8);
          *(LAS u32x4*)(WL + rown * 2048 + ((ch ^ (rown & 15)) << 4)) = v; } }
    __syncthreads();
    const bf16_t* X1B = (const bf16_t*)(args.ws + WS_X1B); const float* SS1 = (const float*)(args.ws + WS_SS1);
    float* RS1 = (float*)(args.ws + WS_RS1); float* WTS = (float*)(args.ws + WS_WTS); int* TOKB = (int*)(args.ws + WS_TOKB); int* LIST = (int*)(args.ws + WS_LIST);
    unsigned* gcnt = (unsigned*)(args.ws + WS_CTL) + CW_CNT + l * 64;
    const float* bgp = args.in[I_RGB] + l * 4; const float* bep = args.in[I_REB] + l * 16;
    for (int blk = F.vcu; blk < T / 128; blk += F.G) {
        const int row = blk * 128 + wave * 16 + fr;
        const bf16_t* xp = X1B + (size_t)row * D + 8 * fq;
        f32x4 acc0 = (f32x4){0.f, 0.f, 0.f, 0.f}, acc1 = acc0;
#pragma unroll 8
        for (int ks = 0; ks < 32; ++ks) {
            const bf16x8 xh = *(const bf16x8*)(xp + 32 * ks);
            const int wo = fr * 2048 + (((4 * ks + fq) ^ fr) << 4);
            const bf16x8 wh0 = *(const LAS bf16x8*)(WL + wo), wh1 = *(const LAS bf16x8*)(WL + 16 * 2048 + wo), wl0 = *(const LAS bf16x8*)(WL + 32 * 2048 + wo), wl1 = *(const LAS bf16x8*)(WL + 48 * 2048 + wo);
            acc0 = __builtin_amdgcn_mfma_f32_16x16x32_bf16(wl0, xh, acc0, 0, 0, 0); acc0 = __builtin_amdgcn_mfma_f32_16x16x32_bf16(wh0, xh, acc0, 0, 0, 0);
            acc1 = __builtin_amdgcn_mfma_f32_16x16x32_bf16(wl1, xh, acc1, 0, 0, 0); acc1 = __builtin_amdgcn_mfma_f32_16x16x32_bf16(wh1, xh, acc1, 0, 0, 0);
        }
        *(LAS f32x4*)(lgs + fr * 24 + 4 * fq) = acc0; if (fq == 0) *(LAS f32x4*)(lgs + fr * 24 + 16) = acc1;
        LDS_WAIT(); asm volatile("" ::: "memory");
        if (lane < 16) {
            const float rstd = row_rstd16(SS1 + (size_t)row * 16);
            float lg[20];
#pragma unroll
            for (int q = 0; q < 5; ++q) { const f32x4 v = *(const LAS f32x4*)(lgs + lane * 24 + 4 * q); lg[4 * q] = v[0] * rstd; lg[4 * q + 1] = v[1] * rstd; lg[4 * q + 2] = v[2] * rstd; lg[4 * q + 3] = v[3] * rstd; }
            float g4[4];
#pragma unroll
            for (int j = 0; j < 4; ++j) g4[j] = lg[j] + bgp[j];
            int gidx = 0; float gm = g4[0];
#pragma unroll
            for (int j = 1; j < 4; ++j) if (g4[j] > gm) { gm = g4[j]; gidx = j; }
            float gs = 0.f;
#pragma unroll
            for (int j = 0; j < 4; ++j) gs += __expf(g4[j] - gm);
            const float gp = 1.f / gs;
            float le[4];
#pragma unroll
            for (int j = 0; j < 4; ++j) { const float v = (gidx == 0) ? lg[4 + j] : (gidx == 1) ? lg[8 + j] : (gidx == 2) ? lg[12 + j] : lg[16 + j];
                const float bb = (gidx == 0) ? bep[j] : (gidx == 1) ? bep[4 + j] : (gidx == 2) ? bep[8 + j] : bep[12 + j]; le[j] = v + bb; }
            int ia = 0; float la = le[0];
#pragma unroll
            for (int j = 1; j < 4; ++j) if (le[j] > la) { la = le[j]; ia = j; }
            int ib = -1; float lb = -INFINITY;
#pragma unroll
            for (int j = 0; j < 4; ++j) if (j != ia && le[j] > lb) { lb = le[j]; ib = j; }
            const float pa = 1.f / (1.f + __expf(lb - la)), pbv = 1.f - pa;
            const float wa = gp * pa, wb = gp * pbv;
            const int lo2 = ia < ib ? ia : ib, hi2 = ia < ib ? ib : ia; const float wlo = ia < ib ? wa : wb, whi = ia < ib ? wb : wa;
            const int pi = (lo2 == 0) ? (hi2 - 1) : (lo2 == 1) ? (hi2 + 1) : 5;
            RS1[row] = rstd; WTS[row * 2] = wlo; WTS[row * 2 + 1] = whi; bk[wave * 16 + lane] = gidx * 6 + pi;
        }
        __syncthreads();
        int mybk = 0, lpos = 0;
        if (tid < 128) { mybk = bk[tid]; for (int r = 0; r < tid; ++r) lpos += (bk[r] == mybk) ? 1 : 0; }
        if (tid >= 128 && tid < 128 + NBKT) { const int bq = tid - 128; int c = 0; for (int r = 0; r < 128; ++r) c += (bk[r] == bq) ? 1 : 0;
            base[bq] = (int)__hip_atomic_fetch_add(gcnt + bq, (unsigned)c, __ATOMIC_RELAXED, __HIP_MEMORY_SCOPE_AGENT); }
        __syncthreads();
        if (tid < 128) { const int r2 = blk * 128 + tid; const int pos = base[mybk] + lpos; LIST[(size_t)mybk * T + pos] = r2; TOKB[r2 * 2] = mybk; TOKB[r2 * 2 + 1] = pos; }
        __syncthreads();
    }
}

constexpr int N_PHASES = 1 + 6 * NL;
__global__ void __launch_bounds__(NTHREADS, 2) mega_fwd(Args args) {
    extern __shared__ __attribute__((aligned(16))) unsigned char lds_[];
    Frame F;
    F.lds = (LAS unsigned char*)lds_;
    F.tid = threadIdx.x; F.lane = F.tid & 63; F.wave = __builtin_amdgcn_readfirstlane(F.tid >> 6);
    F.G = gridDim.x; { const int bx = blockIdx.x; F.vcu = (F.G % 8 == 0) ? (bx % 8) * (F.G / 8) + bx / 8 : bx; }
    volatile LAS unsigned* MISC = (volatile LAS unsigned*)(F.lds + MISC_OFF);
    for (int u = F.tid; u < 256; u += NTHREADS) MISC[u] = 0u;
    __syncthreads();
    unsigned char* ws = args.ws;
    unsigned* ctl = (unsigned*)(ws + WS_CTL);
    const int lo = args.ph_lo, hi = args.ph_hi;
    XcdBarrier bar; bar.bar = ctl + CW_BAR; bar.x = 0; bar.st = nullptr;
    if (hi - lo > 1) bar = xcd_barrier_post(ctl + CW_BAR, MISC + 8);
#ifdef ONLY_KIND
#define IN(k) ((((k)==0?0:(((k)-1)%6)+1))==ONLY_KIND && lo <= (k) && (k) < hi)
#else
#define IN(k) (lo <= (k) && (k) < hi)
#endif
#ifdef PROBE_KIND
    F.pk_prev = __builtin_amdgcn_s_memrealtime(); F.pk_acc = 0ull;
#define PK_STAMP(k) do { const unsigned long long t_ = __builtin_amdgcn_s_memrealtime(); if ((((k) == 0) ? 0 : ((((k) - 1) % 6) + 1)) == PROBE_KIND) F.pk_acc += t_ - F.pk_prev; F.pk_prev = t_; } while (0)
#else
#define PK_STAMP(k) do { } while (0)
#endif
#define SEAM(k) do { if (IN(k) && IN((k) + 1)) xcd_barrier(bar); PK_STAMP(k); } while (0)
#define RELAUNDER() do { int t_ = threadIdx.x; asm volatile("" : "+v"(t_)); F.tid = t_; F.lane = t_ & 63; } while (0)
    if (IN(0)) { p0_prologue(args, F); SEAM(0); }
    for (int l = 0; l < NL; ++l) {
        const int pb = 1 + 6 * l;
        if (IN(pb)) { RELAUNDER();
            pg8::Gemm g{(const char*)(ws + WS_XB), D, nullptr, D, D, 1 << 30};
            DenseOrder S; S.init(T, NIN, F.G, (int)blockIdx.x, (const bf16_t*)(ws + WS_WIN) + (size_t)l * NIN * D, D);
            EpiInProj E{(const float*)(ws + WS_SS), (bf16_t*)(ws + WS_U), (bf16_t*)(ws + WS_PIN), (bf16_t*)(ws + WS_Q), (bf16_t*)(ws + WS_K), (bf16_t*)(ws + WS_V), args.in[I_QG] + l * DH, args.in[I_KG] + l * DH};
            pg8::gemm_phase<EpiInProj, DenseOrder, true>(F.lds, g, S, E, F.tid);
            SEAM(pb);
        }
        if (IN(pb + 1)) { RELAUNDER(); PK_SUB(F, 11);
            const float lam_init = 0.8f - 0.6f * expf(-0.3f * (float)l);
            float lam;
            { const float a = args.in[I_LQ1][l * DH + F.lane] * args.in[I_LK1][l * DH + F.lane], b2 = args.in[I_LQ2][l * DH + F.lane] * args.in[I_LK2][l * DH + F.lane];
              lam = expf(wave_sum(a)) - expf(wave_sum(b2)) + lam_init; }
            float smax2;
            { const float gq = fabsf(args.in[I_QG][l * DH + F.lane]), gk = fabsf(args.in[I_KG][l * DH + F.lane]); float a = gq, b2 = gk;
#pragma unroll
              for (int o = 1; o < 64; o <<= 1) { a = fmaxf(a, __shfl_xor(a, o)); b2 = fmaxf(b2, __shfl_xor(b2, o)); }
              smax2 = 2.f * 64.f * a * b2 * QSCALE * 1.01f; }
            for (int v = F.vcu; v < 256; v += F.G) {
                const int bb = v >> 4, s = v & 15;
                for (int i = 0; i < 4; ++i) { const int hh = 3 - i; const int qb = (i & 1) ? s : (15 - s);
                    attn_unit(args, F, l, bb, hh, qb, lam, lam_init, smax2); }
            }
            PK_SUB(F, 9);
            for (int tl = F.vcu; tl < T / 64; tl += F.G) local_unit(args, F, l, tl);
            PK_SUB(F, 10);
            SEAM(pb + 1);
        }
        if (IN(pb + 2)) { RELAUNDER();
            pg8::Gemm g{(const char*)(ws + WS_MIX), D, nullptr, D, D, 1 << 30};
            DenseOrder S; S.init(T, D, F.G, (int)blockIdx.x, (const bf16_t*)(ws + WS_WOUT) + (size_t)l * D * D, D);
            EpiOutProj E{(const bf16_t*)(ws + WS_XB), (bf16_t*)(ws + WS_X1B), (float*)(ws + WS_SS1)};
            pg8::gemm_phase<EpiOutProj, DenseOrder, true>(F.lds, g, S, E, F.tid);
            SEAM(pb + 2);
        }
        if (IN(pb + 3)) { RELAUNDER(); router_phase(args, F, l); SEAM(pb + 3); }
        if (IN(pb + 4) || IN(pb + 5)) { RELAUNDER();
            LAS int* ti = (LAS int*)(F.lds + LDS_EXTRA + 8192);
            LAS int* tb = ti + 512;
            const unsigned* gc = ctl + CW_CNT + l * 64;
            if (F.tid == 0) { int a = 0; for (int b = 0; b < NBKT; ++b) { const int c = (int)__hip_atomic_load(gc + b, __ATOMIC_RELAXED, __HIP_MEMORY_SCOPE_AGENT); tb[b] = a; a += (c + 255) >> 8; } tb[NBKT] = a; ti[0] = a; }
            __syncthreads();
            if (F.tid < NBKT) { const int b = F.tid; const int c = (int)__hip_atomic_load(gc + b, __ATOMIC_RELAXED, __HIP_MEMORY_SCOPE_AGENT); const int t0 = tb[b], n = tb[b + 1] - t0;
                for (int lt = 0; lt < n; ++lt) { ti[2 + 2 * (t0 + lt)] = b | (lt << 8); ti[3 + 2 * (t0 + lt)] = (c - lt * 256) < 256 ? (c - lt * 256) : 256; } }
            __syncthreads();
            if (IN(pb + 4)) { RELAUNDER();
                pg8::Gemm g{(const char*)(ws + WS_X1B), D, (const int*)(ws + WS_LIST), D, D, 1 << 30};
                MoeOrder S{ti, F.G, (int)blockIdx.x, l, 1, (const char*)(ws + WS_WGU)};
                EpiMoe1 E{(const int*)(ws + WS_LIST), (const float*)(ws + WS_RS1), (const float*)(ws + WS_WTS), (bf16_t*)(ws + WS_ACT)};
                pg8::gemm_phase<EpiMoe1, MoeOrder, true>(F.lds, g, S, E, F.tid);
                SEAM(pb + 4);
            }
            if (IN(pb + 5)) { RELAUNDER();
                pg8::Gemm g{(const char*)(ws + WS_ACT), 512, nullptr, DE, 512, 4};
                MoeOrder S{ti, F.G, (int)blockIdx.x, l, 2, (const char*)(ws + WS_WD)};
                EpiMoe2 E{(const int*)(ws + WS_LIST), (const bf16_t*)(ws + WS_X1B), args.out, (bf16_t*)(ws + WS_XB), (float*)(ws + WS_SS), (l == NL - 1) ? 1 : 0};
                pg8::gemm_phase<EpiMoe2, MoeOrder, true>(F.lds, g, S, E, F.tid);
                SEAM(pb + 5);
            }
        }
    }
#ifdef PROBE_KIND
    { const unsigned long long t0_ = __builtin_amdgcn_s_memrealtime(); while (__builtin_amdgcn_s_memrealtime() - t0_ < F.pk_acc) __builtin_amdgcn_s_sleep(8); }
#endif
#undef IN
#undef SEAM
#undef RELAUNDER
}

#ifdef DBG_CHECK
__device__ __forceinline__ int sample_row(int s) {
    const int tbl[24] = {0, 1, 2, 14, 15, 16, 29, 30, 31, 32, 63, 64, 65, 127, 128, 2047, 2048, 2049, 2063, 2078, 2079, 4095, 4096, 32767};
    if (s < 24) return tbl[s];
    return (int)(((unsigned)s * 2654435761u) % (unsigned)T);
}
__device__ __forceinline__ void rec_err(float* errs, int idx, float e) { if (!(e == e)) e = 1e30f; atomicMax((int*)errs + idx, __float_as_int(e)); }
__device__ __forceinline__ float blk_max(float v, float* sh) {
    __syncthreads(); sh[threadIdx.x] = v; __syncthreads();
    for (int s = 128; s > 0; s >>= 1) { if ((int)threadIdx.x < s) sh[threadIdx.x] = fmaxf(sh[threadIdx.x], sh[threadIdx.x + s]); __syncthreads(); }
    const float r = sh[0]; __syncthreads(); return r;
}
__device__ __forceinline__ float blk_sum(float v, float* sh) {
    __syncthreads(); sh[threadIdx.x] = v; __syncthreads();
    for (int s = 128; s > 0; s >>= 1) { if ((int)threadIdx.x < s) sh[threadIdx.x] += sh[threadIdx.x + s]; __syncthreads(); }
    const float r = sh[0]; __syncthreads(); return r;
}
__global__ void chk_prologue(Args a, float* errs) {
    __shared__ float sh[256];
    const int r = sample_row(blockIdx.x); const float* x = a.in[I_X] + (size_t)r * D; const bf16_t* xb = (const bf16_t*)(a.ws + WS_XB) + (size_t)r * D;
    float e = 0.f, s = 0.f;
    for (int k = threadIdx.x; k < D; k += 256) { e = fmaxf(e, fabsf(bf2f(xb[k]) - x[k]) / (fabsf(x[k]) + 1.f)); s += x[k] * x[k]; }
    s = blk_sum(s, sh); const float* ss = (const float*)(a.ws + WS_SS) + (size_t)r * 16; float s2 = 0.f; for (int i = 0; i < 16; ++i) s2 += ss[i];
    e = fmaxf(e, fabsf(s2 - s) / (s + 1.f) * 10.f);
    for (int l = 0; l < NL; ++l) { const unsigned hsh = (blockIdx.x * 256u + threadIdx.x) * 2654435761u + l * 97u;
        { const int n = hsh % D, k = (hsh >> 10) % D; const float w = a.in[I_WOUT][(size_t)l * D * D + (size_t)k * D + n]; const float g = bf2f(((const bf16_t*)(a.ws + WS_WOUT))[(size_t)l * D * D + (size_t)n * D + k]); e = fmaxf(e, fabsf(g - w) * 20.f); }
        { const int ee = hsh % NE, n = (hsh >> 4) % D, k = (hsh >> 14) % DE; const float w = a.in[I_WDN][((size_t)(l * NE + ee) * DE + k) * D + n]; const float g = bf2f(((const bf16_t*)(a.ws + WS_WD))[((size_t)(l * NE + ee) * D + n) * DE + k]); e = fmaxf(e, fabsf(g - w) * 20.f); }
        { const int ee = hsh % NE, j = (hsh >> 4) % DE, k = (hsh >> 12) % D, gu = (hsh >> 22) & 1; const float w = (gu ? a.in[I_WU] : a.in[I_WG])[((size_t)(l * NE + ee) * D + k) * DE + j] * a.in[I_FNG][l * D + k];
          const int p = (j >> 7) * 256 + gu * 128 + (j & 127); const float g = bf2f(((const bf16_t*)(a.ws + WS_WGU))[((size_t)(l * NE + ee) * 512 + p) * D + k]); e = fmaxf(e, fabsf(g - w) * 20.f); }
        { const int j = hsh % 20, k = (hsh >> 5) % D; const float w = ((j < 4) ? a.in[I_RGW][(size_t)(l * D + k) * 4 + j] : a.in[I_REW][(size_t)(l * D + k) * 16 + j - 4]) * a.in[I_FNG][l * D + k];
          const bf16_t* wr = (const bf16_t*)(a.ws + WS_WR) + (size_t)l * 2 * 32 * D; const float g = bf2f(wr[(size_t)j * D + k]) + bf2f(wr[(size_t)(32 + j) * D + k]); e = fmaxf(e, fabsf(g - w) * 1000.f); }
    }
    e = blk_max(e, sh); if (threadIdx.x == 0) rec_err(errs, 0, e);
}
__global__ void chk_inproj(Args a, int l, float* errs) {
    __shared__ float z[NIN]; __shared__ float sh[256];
    const int r = sample_row(blockIdx.x); const bf16_t* xb = (const bf16_t*)(a.ws + WS_XB) + (size_t)r * D;
    const float* ss = (const float*)(a.ws + WS_SS) + (size_t)r * 16; float s2 = 0.f; for (int i = 0; i < 16; ++i) s2 += ss[i];
    const float rstd = rsqrtf(s2 / D + EPS); const float* W = a.in[I_WIN] + (size_t)l * D * NIN; const float* g = a.in[I_ANG] + l * D;
    for (int c = threadIdx.x; c < NIN; c += 256) { float acc = 0.f; for (int k = 0; k < D; ++k) acc += bf2f(xb[k]) * g[k] * W[(size_t)k * NIN + c]; z[c] = acc * rstd; }
    __syncthreads();
    float e = 0.f; const int t = threadIdx.x;
    { const float ex = z[t] * (1.f / (1.f + expf(-z[256 + t]))); e = fmaxf(e, fabsf(ex - bf2f(((const bf16_t*)(a.ws + WS_U))[(size_t)r * CC + t]))); }
    { e = fmaxf(e, fabsf(z[512 + t] - bf2f(((const bf16_t*)(a.ws + WS_PIN))[(size_t)r * CP + t]))); }
    for (int c = t; c < CA; c += 256) {
        e = fmaxf(e, fabsf(z[1792 + c] - bf2f(((const bf16_t*)(a.ws + WS_V))[(size_t)r * CA + c])));
        const int hs = c >> 6, d = c & 63; float sq = 0.f, sk = 0.f; for (int i = 0; i < 64; ++i) { const float q = z[768 + hs * 64 + i], k = z[1280 + hs * 64 + i]; sq += q * q; sk += k * k; }
        const float eq = z[768 + c] * rsqrtf(sq / 64.f + EPS) * a.in[I_QG][l * DH + d] * QSCALE, ek = z[1280 + c] * rsqrtf(sk / 64.f + EPS) * a.in[I_KG][l * DH + d];
        e = fmaxf(e, fabsf(eq - bf2f(((const bf16_t*)(a.ws + WS_Q))[(size_t)r * CA + c])) * 4.f);
        e = fmaxf(e, fabsf(ek - bf2f(((const bf16_t*)(a.ws + WS_K))[(size_t)r * CA + c])));
    }
    e = blk_max(e, sh); if (t == 0) rec_err(errs, l * 8 + 1, e);
}
__global__ void chk_attn(Args a, int l, float* errs) {
    __shared__ float p[2][SEQ]; __shared__ float sh[256]; __shared__ float ov[DV];
    const int qt[16] = {0, 1, 31, 32, 63, 64, 65, 127, 128, 129, 191, 192, 500, 1023, 1024, 2047};
    const int q = qt[blockIdx.x & 15], h = (blockIdx.x >> 4) & 3, b = (blockIdx.x >> 6) ? 13 : 0; const int t = threadIdx.x;
    const bf16_t* Q = (const bf16_t*)(a.ws + WS_Q); const bf16_t* K = (const bf16_t*)(a.ws + WS_K); const bf16_t* V = (const bf16_t*)(a.ws + WS_V);
    const size_t rb = (size_t)b * SEQ; const float slope = exp2f(-2.f * (h + 1)); const float sl2 = slope * 1.4426950408889634f;
    const float lam_init = 0.8f - 0.6f * expf(-0.3f * (float)l); float s1 = 0.f, s2 = 0.f;
    for (int d = 0; d < DH; ++d) { s1 += a.in[I_LQ1][l * DH + d] * a.in[I_LK1][l * DH + d]; s2 += a.in[I_LQ2][l * DH + d] * a.in[I_LK2][l * DH + d]; }
    const float lam = expf(s1) - expf(s2) + lam_init;
    for (int m = 0; m < 2; ++m) {
        float mx = -INFINITY;
        for (int kv = t; kv <= q; kv += 256) { float s = 0.f; for (int d = 0; d < DH; ++d) s += bf2f(Q[(rb + q) * CA + h * 128 + m * 64 + d]) * bf2f(K[(rb + kv) * CA + h * 128 + m * 64 + d]); s -= sl2 * (float)(q - kv); p[m][kv] = s; mx = fmaxf(mx, s); }
        mx = blk_max(mx, sh); float sm = 0.f;
        for (int kv = t; kv <= q; kv += 256) { const float e_ = exp2f(p[m][kv] - mx); p[m][kv] = e_; sm += e_; }
        sm = blk_sum(sm, sh);
        for (int kv = t; kv <= q; kv += 256) p[m][kv] /= sm;
        __syncthreads();
    }
    float o = 0.f;
    if (t < DV) { for (int kv = 0; kv <= q; ++kv) o += (p[0][kv] - lam * p[1][kv]) * bf2f(V[(rb + kv) * CA + h * 128 + t]); }
    const float ssq = blk_sum(t < DV ? o * o : 0.f, sh);
    float e = 0.f;
    if (t < DV) { const float ex = o * rsqrtf(ssq / DV + EPS) * a.in[I_ASG][l * DV + t] * (1.f - lam_init); e = fabsf(ex - bf2f(((const bf16_t*)(a.ws + WS_MIX))[(rb + q) * D + 512 + h * 128 + t])); }
    e = blk_max(e, sh); if (t == 0) rec_err(errs, l * 8 + 2, e);
}
__global__ void chk_local(Args a, int l, float* errs) {
    __shared__ float sv[CC]; __shared__ float sh[256];
    const int r = sample_row(blockIdx.x); const int b = r / SEQ, tp = r % SEQ; const int t = threadIdx.x;
    const bf16_t* U = (const bf16_t*)(a.ws + WS_U); const bf16_t* PIN = (const bf16_t*)(a.ws + WS_PIN); const bf16_t* MIX = (const bf16_t*)(a.ws + WS_MIX);
    float y = a.in[I_CB][l * CC + t];
    for (int j = 0; j < CW; ++j) { const int tt = tp - 30 + j; if (tt >= 0) y += a.in[I_CW][(size_t)(l * CW + j) * CC + t] * bf2f(U[((size_t)b * SEQ + tt) * CC + t]); }
    const float mean = blk_sum(y, sh) / CC; const float dv = y - mean; const float var = blk_sum(dv * dv, sh) / CC;
    float yn = dv * rsqrtf(var + EPS) * a.in[I_CLG][l * CC + t] + a.in[I_CLB][l * CC + t]; yn = yn / (1.f + expf(-yn));
    sv[t] = yn; __syncthreads();
    float o = a.in[I_CPB][l * CC + t]; for (int c = 0; c < CC; ++c) o += sv[c] * a.in[I_CPW][(size_t)l * CC * CC + (size_t)c * CC + t];
    float e = fabsf(o - bf2f(MIX[(size_t)r * D + t]));
    __syncthreads();
    { const int gi = t >> 6, win = 2 << gi; float s = 0.f; for (int i = 0; i < win; ++i) { const int tt = tp - i; if (tt >= 0) s += bf2f(PIN[((size_t)b * SEQ + tt) * CP + t]); }
      const float cnt = (float)((tp + 1 < win) ? tp + 1 : win); sv[t] = s / cnt - bf2f(PIN[(size_t)r * CP + t]); }
    __syncthreads();
    { const int gi = t >> 6, dd = t & 63; float o2 = 0.f; for (int c = 0; c < 64; ++c) o2 += sv[gi * 64 + c] * a.in[I_PW][((size_t)(l * 4 + gi) * 64 + c) * 64 + dd];
      o2 *= a.in[I_PS][l * CP + t]; e = fmaxf(e, fabsf(o2 - bf2f(MIX[(size_t)r * D + 256 + t]))); }
    e = blk_max(e, sh); if (t == 0) rec_err(errs, l * 8 + 3, e);
}
__global__ void chk_outproj(Args a, int l, float* errs) {
    __shared__ float sh[256];
    const int r = sample_row(blockIdx.x); const int t = threadIdx.x; const bf16_t* MIX = (const bf16_t*)(a.ws + WS_MIX) + (size_t)r * D;
    float e = 0.f, ssq = 0.f;
    for (int n = t; n < D; n += 256) { float acc = 0.f; for (int k = 0; k < D; ++k) acc += bf2f(MIX[k]) * a.in[I_WOUT][(size_t)l * D * D + (size_t)k * D + n];
        const float xin = bf2f(((const bf16_t*)(a.ws + WS_XB))[(size_t)r * D + n]);
        const float got = bf2f(((const bf16_t*)(a.ws + WS_X1B))[(size_t)r * D + n]); e = fmaxf(e, fabsf(xin + acc - got)); ssq += got * got; }
    ssq = blk_sum(ssq, sh); const float* ss = (const float*)(a.ws + WS_SS1) + (size_t)r * 16; float s2 = 0.f; for (int i = 0; i < 16; ++i) s2 += ss[i];
    e = fmaxf(e, fabsf(s2 - ssq) / (ssq + 1.f) * 10.f);
    e = blk_max(e, sh); if (t == 0) rec_err(errs, l * 8 + 4, e);
}
__global__ void chk_router_moe(Args a, int l, float* errs) {
    __shared__ float sh[256]; __shared__ float hf[D]; __shared__ float lgs[20]; __shared__ float act[2][DE]; __shared__ int eid[2]; __shared__ float wv[2];
    const int r = sample_row(blockIdx.x); const int t = threadIdx.x; const bf16_t* x1b = (const bf16_t*)(a.ws + WS_X1B) + (size_t)r * D;
    __shared__ float x1[D]; for (int k = t; k < D; k += 256) x1[k] = bf2f(x1b[k]); __syncthreads();
    float s = 0.f; for (int k = t; k < D; k += 256) s += x1[k] * x1[k];
    s = blk_sum(s, sh); const float rstd = rsqrtf(s / D + EPS);
    for (int k = t; k < D; k += 256) hf[k] = x1[k] * rstd * a.in[I_FNG][l * D + k];
    __syncthreads();
    if (t < 20) { double acc = 0.0; for (int k = 0; k < D; ++k) acc += (double)hf[k] * (double)((t < 4) ? a.in[I_RGW][(size_t)(l * D + k) * 4 + t] : a.in[I_REW][(size_t)(l * D + k) * 16 + t - 4]);
        lgs[t] = (float)acc + ((t < 4) ? a.in[I_RGB][l * 4 + t] : a.in[I_REB][l * 16 + t - 4]); }
    __syncthreads();
    float e = 0.f;
    if (t == 0) {
        int gi = 0; for (int j = 1; j < 4; ++j) if (lgs[j] > lgs[gi]) gi = j;
        float gs = 0.f; for (int j = 0; j < 4; ++j) gs += expf(lgs[j] - lgs[gi]); const float gp = 1.f / gs;
        const float* le = lgs + 4 + 4 * gi; int ia = 0; for (int j = 1; j < 4; ++j) if (le[j] > le[ia]) ia = j;
        int ib = -1; for (int j = 0; j < 4; ++j) if (j != ia && (ib < 0 || le[j] > le[ib])) ib = j;
        const float pa = 1.f / (1.f + expf(le[ib] - le[ia])); const float wa = gp * pa, wb = gp * (1.f - pa);
        const int lo = ia < ib ? ia : ib, hi = ia < ib ? ib : ia; const float wlo = ia < ib ? wa : wb, whi = ia < ib ? wb : wa;
        const int pi = (lo == 0) ? hi - 1 : (lo == 1) ? hi + 1 : 5; const int bkt = gi * 6 + pi;
        const int* TOKB = (const int*)(a.ws + WS_TOKB); const float* WTS = (const float*)(a.ws + WS_WTS); const int* LIST = (const int*)(a.ws + WS_LIST);
        if (TOKB[r * 2] != bkt) e = 1000.f;
        else { const int pos = TOKB[r * 2 + 1]; const unsigned cnt = ((const unsigned*)(a.ws + WS_CTL))[CW_CNT + l * 64 + bkt];
            if (pos < 0 || (unsigned)pos >= cnt || LIST[(size_t)bkt * T + pos] != r) e = 500.f; }
        e = fmaxf(e, fabsf(WTS[r * 2] - wlo) * 10.f); e = fmaxf(e, fabsf(WTS[r * 2 + 1] - whi) * 10.f);
        e = fmaxf(e, fabsf(((const float*)(a.ws + WS_RS1))[r] - rstd) * 10.f);
        eid[0] = gi * 4 + lo; eid[1] = gi * 4 + hi; wv[0] = wlo; wv[1] = whi;
    }
    __syncthreads();
    for (int s2 = 0; s2 < 2; ++s2) { const int ee = eid[s2]; const float* Wg = a.in[I_WG] + (size_t)(l * NE + ee) * D * DE; const float* Wu = a.in[I_WU] + (size_t)(l * NE + ee) * D * DE;
        float g = 0.f, u = 0.f; for (int k = 0; k < D; ++k) { g += hf[k] * Wg[(size_t)k * DE + t]; u += hf[k] * Wu[(size_t)k * DE + t]; }
        act[s2][t] = g / (1.f + expf(-g)) * u * wv[s2]; }
    __syncthreads();
    float* exp_out = (float*)(a.ws + WS_DBG) + (size_t)blockIdx.x * D;
    for (int n = t; n < D; n += 256) { float y = 0.f; for (int s2 = 0; s2 < 2; ++s2) { const float* Wd = a.in[I_WDN] + (size_t)(l * NE + eid[s2]) * DE * D; for (int j = 0; j < DE; ++j) y += act[s2][j] * Wd[(size_t)j * D + n]; }
        exp_out[n] = x1[n] + y; }
    e = blk_max(e, sh); if (t == 0) rec_err(errs, l * 8 + 5, e);
}
__global__ void chk_moe_post(Args a, int l, float* errs) {
    __shared__ float sh[256];
    const int r = sample_row(blockIdx.x); const int t = threadIdx.x; const float* exp_out = (const float*)(a.ws + WS_DBG) + (size_t)blockIdx.x * D;
    float e = 0.f, ssq = 0.f;
    for (int n = t; n < D; n += 256) { const float got = (l < NL - 1) ? bf2f(((const bf16_t*)(a.ws + WS_XB))[(size_t)r * D + n]) : a.out[(size_t)r * D + n]; e = fmaxf(e, fabsf(got - exp_out[n])); ssq += got * got; }
    ssq = blk_sum(ssq, sh);
    if (l < NL - 1) { const float* ss = (const float*)(a.ws + WS_SS) + (size_t)r * 16; float s2 = 0.f; for (int i = 0; i < 16; ++i) s2 += ss[i]; e = fmaxf(e, fabsf(s2 - ssq) / (ssq + 1.f) * 10.f); }
    e = blk_max(e, sh); if (t == 0) rec_err(errs, l * 8 + 6, e);
}
#ifndef DBG_SHOW
#define DBG_SHOW -2
#endif
__global__ void chk_report(Args a, const float* errs) {
    const float tol[8] = {0.05f, 0.06f, 0.05f, 0.06f, 0.08f, 0.05f, 0.08f, 1e30f};
    int bad = -1; for (int i = 0; i < 16; ++i) if (errs[i] > tol[i & 7]) { bad = i; break; }
    float val = 0.f; bool over = false;
    if (DBG_SHOW == -1) { val = 16.f; over = true; }
    else if (DBG_SHOW >= 0) { val = 1000.f * errs[DBG_SHOW]; over = true; }
    else if (bad >= 0) { val = 8.f * exp2f((float)bad); over = true; }
    if (over) for (size_t i = (size_t)blockIdx.x * blockDim.x + threadIdx.x; i < (size_t)T * D; i += (size_t)gridDim.x * blockDim.x) a.out[i] = val;
}
#endif

extern "C" void kernel_launch(void* const* d_in, const int* in_sizes, int n_in, void* d_out, int out_size, void* d_ws, size_t ws_size, hipStream_t stream) {
    static int grid = 0;
    if (grid == 0) {
        if (n_in != 27 || out_size != T * D || ws_size < WS_END) { fprintf(stderr, "kernel_launch: unexpected shapes (n_in %d out %d ws %zu)\n", n_in, out_size, ws_size); grid = -1; return; }
        int dev = 0, cus = 0, per_cu = 0;
        if (hipGetDevice(&dev) != hipSuccess || hipDeviceGetAttribute(&cus, hipDeviceAttributeMultiprocessorCount, dev) != hipSuccess) { grid = -1; return; }
        if (hipFuncSetAttribute((const void*)mega_fwd, hipFuncAttributeMaxDynamicSharedMemorySize, LDS_BYTES) != hipSuccess) { fprintf(stderr, "kernel_launch: hipFuncSetAttribute failed\n"); grid = -1; return; }
        if (hipOccupancyMaxActiveBlocksPerMultiprocessor(&per_cu, (const void*)mega_fwd, NTHREADS, LDS_BYTES) != hipSuccess || per_cu < 1) fprintf(stderr, "kernel_launch: occupancy query reports %d\n", per_cu);
        (void)hipGetLastError();
        grid = cus;
    }
    if (grid < 0) return;
    (void)hipMemsetAsync((char*)d_ws + WS_CTL, 0, CTL_ZERO_BYTES, stream);
    Args a{};
    for (int i = 0; i < 27; ++i) a.in[i] = (const float*)d_in[i];
    a.out = (float*)d_out; a.ws = (unsigned char*)d_ws;
#ifdef DBG_CHECK
    float* errs = (float*)((char*)d_ws + WS_ERR);
    (void)hipMemsetAsync(errs, 0, 4096, stream);
    auto run = [&](int lo, int hi) { a.ph_lo = lo; a.ph_hi = hi; hipLaunchKernelGGL(mega_fwd, dim3(grid), dim3(NTHREADS), LDS_BYTES, stream, a); };
    run(0, 1); chk_prologue<<<48, 256, 0, stream>>>(a, errs);
    for (int l = 0; l < NL; ++l) { const int pb = 1 + 6 * l;
        run(pb, pb + 1); chk_inproj<<<48, 256, 0, stream>>>(a, l, errs);
        run(pb + 1, pb + 2); chk_attn<<<128, 256, 0, stream>>>(a, l, errs); chk_local<<<48, 256, 0, stream>>>(a, l, errs);
        run(pb + 2, pb + 3); chk_outproj<<<48, 256, 0, stream>>>(a, l, errs);
        run(pb + 3, pb + 4); chk_router_moe<<<48, 256, 0, stream>>>(a, l, errs);
        run(pb + 4, pb + 5); run(pb + 5, pb + 6); chk_moe_post<<<48, 256, 0, stream>>>(a, l, errs);
    }
    chk_report<<<1024, 256, 0, stream>>>(a, errs);
#else
#ifndef N_SPLIT
#define N_SPLIT 0
#endif
    if (N_SPLIT) { for (int p = 0; p < N_PHASES; ++p) { a.ph_lo = p; a.ph_hi = p + 1; hipLaunchKernelGGL(mega_fwd, dim3(grid), dim3(NTHREADS), LDS_BYTES, stream, a); } }
    else { a.ph_lo = 0; a.ph_hi = N_PHASES; hipLaunchKernelGGL(mega_fwd, dim3(grid), dim3(NTHREADS), LDS_BYTES, stream, a); }
#endif
}
```

```cpp
#include <hip/hip_runtime.h>
#include <cstdio>
#include <cstdint>

#define GAS __attribute__((address_space(1)))
#define LAS __attribute__((address_space(3)))
typedef unsigned short bf16_t;
typedef short bf16x8 __attribute__((ext_vector_type(8)));
typedef short s16x4 __attribute__((ext_vector_type(4)));
typedef float f32x4 __attribute__((ext_vector_type(4)));
typedef float f32x2 __attribute__((ext_vector_type(2)));
typedef float f32x16 __attribute__((ext_vector_type(16)));
typedef unsigned u32x4 __attribute__((ext_vector_type(4)));
typedef unsigned u32x2 __attribute__((ext_vector_type(2)));

__device__ __forceinline__ float bf2f(unsigned v) { return __uint_as_float(v << 16); }
__device__ __forceinline__ unsigned f2bf(float f) { unsigned u = __float_as_uint(f); return (u + 0x7fffu + ((u >> 16) & 1u)) >> 16; }
__device__ __forceinline__ unsigned pk2(float lo, float hi) { return f2bf(lo) | (f2bf(hi) << 16); }
__device__ __forceinline__ float wave_sum(float v) {
#define WS_DPP(ctrl, rmask) __builtin_bit_cast(float, __builtin_amdgcn_update_dpp(0, __builtin_bit_cast(int, v), (ctrl), (rmask), 0xf, true))
    v += WS_DPP(0xB1, 0xf);
    v += WS_DPP(0x4E, 0xf);
    v += WS_DPP(0x141, 0xf);
    v += WS_DPP(0x140, 0xf);
    v += WS_DPP(0x142, 0xa);
    v += WS_DPP(0x143, 0xc);
#undef WS_DPP
    return __builtin_bit_cast(float, __builtin_amdgcn_readlane(__builtin_bit_cast(int, v), 63));
}

namespace pg8 {
constexpr int BM = 256, BK = 64, HALF = 128, HTB = HALF * BK * 2, STAGE_BYTES = 8 * HTB;
__host__ __device__ __forceinline__ int lds_byte(int r, int c) { const int st = (r >> 4) * 2 + (c >> 5), rr = r & 15, cc = c & 31, ob = rr * 64 + cc * 2; return st * 1024 + (ob ^ (((ob >> 9) & 1) << 5)); }
__host__ __device__ __forceinline__ void stage_rc(int b, int& R, int& C) { const int st = b / 1024, sb = b % 1024, swz = sb ^ (((sb >> 9) & 1) << 5); R = (st >> 1) * 16 + swz / 64; C = (st & 1) * 32 + (swz % 64) / 2; }
__host__ __device__ __forceinline__ int perm32(int rho) { const int n = rho >> 4, i = rho & 15; return 8 * (i >> 2) + 4 * n + (i & 3); }

struct Unit { int pm, pn; const char* bb; long bjump; int arow0; int acount; int aux; };
struct Gemm { const char* A; int lda; const int* gather; int ldb; int K; int bsplit; };

__device__ __forceinline__ unsigned cvt_pk_bf16(float lo, float hi) { unsigned r; asm volatile("v_cvt_pk_bf16_f32 %0, %1, %2" : "=v"(r) : "v"(lo), "v"(hi)); return r; }

template <class Epi, class Sched, bool ALIGN_EPI>
__device__ __forceinline__ void gemm_phase(LAS unsigned char* lds, const Gemm g, const Sched& S, const Epi& E, const int tid) {
    const int wid = __builtin_amdgcn_readfirstlane(tid >> 6), lane = tid & 63, wr = wid >> 2, wc = wid & 3, fr = lane & 15, fq = lane >> 4;
    const int K = g.K, nt = K / BK;
    unsigned voffB[2];
#pragma unroll
    for (int i = 0; i < 2; ++i) { int R, C; stage_rc(tid * 16 + i * 8192, R, C); const int Rb = Epi::PERM ? ((R & ~31) + perm32(R & 31)) : R; voffB[i] = (unsigned)(Rb * g.ldb + C) * 2u; }
    const size_t kstep = (size_t)(BK * 2);
    const size_t bh = (size_t)HALF * g.ldb * 2;
    const unsigned ldsw = (unsigned)wid * 1024u;
    const int aoff = lds_byte(wr * 64 + fr, fq * 8), boff = lds_byte(wc * 32 + fr, fq * 8);
    const char* const Ab = g.A;
#define PG8_SA(b, h) (((b) * 2 + (h)) * HTB)
#define PG8_SB(b, h) ((4 + (b) * 2 + (h)) * HTB)
#define PG8_STAGE(bufoff, gbase, voff) do { _Pragma("unroll") for (int _i = 0; _i < 2; ++_i) \
        __builtin_amdgcn_global_load_lds((const unsigned*)((const char*)(gbase) + (voff)[_i]), (LAS unsigned*)(lds + (bufoff) + ldsw + _i * 8192), 16, 0, 0); } while (0)
#define PG8_LDA(dst, b, h) do { _Pragma("unroll") for (int m = 0; m < 4; ++m) _Pragma("unroll") for (int k = 0; k < 2; ++k) dst[m][k] = *(const LAS bf16x8*)(lds + PG8_SA(b, h) + aoff + m * 2048 + k * 1024); } while (0)
#define PG8_LDB(dst, b, h) do { _Pragma("unroll") for (int n = 0; n < 2; ++n) _Pragma("unroll") for (int k = 0; k < 2; ++k) dst[n][k] = *(const LAS bf16x8*)(lds + PG8_SB(b, h) + boff + n * 2048 + k * 1024); } while (0)
#define PG8_MMA(ai, bj, At, Bt) do { __builtin_amdgcn_s_setprio(1); _Pragma("unroll") for (int m = 0; m < 4; ++m) _Pragma("unroll") for (int n = 0; n < 2; ++n) _Pragma("unroll") for (int k = 0; k < 2; ++k) \
        acc[ai][bj][m][n] = __builtin_amdgcn_mfma_f32_16x16x32_bf16(Bt[n][k], At[m][k], acc[ai][bj][m][n], 0, 0, 0); __builtin_amdgcn_s_setprio(0); } while (0)
#define PG8_WAIT_V(n) asm volatile("s_waitcnt vmcnt(" #n ")" ::: "memory")
#define PG8_WAIT_L(n) asm volatile("s_waitcnt lgkmcnt(" #n ")" ::: "memory")
#define PG8_BAR __builtin_amdgcn_s_barrier()
#define PG8_SCHED __builtin_amdgcn_sched_barrier(0)
#define PG8_AOFFS(u, o) do { _Pragma("unroll") for (int _h = 0; _h < 2; ++_h) _Pragma("unroll") for (int _i = 0; _i < 2; ++_i) { int _R, _C; stage_rc(tid * 16 + _i * 8192, _R, _C); const int _r = _h * HALF + _R; \
        int _row; if (g.gather) { _row = (_r < (u).acount) ? g.gather[(u).arow0 + _r] : 0; } else { _row = (u).arow0 + _r; } (o)[_h][_i] = (unsigned)(_row * g.lda + _C) * 2u; } } while (0)
#define PG8_BKO(u, tt) ((size_t)(tt) * kstep + (((tt) >= g.bsplit) ? (size_t)(u).bjump : (size_t)0))
    Unit cur, nxt; int ui = 0;
    if (!S.next(0, cur)) return;
    f32x4 acc[2][2][4][2];
#pragma unroll
    for (int a = 0; a < 2; ++a)
#pragma unroll
        for (int b = 0; b < 2; ++b)
#pragma unroll
            for (int m = 0; m < 4; ++m)
#pragma unroll
                for (int n = 0; n < 2; ++n) acc[a][b][m][n] = (f32x4){0.f, 0.f, 0.f, 0.f};
    bf16x8 At[4][2], B0[2][2], B1[2][2];
    unsigned cao[2][2];
    LAS u32x4* const naol = (LAS u32x4*)(lds + STAGE_BYTES + 1024) + tid;
    PG8_AOFFS(cur, cao);
    const char* cB = cur.bb;
    PG8_STAGE(PG8_SB(0, 0), cB, voffB); PG8_STAGE(PG8_SB(0, 1), cB + bh, voffB); PG8_STAGE(PG8_SA(0, 0), Ab, cao[0]); PG8_STAGE(PG8_SA(0, 1), Ab, cao[1]);
    if (wr == 1) PG8_BAR;
    PG8_WAIT_V(2); PG8_BAR;
    PG8_STAGE(PG8_SB(1, 0), cB + kstep, voffB); PG8_STAGE(PG8_SA(1, 0), Ab + kstep, cao[0]); PG8_STAGE(PG8_SB(1, 1), cB + bh + kstep, voffB);
    PG8_WAIT_V(6); PG8_BAR;
    for (;;) {
        const bool has_next = S.next(ui + 1, nxt);
        const char* nB = cB;
        { unsigned nao[2][2];
          if (has_next) { PG8_AOFFS(nxt, nao); nB = nxt.bb; }
          else {
#pragma unroll
            for (int h = 0; h < 2; ++h)
#pragma unroll
                for (int i = 0; i < 2; ++i) nao[h][i] = cao[h][i];
          }
          *naol = (u32x4){nao[0][0], nao[0][1], nao[1][0], nao[1][1]}; }
#pragma unroll 1
        for (int t = 0; t < nt; t += 2) {
            const bool last = (t == nt - 2);
            const char* a1 = Ab + (size_t)(t + 1) * kstep;
            const char* a2 = last ? Ab : Ab + (size_t)(t + 2) * kstep;
            const char* a3 = a2 + kstep;
            const char* b2 = last ? nB : cB + PG8_BKO(cur, t + 2);
            const char* b3 = last ? nB + kstep : cB + PG8_BKO(cur, t + 3);
            unsigned ao2[2][2];
#pragma unroll
            for (int h = 0; h < 2; ++h)
#pragma unroll
                for (int i = 0; i < 2; ++i) ao2[h][i] = cao[h][i];
            if (last) { const u32x4 v = *naol; ao2[0][0] = v.x; ao2[0][1] = v.y; ao2[1][0] = v.z; ao2[1][1] = v.w; }
            PG8_LDB(B0, 0, 0); PG8_LDB(B1, 0, 1); PG8_SCHED; PG8_LDA(At, 0, 0); PG8_STAGE(PG8_SA(1, 1), a1, cao[1]);
            PG8_WAIT_V(8); PG8_WAIT_L(0); PG8_BAR; PG8_MMA(0, 0, At, B0); PG8_MMA(0, 1, At, B1); PG8_BAR; PG8_SCHED;
            PG8_LDA(At, 0, 1); PG8_STAGE(PG8_SB(0, 0), b2, voffB); PG8_STAGE(PG8_SB(0, 1), b2 + bh, voffB); PG8_STAGE(PG8_SA(0, 0), a2, ao2[0]);
            PG8_WAIT_V(8); PG8_WAIT_L(0); PG8_BAR; PG8_MMA(1, 0, At, B0); PG8_MMA(1, 1, At, B1); PG8_BAR; PG8_SCHED;
            PG8_LDB(B0, 1, 0); PG8_LDB(B1, 1, 1); PG8_SCHED; PG8_LDA(At, 1, 0); PG8_STAGE(PG8_SA(0, 1), a2, ao2[1]);
            PG8_WAIT_V(8); PG8_WAIT_L(0); PG8_BAR; PG8_MMA(0, 0, At, B0); PG8_MMA(0, 1, At, B1); PG8_BAR; PG8_SCHED;
            PG8_LDA(At, 1, 1); PG8_STAGE(PG8_SB(1, 0), b3, voffB); PG8_STAGE(PG8_SB(1, 1), b3 + bh, voffB); PG8_STAGE(PG8_SA(1, 0), a3, ao2[0]);
            PG8_WAIT_V(8); PG8_WAIT_L(0); PG8_BAR; PG8_MMA(1, 0, At, B0); PG8_MMA(1, 1, At, B1); PG8_BAR; PG8_SCHED;
        }
        if constexpr (ALIGN_EPI) { if (wr == 0) PG8_BAR; }
        { int t2_ = tid; asm volatile("" : "+v"(t2_)); const int l2_ = t2_ & 63; E(acc, cur, wr, wc, l2_ & 15, l2_ >> 4); }
        if (!has_next) break;
#pragma unroll
        for (int a = 0; a < 2; ++a)
#pragma unroll
            for (int b = 0; b < 2; ++b)
#pragma unroll
                for (int m = 0; m < 4; ++m)
#pragma unroll
                    for (int n = 0; n < 2; ++n) acc[a][b][m][n] = (f32x4){0.f, 0.f, 0.f, 0.f};
        cur = nxt; cB = nB; ++ui;
        { const u32x4 v = *naol; cao[0][0] = v.x; cao[0][1] = v.y; cao[1][0] = v.z; cao[1][1] = v.w; }
        if constexpr (ALIGN_EPI) { if (wr == 1) PG8_BAR; }
    }
    PG8_WAIT_V(0);
    if constexpr (!ALIGN_EPI) { if (wr == 0) PG8_BAR; }
    PG8_BAR;
#undef PG8_SA
#undef PG8_SB
#undef PG8_STAGE
#undef PG8_LDA
#undef PG8_LDB
#undef PG8_MMA
#undef PG8_WAIT_V
#undef PG8_WAIT_L
#undef PG8_BAR
#undef PG8_SCHED
#undef PG8_AOFFS
#undef PG8_BKO
}
}

constexpr int BATCH = 16, SEQ = 2048, T = BATCH * SEQ, D = 1024, NIN = 2304, NL = 2;
constexpr int CC = 256, CP = 256, CA = 512, NH = 4, DH = 64, DV = 128, CW = 31;
constexpr int NE = 16, DE = 256, NBKT = 24;
constexpr float EPS = 1e-6f;
constexpr float QSCALE = 0.125f * 1.4426950408889634f;
constexpr int NWAVES = 8, NTHREADS = 512;

constexpr size_t MiB = 1u << 20, KiB = 1u << 10;
constexpr size_t WS_CTL = 0, CTL_ZERO_BYTES = 1 * MiB;
constexpr size_t WS_SS = 2 * MiB;
constexpr size_t WS_SS1 = 4 * MiB;
constexpr size_t WS_RS1 = 6 * MiB;
constexpr size_t WS_WTS = 6 * MiB + 256 * KiB;
constexpr size_t WS_TOKB = 6 * MiB + 512 * KiB;
constexpr size_t WS_LIST = 7 * MiB;
constexpr size_t WS_WR = 10 * MiB;
constexpr size_t WS_WPW = 10 * MiB + 512 * KiB;
constexpr size_t WS_WPOOL = 10 * MiB + 768 * KiB;
constexpr size_t WS_ERR = 11 * MiB;
constexpr size_t WS_WIN = 16 * MiB;
constexpr size_t WS_WOUT = 25 * MiB;
constexpr size_t WS_WGU = 29 * MiB;
constexpr size_t WS_WD = 61 * MiB;
constexpr size_t WS_XB = 80 * MiB;
constexpr size_t WS_X1B = 144 * MiB;
constexpr size_t WS_MIX = 208 * MiB;
constexpr size_t WS_U = 272 * MiB;
constexpr size_t WS_PIN = 288 * MiB;
constexpr size_t WS_Q = 304 * MiB;
constexpr size_t WS_K = 336 * MiB;
constexpr size_t WS_V = 368 * MiB;
constexpr size_t WS_ACT = 400 * MiB;
constexpr size_t WS_DBG = 440 * MiB;
constexpr size_t WS_END = 512 * MiB;
constexpr int CW_BAR = 4096;
constexpr int CW_CNT = 16384;
constexpr int RING_BYTES = 131072;
constexpr int MISC_OFF = RING_BYTES;
constexpr int LDS_EXTRA = RING_BYTES + 1024;
constexpr int LDS_BYTES = 163840;

#define LDS_WAIT() asm volatile("s_waitcnt lgkmcnt(0)" ::: "memory")
#define VM_WAIT() asm volatile("s_waitcnt vmcnt(0)" ::: "memory")

#define XB_TMO      128
#define XB_XCNT(j)  (256  + 64 * (j))
#define XB_XSUB(j)  (1280 + 64 * (j))
#define XB_XGEN(j)  (2304 + 64 * (j))
#define XB_TOP      3328
#define XB_TOPGEN   3392
#define XCD_BAR_WORDS 3456
#define XB_SPIN_CAP (1u << 22)
__device__ __forceinline__ unsigned xb_ld(unsigned* p)              { return __hip_atomic_load(p, __ATOMIC_RELAXED, __HIP_MEMORY_SCOPE_AGENT); }
__device__ __forceinline__ unsigned xb_add(unsigned* p, unsigned v) { return __hip_atomic_fetch_add(p, v, __ATOMIC_RELAXED, __HIP_MEMORY_SCOPE_AGENT); }
__device__ __forceinline__ unsigned xb_xcc_id() { return (unsigned)__builtin_amdgcn_s_getreg((3 << 11) | 20) & 0xFu; }
#define XB_SPIN(cond, bar) do { unsigned _sp = 0; while (cond) { __builtin_amdgcn_s_sleep(1); \
    if ((++_sp & 255u) == 0u) { if (xb_ld(&(bar)[XB_TMO])) break; if (_sp > XB_SPIN_CAP) { atomicAdd(&(bar)[XB_TMO], 1u); break; } } } } while (0)
struct XcdBarrier { unsigned* bar; unsigned x; volatile LAS unsigned* st; };
__device__ __forceinline__ XcdBarrier xcd_barrier_post(unsigned* bar, volatile LAS unsigned* st) {
    XcdBarrier b; b.bar = bar; b.x = xb_xcc_id(); b.st = st;
    if (threadIdx.x == 0) (void)xb_add(&bar[XB_XCNT(b.x)], 1u);
    return b;
}
__device__ __forceinline__ void xcd_barrier_complete(unsigned* bar, unsigned x, unsigned& nloc, unsigned& nx) {
    const unsigned G = gridDim.x * gridDim.y * gridDim.z;
    unsigned sum, cnt, mine, sp = 0u;
    for (;;) {
        sum = 0u; cnt = 0u; mine = 0u;
#pragma unroll
        for (unsigned j = 0; j < 16; ++j) { const unsigned c = xb_ld(&bar[XB_XCNT(j)]); sum += c; cnt += (c > 0u) ? 1u : 0u; mine = (j == x) ? c : mine; }
        if (sum == G) break;
        __builtin_amdgcn_s_sleep(1);
        if ((++sp & 255u) == 0u) { if (xb_ld(&bar[XB_TMO])) break; if (sp > XB_SPIN_CAP) { atomicAdd(&bar[XB_TMO], 1u); break; } }
    }
    nloc = mine > 0u ? mine : 1u; nx = cnt > 0u ? cnt : 1u;
}
__device__ __forceinline__ void xcd_barrier(const XcdBarrier& b) {
    asm volatile("s_waitcnt vmcnt(0)" ::: "memory");
    __syncthreads();
    if (threadIdx.x == 0) {
        unsigned* bar = b.bar;
        __builtin_amdgcn_s_waitcnt(0);
        unsigned nloc = b.st[0], nx = b.st[1];
        if (nloc == 0u) { xcd_barrier_complete(bar, b.x, nloc, nx); b.st[0] = nloc; b.st[1] = nx; }
        const unsigned old = xb_add(&bar[XB_XSUB(b.x)], 1u);
        const unsigned gen = old / nloc;
        if (old + 1u == (gen + 1u) * nloc) {
            __builtin_amdgcn_fence(__ATOMIC_RELEASE, "agent");
            asm volatile("s_waitcnt vmcnt(0)" ::: "memory");
            const unsigned og = xb_add(&bar[XB_TOP], 1u);
            const unsigned tg = og / nx;
            if (og + 1u == (tg + 1u) * nx) xb_add(&bar[XB_TOPGEN], 1u);
            else XB_SPIN(xb_ld(&bar[XB_TOPGEN]) == tg, bar);
            __builtin_amdgcn_fence(__ATOMIC_ACQUIRE, "agent");
            xb_add(&bar[XB_XGEN(b.x)], 1u);
            asm volatile("s_waitcnt vmcnt(0)" ::: "memory");
        } else {
            XB_SPIN(xb_ld(&bar[XB_XGEN(b.x)]) == gen, bar);
            __builtin_amdgcn_fence(__ATOMIC_ACQUIRE, "agent");
            asm volatile("s_waitcnt vmcnt(0)" ::: "memory");
        }
    }
    __syncthreads();
}

struct Args { const float* in[27]; float* out; unsigned char* ws; int ph_lo, ph_hi; };
enum { I_X = 0, I_ANG, I_WIN, I_CW, I_CB, I_CLG, I_CLB, I_CPW, I_CPB, I_PW, I_PS, I_QG, I_KG, I_LQ1, I_LK1, I_LQ2, I_LK2, I_ASG, I_WOUT, I_FNG, I_RGW, I_RGB, I_REW, I_REB, I_WG, I_WU, I_WDN };

struct Frame {
    LAS unsigned char* lds;
    int tid, lane, wave, vcu, G;
#ifdef PROBE_KIND
    unsigned long long pk_prev, pk_acc;
#endif
};
#ifdef PROBE_KIND
#define PK_SUB(F, kind) do { const unsigned long long t_ = __builtin_amdgcn_s_memrealtime(); if ((kind) == PROBE_KIND) (F).pk_acc += t_ - (F).pk_prev; (F).pk_prev = t_; } while (0)
#else
#define PK_SUB(F, kind) do { } while (0)
#endif

template <bool HASG> __device__ __forceinline__ void tr_item(const float* S, int ldS, int scol, int k0, const float* gk, bf16_t* Dst, int ldD, int prow0, LAS unsigned char* scr, int lane) {
    const float* sp = S + (size_t)k0 * ldS + scol;
    float v[64]; f32x4 g4[16];
    if (HASG) {
#pragma unroll
        for (int i = 0; i < 16; ++i) g4[i] = *(const f32x4*)(gk + k0 + 4 * i);
    }
#pragma unroll
    for (int i = 0; i < 64; ++i) v[i] = sp[(size_t)i * ldS];
    asm volatile("" ::: "memory");
    unsigned w[32];
#pragma unroll
    for (int i = 0; i < 32; ++i) { float a = v[2 * i], b = v[2 * i + 1]; if (HASG) { a *= g4[i >> 1][(2 * i) & 3]; b *= g4[i >> 1][(2 * i + 1) & 3]; } w[i] = pk2(a, b); }
#pragma unroll
    for (int j = 0; j < 8; ++j) *(LAS u32x4*)(scr + lane * 144 + j * 16) = (u32x4){w[4 * j], w[4 * j + 1], w[4 * j + 2], w[4 * j + 3]};
    LDS_WAIT(); asm volatile("" ::: "memory");
#pragma unroll
    for (int j = 0; j < 8; ++j) { const int r = 8 * j + (lane >> 3), c = lane & 7; const u32x4 v = *(const LAS u32x4*)(scr + r * 144 + c * 16);
        *(u32x4*)(Dst + (size_t)(prow0 + r) * ldD + k0 + 8 * c) = v; }
    LDS_WAIT(); asm volatile("" ::: "memory");
}
__device__ __forceinline__ int win_logical(int p0) {
    const int pn = p0 >> 8, c = p0 & 255;
    if (pn < 2) return (c < 128) ? (pn * 128 + c) : (256 + pn * 128 + (c - 128));
    if (pn == 2) return 512 + c;
    if (pn < 7) { const int bj = c >> 7, wc = (c >> 5) & 3; return 768 + (pn - 3) * 256 + 64 * wc + 32 * bj; }
    return 1792 + (pn - 7) * 256 + c;
}
constexpr int TR_IN = 16 * 36, TR_OUT = 16 * 16, TR_GU = 16 * 8 * 16, TR_DN = 4 * 16 * 16, TR_PWI = 4 * 4, TR_PL = 4;
constexpr int TR_PER_L = TR_IN + TR_OUT + TR_GU + TR_DN + TR_PWI + TR_PL;
__device__ __forceinline__ void tr_dispatch(const Args& args, int l, int r, LAS unsigned char* scr, int lane) {
    unsigned char* ws = args.ws;
    if (r < TR_IN) { const int kb = r / 36, pb = r % 36; const int p = pb * 64 + lane;
        tr_item<true>(args.in[I_WIN] + (size_t)l * D * NIN, NIN, win_logical(p & ~31) + (p & 31), kb * 64, args.in[I_ANG] + l * D, (bf16_t*)(ws + WS_WIN) + (size_t)l * NIN * D, D, pb * 64, scr, lane); return; }
    r -= TR_IN;
    if (r < TR_OUT) { const int kb = r / 16, pb = r % 16; const int p = pb * 64 + lane;
        tr_item<false>(args.in[I_WOUT] + (size_t)l * D * D, D, p, kb * 64, nullptr, (bf16_t*)(ws + WS_WOUT) + (size_t)l * D * D, D, pb * 64, scr, lane); return; }
    r -= TR_OUT;
    if (r < TR_GU) { const int e = r / 128, q = r % 128, kb = q / 8, pb = q % 8; const int p = pb * 64 + lane;
        const int half = p >> 8, gu = (p >> 7) & 1, i0 = p & 127; const float* src = (gu ? args.in[I_WU] : args.in[I_WG]) + (size_t)(l * NE + e) * D * DE;
        tr_item<true>(src, DE, half * 128 + i0, kb * 64, args.in[I_FNG] + l * D, (bf16_t*)(ws + WS_WGU) + (size_t)(l * NE + e) * 512 * D, D, pb * 64, scr, lane); return; }
    r -= TR_GU;
    if (r < TR_DN) { const int e = r / 64, q = r % 64, kb = q / 16, pb = q % 16; const int p = pb * 64 + lane;
        tr_item<false>(args.in[I_WDN] + (size_t)(l * NE + e) * DE * D, D, p, kb * 64, nullptr, (bf16_t*)(ws + WS_WD) + (size_t)(l * NE + e) * D * DE, DE, pb * 64, scr, lane); return; }
    r -= TR_DN;
    if (r < TR_PWI) { const int kb = r / 4, pb = r % 4; const int p = pb * 64 + lane;
        tr_item<false>(args.in[I_CPW] + (size_t)l * CC * CC, CC, p, kb * 64, nullptr, (bf16_t*)(ws + WS_WPW) + (size_t)l * CC * CC, CC, pb * 64, scr, lane); return; }
    r -= TR_PWI;
    { const int gi = r;
        tr_item<false>(args.in[I_PW] + (size_t)(l * 4 + gi) * 64 * 64, 64, lane, 0, nullptr, (bf16_t*)(ws + WS_WPOOL) + (size_t)(l * 4 + gi) * 64 * 64, 64, 0, scr, lane); }
}
__device__ __forceinline__ void deferred_transposes(const Args& args, Frame& F, int set, int rank, int nrank) {
    LAS unsigned char* scr = F.lds + F.wave * 16384;
    const int first = (set == 0) ? TR_IN : 0, count = TR_PER_L - first;
    for (int it = rank * NWAVES + F.wave; it < count; it += nrank * NWAVES) { const int itu = __builtin_amdgcn_readfirstlane(it); tr_dispatch(args, set, first + itu, scr, F.lane); }
}
__device__ __forceinline__ void p0_prologue(const Args& args, Frame& F) {
    unsigned char* ws = args.ws;
    const int gw = F.vcu * NWAVES + F.wave, NGW = F.G * NWAVES, lane = F.lane;
    LAS unsigned char* scr = F.lds + F.wave * 16384;
    for (int it = gw; it < TR_IN; it += NGW) { const int itu = __builtin_amdgcn_readfirstlane(it); tr_dispatch(args, 0, itu, scr, lane); }
    PK_SUB(F, 7);
    for (int i = (F.vcu * NTHREADS + F.tid); i < NL * 32 * D; i += F.G * NTHREADS) {
        const int l = i / (32 * D), j = (i / D) % 32, k = i % D;
        float w = 0.f; if (j < 4) w = args.in[I_RGW][(size_t)(l * D + k) * 4 + j]; else if (j < 20) w = args.in[I_REW][(size_t)(l * D + k) * 16 + (j - 4)];
        w *= args.in[I_FNG][l * D + k];
        const unsigned h = f2bf(w); const unsigned lo = f2bf(w - bf2f(h));
        bf16_t* base = (bf16_t*)(ws + WS_WR) + (size_t)l * 2 * 32 * D;
        base[(size_t)j * D + k] = (bf16_t)h; base[(size_t)(32 + j) * D + k] = (bf16_t)lo;
    }
    PK_SUB(F, 8);
    for (int m0 = gw * 4; m0 < T; m0 += NGW * 4) {
        f32x4 v[4][4];
#pragma unroll
        for (int r = 0; r < 4; ++r) { const GAS f32x4* xr = (const GAS f32x4*)(args.in[I_X] + (size_t)(m0 + r) * D) + lane;
#pragma unroll
            for (int j = 0; j < 4; ++j) v[r][j] = xr[64 * j]; }
#pragma unroll
        for (int r = 0; r < 4; ++r) { const int m = m0 + r; GAS unsigned long long* o8 = (GAS unsigned long long*)((bf16_t*)(ws + WS_XB) + (size_t)m * D) + lane; float s = 0.f;
#pragma unroll
            for (int j = 0; j < 4; ++j) { const f32x4 x = v[r][j]; s += (x.x * x.x + x.y * x.y) + (x.z * x.z + x.w * x.w); o8[64 * j] = (unsigned long long)pk2(x.x, x.y) | ((unsigned long long)pk2(x.z, x.w) << 32); }
            s = wave_sum(s);
            if (lane < 16) ((float*)(ws + WS_SS))[(size_t)m * 16 + lane] = (lane == 0) ? s : 0.f; }
    }
}

struct DenseOrder {
    int nM, nN, nwg, G, c; const char* Bt; size_t btile;
    __device__ void init(int M, int N, int G_, int c_, const void* Bt_, int ldb) { nM = M / 256; nN = N / 256; nwg = nM * nN; G = G_; c = c_; Bt = (const char*)Bt_; btile = (size_t)256 * ldb * 2; }
    __device__ __forceinline__ bool next(int i, pg8::Unit& u) const {
        const long L = (long)i * G + c; if (L >= nwg) return false;
        int wgid = (int)L; { const int q = nwg / 8, r = nwg % 8, xcd = wgid % 8, off = wgid / 8; wgid = (xcd < r ? xcd * (q + 1) : r * (q + 1) + (xcd - r) * q) + off; }
        const int nig = 8 * nN, gid = wgid / nig, fm = gid * 8, gsz = (nM - fm) < 8 ? (nM - fm) : 8;
        u.pm = fm + ((wgid % nig) % gsz); u.pn = (wgid % nig) / gsz;
        u.bb = Bt + (size_t)u.pn * btile; u.bjump = 0; u.arow0 = u.pm * 256; u.acount = 256; u.aux = 0; return true;
    }
};
struct MoeOrder {
    const LAS int* ti; int G, c, l, mode; const char* W;
    __device__ __forceinline__ bool next(int i, pg8::Unit& u) const {
        const int NT = __builtin_amdgcn_readfirstlane(ti[0]); const int nwg = NT * 4;
        const long L = (long)i * G + c; if (L >= nwg) return false;
        int wgid = (int)L; { const int q = nwg / 8, r = nwg % 8, xcd = wgid % 8, off = wgid / 8; wgid = (xcd < r ? xcd * (q + 1) : r * (q + 1) + (xcd - r) * q) + off; }
        const int rt = wgid >> 2, pn = wgid & 3;
        const int inf = __builtin_amdgcn_readfirstlane(ti[2 + 2 * rt]); const int b = inf & 255, lt = inf >> 8;
        const int grp = b / 6, pi = b % 6;
        const int lo = (pi < 3) ? 0 : (pi < 5 ? 1 : 2), hi = (pi < 3) ? pi + 1 : (pi < 5 ? pi - 1 : 3);
        const int e0 = grp * 4 + lo, e1 = grp * 4 + hi;
        u.pm = rt; u.pn = pn; u.acount = __builtin_amdgcn_readfirstlane(ti[3 + 2 * rt]);
        if (mode == 1) { const int e = (pn < 2) ? e0 : e1; u.bb = W + ((size_t)(l * NE + e) * 512 + (size_t)(pn & 1) * 256) * D * 2; u.bjump = 0; u.arow0 = b * T + lt * 256; u.aux = b; }
        else { u.bb = W + ((size_t)(l * NE + e0) * D + (size_t)pn * 256) * DE * 2; u.bjump = (long)(e1 - e0) * D * DE * 2 - 4 * 128; u.arow0 = rt * 256; u.aux = b * T + lt * 256; }
        return true;
    }
};

__device__ __forceinline__ float sigmoidf_(float x) { return __frcp_rn(1.f + __expf(-x)); }
__device__ __forceinline__ float row_rstd16(const float* p) {
    const f32x4 a = ((const f32x4*)p)[0], b = ((const f32x4*)p)[1], c = ((const f32x4*)p)[2], d = ((const f32x4*)p)[3];
    const float s = ((a.x + a.y) + (a.z + a.w)) + ((b.x + b.y) + (b.z + b.w)) + ((c.x + c.y) + (c.z + c.w)) + ((d.x + d.y) + (d.z + d.w));
    return rsqrtf(s * (1.f / D) + EPS);
}
__device__ __forceinline__ u32x4 pack8(const f32x4 a, const f32x4 b) { u32x4 w; w.x = pg8::cvt_pk_bf16(a[0], a[1]); w.y = pg8::cvt_pk_bf16(a[2], a[3]); w.z = pg8::cvt_pk_bf16(b[0], b[1]); w.w = pg8::cvt_pk_bf16(b[2], b[3]); return w; }

struct EpiInProj {
    static constexpr bool PERM = true;
    const float* SS; bf16_t *U, *PIN, *Q, *Kb, *V; const float *qg, *kg;
    __device__ __forceinline__ void operator()(const f32x4 (&acc)[2][2][4][2], const pg8::Unit& u, int wr, int wc, int fr, int fq) const {
        const int row0 = u.pm * 256 + wr * 64 + fr, pn = u.pn;
        float rsv[2][4];
#pragma unroll
        for (int ai = 0; ai < 2; ++ai)
#pragma unroll
            for (int m = 0; m < 4; ++m) rsv[ai][m] = row_rstd16(SS + (size_t)(row0 + ai * 128 + m * 16) * 16);
        if (pn < 2) {
#pragma unroll
            for (int ai = 0; ai < 2; ++ai)
#pragma unroll
                for (int m = 0; m < 4; ++m) { const int row = row0 + ai * 128 + m * 16; const float rs = rsv[ai][m];
                    f32x4 o[2];
#pragma unroll
                    for (int n = 0; n < 2; ++n) { const f32x4 v = acc[ai][0][m][n] * rs, g = acc[ai][1][m][n] * rs;
                        o[n] = (f32x4){v[0] * sigmoidf_(g[0]), v[1] * sigmoidf_(g[1]), v[2] * sigmoidf_(g[2]), v[3] * sigmoidf_(g[3])}; }
                    *(u32x4*)(U + (size_t)row * CC + pn * 128 + wc * 32 + 8 * fq) = pack8(o[0], o[1]); }
        } else if (pn == 2 || pn >= 7) {
            bf16_t* dst = (pn == 2) ? PIN : V; const int ld = (pn == 2) ? CP : CA; const int cb = (pn == 2) ? 0 : (pn - 7) * 256;
#pragma unroll
            for (int ai = 0; ai < 2; ++ai)
#pragma unroll
                for (int m = 0; m < 4; ++m) { const int row = row0 + ai * 128 + m * 16; const float rs = rsv[ai][m];
#pragma unroll
                    for (int bj = 0; bj < 2; ++bj) *(u32x4*)(dst + (size_t)row * ld + cb + bj * 128 + wc * 32 + 8 * fq) = pack8(acc[ai][bj][m][0] * rs, acc[ai][bj][m][1] * rs); }
        } else {
            const bool isq = pn < 5; bf16_t* dst = isq ? Q : Kb; const float* gn = isq ? qg : kg; const int hs = (isq ? (pn - 3) : (pn - 5)) * 4 + wc;
            f32x4 gv[2][2];
#pragma unroll
            for (int bj = 0; bj < 2; ++bj)
#pragma unroll
                for (int n = 0; n < 2; ++n) gv[bj][n] = *(const f32x4*)(gn + 32 * bj + 8 * fq + 4 * n);
#pragma unroll
            for (int ai = 0; ai < 2; ++ai)
#pragma unroll
                for (int m = 0; m < 4; ++m) { const int row = row0 + ai * 128 + m * 16; const float rs = rsv[ai][m];
                    f32x4 z[2][2]; float ss = 0.f;
#pragma unroll
                    for (int bj = 0; bj < 2; ++bj)
#pragma unroll
                        for (int n = 0; n < 2; ++n) { z[bj][n] = acc[ai][bj][m][n] * rs; const f32x4 q = z[bj][n] * z[bj][n]; ss += (q[0] + q[1]) + (q[2] + q[3]); }
                    ss += __shfl_xor(ss, 16); ss += __shfl_xor(ss, 32);
                    const float r = rsqrtf(ss * (1.f / DH) + EPS) * (isq ? QSCALE : 1.f);
#pragma unroll
                    for (int bj = 0; bj < 2; ++bj) *(u32x4*)(dst + (size_t)row * CA + hs * 64 + 32 * bj + 8 * fq) = pack8(z[bj][0] * r * gv[bj][0], z[bj][1] * r * gv[bj][1]); }
        }
    }
};

struct EpiOutProj {
    static constexpr bool PERM = true;
    const bf16_t* XB; bf16_t* X1B; float* SS1;
    __device__ __forceinline__ void operator()(const f32x4 (&acc)[2][2][4][2], const pg8::Unit& u, int wr, int wc, int fr, int fq) const {
        const int row0 = u.pm * 256 + wr * 64 + fr, col0 = u.pn * 256 + wc * 32 + 8 * fq;
#pragma unroll
        for (int ai = 0; ai < 2; ++ai) {
            u32x4 xin[4][2];
#pragma unroll
            for (int m = 0; m < 4; ++m)
#pragma unroll
                for (int bj = 0; bj < 2; ++bj) xin[m][bj] = *(const u32x4*)(XB + (size_t)(row0 + ai * 128 + m * 16) * D + col0 + bj * 128);
#pragma unroll
            for (int m = 0; m < 4; ++m) { const int row = row0 + ai * 128 + m * 16; float ss = 0.f;
#pragma unroll
                for (int bj = 0; bj < 2; ++bj) { const size_t off = (size_t)row * D + col0 + bj * 128; const u32x4 xi = xin[m][bj];
                    const f32x4 a = acc[ai][bj][m][0], b = acc[ai][bj][m][1]; u32x4 w;
                    w.x = pg8::cvt_pk_bf16(bf2f(xi.x & 0xffffu) + a[0], __uint_as_float(xi.x & 0xffff0000u) + a[1]); w.y = pg8::cvt_pk_bf16(bf2f(xi.y & 0xffffu) + a[2], __uint_as_float(xi.y & 0xffff0000u) + a[3]);
                    w.z = pg8::cvt_pk_bf16(bf2f(xi.z & 0xffffu) + b[0], __uint_as_float(xi.z & 0xffff0000u) + b[1]); w.w = pg8::cvt_pk_bf16(bf2f(xi.w & 0xffffu) + b[2], __uint_as_float(xi.w & 0xffff0000u) + b[3]);
                    *(u32x4*)(X1B + off) = w;
#pragma unroll
                    for (int q = 0; q < 4; ++q) { const float lo = bf2f(w[q] & 0xffffu), hi = __uint_as_float(w[q] & 0xffff0000u); ss += lo * lo + hi * hi; } }
                ss += __shfl_xor(ss, 16); ss += __shfl_xor(ss, 32);
                if (fq == 0) SS1[(size_t)row * 16 + u.pn * 4 + wc] = ss; }
            asm volatile("" ::: "memory"); }
    }
};

struct EpiMoe1 {
    static constexpr bool PERM = true;
    const int* LIST; const float* RS1; const float* WTS; bf16_t* ACT;
    __device__ __forceinline__ void operator()(const f32x4 (&acc)[2][2][4][2], const pg8::Unit& u, int wr, int wc, int fr, int fq) const {
        const int pn = u.pn;
        int tok[2][4]; float rsv[2][4], wv[2][4];
#pragma unroll
        for (int ai = 0; ai < 2; ++ai)
#pragma unroll
            for (int m = 0; m < 4; ++m) { const int r = ai * 128 + wr * 64 + m * 16 + fr; tok[ai][m] = (r < u.acount) ? LIST[u.arow0 + r] : 0; }
#pragma unroll
        for (int ai = 0; ai < 2; ++ai)
#pragma unroll
            for (int m = 0; m < 4; ++m) { rsv[ai][m] = RS1[tok[ai][m]]; wv[ai][m] = WTS[tok[ai][m] * 2 + (pn >> 1)]; }
#pragma unroll
        for (int ai = 0; ai < 2; ++ai)
#pragma unroll
            for (int m = 0; m < 4; ++m) { const int r = ai * 128 + wr * 64 + m * 16 + fr; const float rs = rsv[ai][m], w = wv[ai][m];
                f32x4 o[2];
#pragma unroll
                for (int n = 0; n < 2; ++n) { const f32x4 g = acc[ai][0][m][n] * rs, uu = acc[ai][1][m][n] * (rs * w);
                    o[n] = (f32x4){g[0] * sigmoidf_(g[0]) * uu[0], g[1] * sigmoidf_(g[1]) * uu[1], g[2] * sigmoidf_(g[2]) * uu[2], g[3] * sigmoidf_(g[3]) * uu[3]}; }
                *(u32x4*)(ACT + (size_t)(u.pm * 256 + r) * 512 + (pn >> 1) * 256 + (pn & 1) * 128 + wc * 32 + 8 * fq) = pack8(o[0], o[1]); }
    }
};

struct EpiMoe2 {
    static constexpr bool PERM = true;
    const int* LIST; const bf16_t* X1B; float* out; bf16_t* XB; float* SS; int last;
    __device__ __forceinline__ void operator()(const f32x4 (&acc)[2][2][4][2], const pg8::Unit& u, int wr, int wc, int fr, int fq) const {
        const int col0 = u.pn * 256 + wc * 32 + 8 * fq;
        int tok[2][4];
#pragma unroll
        for (int ai = 0; ai < 2; ++ai)
#pragma unroll
            for (int m = 0; m < 4; ++m) { const int r = ai * 128 + wr * 64 + m * 16 + fr; tok[ai][m] = (r < u.acount) ? LIST[u.aux + r] : -1; }
#pragma unroll
        for (int ai = 0; ai < 2; ++ai) {
            u32x4 xin[4][2];
#pragma unroll
            for (int m = 0; m < 4; ++m)
#pragma unroll
                for (int bj = 0; bj < 2; ++bj) { const int t = tok[ai][m] < 0 ? 0 : tok[ai][m]; xin[m][bj] = *(const u32x4*)(X1B + (size_t)t * D + col0 + bj * 128); }
#pragma unroll
            for (int m = 0; m < 4; ++m) { const int tk = tok[ai][m]; const bool valid = tk >= 0; float ss = 0.f;
                if (valid) {
#pragma unroll
                    for (int bj = 0; bj < 2; ++bj) { const size_t off = (size_t)tk * D + col0 + bj * 128; const u32x4 xi = xin[m][bj];
                        const f32x4 a = acc[ai][bj][m][0], b = acc[ai][bj][m][1];
                        const f32x4 xa = (f32x4){bf2f(xi.x & 0xffffu) + a[0], __uint_as_float(xi.x & 0xffff0000u) + a[1], bf2f(xi.y & 0xffffu) + a[2], __uint_as_float(xi.y & 0xffff0000u) + a[3]};
                        const f32x4 xb = (f32x4){bf2f(xi.z & 0xffffu) + b[0], __uint_as_float(xi.z & 0xffff0000u) + b[1], bf2f(xi.w & 0xffffu) + b[2], __uint_as_float(xi.w & 0xffff0000u) + b[3]};
                        if (last) { *(f32x4*)(out + off) = xa; *(f32x4*)(out + off + 4) = xb; }
                        else { const u32x4 w = pack8(xa, xb); *(u32x4*)(XB + off) = w;
#pragma unroll
                            for (int q = 0; q < 4; ++q) { const float lo = bf2f(w[q] & 0xffffu), hi = __uint_as_float(w[q] & 0xffff0000u); ss += lo * lo + hi * hi; } } } }
                ss += __shfl_xor(ss, 16); ss += __shfl_xor(ss, 32);
                if (valid && fq == 0 && !last) SS[(size_t)tk * 16 + u.pn * 4 + wc] = ss; }
            asm volatile("" ::: "memory"); }
    }
};

__device__ __forceinline__ int crow(int r, int hi) { return (r & 3) + 8 * (r >> 2) + 4 * hi; }
typedef short v4i16_t __attribute__((ext_vector_type(4)));
__device__ __forceinline__ s16x4 vtr(const LAS unsigned char* p) { return __builtin_bit_cast(s16x4, __builtin_amdgcn_ds_read_tr16_b64_v4i16((LAS v4i16_t*)p)); }
constexpr int AT_K = 0, AT_V = 16384;

__device__ __forceinline__ void attn_unit(const Args& args, Frame& F, int l, int b, int h, int qb, float lam, float lam_init, float smax2) {
    int tid = F.tid; asm volatile("" : "+v"(tid)); const int lane = tid & 63, wave = F.wave, r32 = lane & 31, hi = lane >> 5;
    const int mp = wave >> 2, rg = wave & 3;
    LAS unsigned char* lds = F.lds;
    const bf16_t* Qg = (const bf16_t*)(args.ws + WS_Q); const bf16_t* Kg = (const bf16_t*)(args.ws + WS_K); const bf16_t* Vg = (const bf16_t*)(args.ws + WS_V);
    bf16_t* MIX = (bf16_t*)(args.ws + WS_MIX);
    const int q0 = qb * 128, nt = 2 * qb + 2; const int q0x = q0;
    const int qpos = q0 + 32 * rg + r32;
    const size_t rowb = (size_t)b * SEQ;
    const float slope = (h == 0) ? 0.25f : (h == 1) ? 0.0625f : (h == 2) ? 0.015625f : 0.00390625f;
    const float sl2 = slope * 1.4426950408889634f;
    const int dcut = (int)((smax2 + 34.f) / sl2) + 1; const int j_lo = (q0x - dcut > 0) ? ((q0x - dcut) >> 6) : 0;
    const bf16_t* ksrc[2]; const bf16_t* vsrc[2];
#pragma unroll
    for (int i = 0; i < 2; ++i) { const int p = wave + 8 * i;
        { const int row = 8 * (p & 7) + (lane >> 3), c = (lane & 7) ^ ((row >> 1) & 7); ksrc[i] = Kg + (rowb + row) * CA + h * 128 + (p >> 3) * 64 + c * 8; }
        { const int row = 4 * p + (lane >> 4), c = (lane & 15) ^ (((row & 3) << 2) | ((row >> 2) & 3)); vsrc[i] = Vg + (rowb + row) * CA + h * 128 + c * 8; } }
#define AT_DMA(j, slot) do { _Pragma("unroll") for (int i = 0; i < 2; ++i) { \
        __builtin_amdgcn_global_load_lds((const unsigned*)(ksrc[i] + (size_t)(j) * 64 * CA), (LAS unsigned*)(lds + (slot) * 32768 + AT_K + (wave + 8 * i) * 1024), 16, 0, 0); \
        __builtin_amdgcn_global_load_lds((const unsigned*)(vsrc[i] + (size_t)(j) * 64 * CA), (LAS unsigned*)(lds + (slot) * 32768 + AT_V + (wave + 8 * i) * 1024), 16, 0, 0); } } while (0)
    AT_DMA(j_lo, 0);
    if (j_lo + 1 < nt) AT_DMA(j_lo + 1, 1);
    if (j_lo + 2 < nt) AT_DMA(j_lo + 2, 2);
    bf16x8 qr[4];
    { const bf16_t* qp = Qg + (rowb + qpos) * CA + h * 128 + mp * 64 + 8 * hi;
#pragma unroll
      for (int ks = 0; ks < 4; ++ks) qr[ks] = *(const bf16x8*)(qp + 16 * ks); }
    f32x16 o[4];
#pragma unroll
    for (int d = 0; d < 4; ++d) o[d] = f32x16{};
    float m_run = 0.f, l_run = 0.f; bool first = true;
    unsigned vaddr[4][2];
#pragma unroll
    for (int db = 0; db < 4; ++db)
#pragma unroll
        for (int sub = 0; sub < 2; ++sub) { const int rb = 4 * hi + 8 * sub + ((lane & 15) >> 2); const int ch = 4 * db + 2 * ((lane >> 4) & 1) + ((lane >> 1) & 1); const int x = ((rb & 3) << 2) | ((rb >> 2) & 3);
            vaddr[db][sub] = (unsigned)(AT_V + 256 * rb + 16 * (ch ^ x) + 8 * (lane & 1)); }
    PK_SUB(F, 30);
    int slot = 0;
    for (int j = j_lo; j < nt; ++j) {
        if (j + 2 < nt) asm volatile("s_waitcnt vmcnt(8)" ::: "memory"); else if (j + 1 < nt) asm volatile("s_waitcnt vmcnt(4)" ::: "memory"); else asm volatile("s_waitcnt vmcnt(0)" ::: "memory");
        __builtin_amdgcn_s_barrier(); asm volatile("" ::: "memory");
        if (j + 3 < nt) { const int s3 = (slot == 0) ? 3 : slot - 1; AT_DMA(j + 3, s3); }
        PK_SUB(F, 33);
        if (64 * j <= q0 + 32 * rg + 31) {
            const LAS unsigned char* KB = lds + slot * 32768 + AT_K + mp * 8192;
            f32x16 p0, p1;
            { const float base = sl2 * (float)(64 * j - qpos + 4 * hi) - m_run;
#pragma unroll
              for (int r = 0; r < 16; ++r) { p0[r] = __builtin_fmaf(sl2, (float)((r & 3) + 8 * (r >> 2)), base); p1[r] = p0[r] + 32.f * sl2; } }
            bf16x8 kf[8];
#pragma unroll
            for (int ks = 0; ks < 4; ++ks) { const int cc = 2 * ks + hi;
                kf[2 * ks] = *(const LAS bf16x8*)(KB + r32 * 128 + ((cc ^ ((r32 >> 1) & 7)) << 4));
                kf[2 * ks + 1] = *(const LAS bf16x8*)(KB + (r32 + 32) * 128 + ((cc ^ (((r32 + 32) >> 1) & 7)) << 4)); }
            __builtin_amdgcn_sched_barrier(0);
#pragma unroll
            for (int ks = 0; ks < 4; ++ks) {
                p0 = __builtin_amdgcn_mfma_f32_32x32x16_bf16(kf[2 * ks], qr[ks], p0, 0, 0, 0);
                p1 = __builtin_amdgcn_mfma_f32_32x32x16_bf16(kf[2 * ks + 1], qr[ks], p1, 0, 0, 0); }
            const LAS unsigned char* VB = lds + slot * 32768;
            s16x4 va[4][2], vb[4][2];
#define AT_VLD(dst, db) do { _Pragma("unroll") for (int ks = 0; ks < 4; ++ks) { dst[ks][0] = vtr(VB + vaddr[db][0] + ks * 4096); dst[ks][1] = vtr(VB + vaddr[db][1] + ks * 4096); } } while (0)
            AT_VLD(va, 0); AT_VLD(vb, 1);
            __builtin_amdgcn_sched_barrier(0);
            PK_SUB(F, 34);
            if (64 * j + 63 > q0 + 32 * rg) {
#pragma unroll
                for (int r = 0; r < 16; ++r) { const int kv = 64 * j + crow(r, hi); if (kv > qpos) p0[r] = -INFINITY; if (kv + 32 > qpos) p1[r] = -INFINITY; }
            }
            float mx = fmaxf(p0[0], p1[0]);
#pragma unroll
            for (int r = 1; r < 16; ++r) mx = fmaxf(mx, fmaxf(p0[r], p1[r]));
            mx = fmaxf(mx, __shfl_xor(mx, 32));
            if (first || __any(mx > 8.f)) {
                const float dl = first ? mx : fmaxf(mx, 0.f);
                m_run += dl;
                const float alpha = __builtin_amdgcn_exp2f(-dl);
                l_run *= alpha;
#pragma unroll
                for (int r = 0; r < 16; ++r) { p0[r] -= dl; p1[r] -= dl; }
                if (!first) {
#pragma unroll
                    for (int d = 0; d < 4; ++d)
#pragma unroll
                        for (int r = 0; r < 16; ++r) o[d][r] *= alpha; }
                first = false;
            }
            float rsum = 0.f;
#pragma unroll
            for (int r = 0; r < 16; ++r) { p0[r] = __builtin_amdgcn_exp2f(p0[r]); p1[r] = __builtin_amdgcn_exp2f(p1[r]); rsum += p0[r] + p1[r]; }
            l_run += rsum;
            bf16x8 pb[4];
            { u32x4 w;
              w.x = pg8::cvt_pk_bf16(p0[0], p0[1]); w.y = pg8::cvt_pk_bf16(p0[2], p0[3]); w.z = pg8::cvt_pk_bf16(p0[4], p0[5]); w.w = pg8::cvt_pk_bf16(p0[6], p0[7]); pb[0] = __builtin_bit_cast(bf16x8, w);
              w.x = pg8::cvt_pk_bf16(p0[8], p0[9]); w.y = pg8::cvt_pk_bf16(p0[10], p0[11]); w.z = pg8::cvt_pk_bf16(p0[12], p0[13]); w.w = pg8::cvt_pk_bf16(p0[14], p0[15]); pb[1] = __builtin_bit_cast(bf16x8, w);
              w.x = pg8::cvt_pk_bf16(p1[0], p1[1]); w.y = pg8::cvt_pk_bf16(p1[2], p1[3]); w.z = pg8::cvt_pk_bf16(p1[4], p1[5]); w.w = pg8::cvt_pk_bf16(p1[6], p1[7]); pb[2] = __builtin_bit_cast(bf16x8, w);
              w.x = pg8::cvt_pk_bf16(p1[8], p1[9]); w.y = pg8::cvt_pk_bf16(p1[10], p1[11]); w.z = pg8::cvt_pk_bf16(p1[12], p1[13]); w.w = pg8::cvt_pk_bf16(p1[14], p1[15]); pb[3] = __builtin_bit_cast(bf16x8, w); }
#define AT_PV(src, db) do { _Pragma("unroll") for (int ks = 0; ks < 4; ++ks) { const bf16x8 vf = (bf16x8){src[ks][0][0], src[ks][0][1], src[ks][0][2], src[ks][0][3], src[ks][1][0], src[ks][1][1], src[ks][1][2], src[ks][1][3]}; \
                o[db] = __builtin_amdgcn_mfma_f32_32x32x16_bf16(vf, pb[ks], o[db], 0, 0, 0); } } while (0)
            PK_SUB(F, 35);
            __builtin_amdgcn_sched_barrier(0);
            AT_PV(va, 0); AT_VLD(va, 2); __builtin_amdgcn_sched_barrier(0); AT_PV(vb, 1); AT_VLD(vb, 3); __builtin_amdgcn_sched_barrier(0); AT_PV(va, 2); AT_PV(vb, 3);
#undef AT_VLD
#undef AT_PV
        }
        PK_SUB(F, 36);
        slot = (slot == 3) ? 0 : slot + 1;
    }
#undef AT_DMA
    asm volatile("s_waitcnt lgkmcnt(0)" ::: "memory"); __builtin_amdgcn_s_barrier(); asm volatile("" ::: "memory");
    PK_SUB(F, 31);
    l_run += __shfl_xor(l_run, 32);
    const float inv = 1.f / l_run;
    LAS float* X = (LAS float*)lds + rg * 4096;
    if (mp == 1) { const float f = lam * inv;
#pragma unroll
        for (int db = 0; db < 4; ++db)
#pragma unroll
            for (int r = 0; r < 16; ++r) X[(32 * db + crow(r, hi)) * 32 + r32] = o[db][r] * f; }
    __syncthreads();
    if (mp == 0) { float ss = 0.f;
#pragma unroll
        for (int db = 0; db < 4; ++db)
#pragma unroll
            for (int r = 0; r < 16; ++r) { const float v = o[db][r] * inv - X[(32 * db + crow(r, hi)) * 32 + r32]; o[db][r] = v; ss += v * v; }
        ss += __shfl_xor(ss, 32);
        const float rn = rsqrtf(ss * (1.f / DV) + EPS) * (1.f - lam_init);
        const float* gs = args.in[I_ASG] + l * DV;
        bf16_t* orow = MIX + (rowb + qpos) * D + 512 + h * 128;
#pragma unroll
        for (int db = 0; db < 4; ++db)
#pragma unroll
            for (int rr = 0; rr < 4; ++rr) { const int d0 = 32 * db + 8 * rr + 4 * hi; const f32x4 g = *(const f32x4*)(gs + d0);
                u32x2 w; w.x = pg8::cvt_pk_bf16(o[db][4 * rr] * rn * g[0], o[db][4 * rr + 1] * rn * g[1]); w.y = pg8::cvt_pk_bf16(o[db][4 * rr + 2] * rn * g[2], o[db][4 * rr + 3] * rn * g[3]);
                *(u32x2*)(orow + d0) = w; } }
    __syncthreads();
    PK_SUB(F, 32);
}

constexpr int LM_UH = 0, LM_Y = 49152, LM_A = 0, LM_PH = 49152, LM_D = 0;
__device__ __forceinline__ void local_unit(const Args& args, Frame& F, int l, int tile) {
    int tid = F.tid; asm volatile("" : "+v"(tid)); int lane = tid & 63; const int wave = F.wave;
#define LM_RELAUNDER() do { asm volatile("" : "+v"(tid)); lane = tid & 63; } while (0)
    LAS unsigned char* lds = F.lds;
    const int b = tile / 32, t0 = (tile % 32) * 64; const size_t row0 = (size_t)b * SEQ + t0;
    const bf16_t* U = (const bf16_t*)(args.ws + WS_U); const bf16_t* PIN = (const bf16_t*)(args.ws + WS_PIN); bf16_t* MIX = (bf16_t*)(args.ws + WS_MIX);
    u32x4 hu[6], hp[5];
#pragma unroll
    for (int q = 0; q < 6; ++q) { const int c = tid + q * NTHREADS; const int i = c >> 5, ch = c & 31; const int t = t0 - 30 + i;
        hu[q] = (u32x4){0u, 0u, 0u, 0u}; if (c < 94 * 32 && t >= 0) hu[q] = *(const u32x4*)(U + ((size_t)b * SEQ + t) * CC + ch * 8); }
#pragma unroll
    for (int q = 0; q < 5; ++q) { const int c = tid + q * NTHREADS; const int i = c >> 5, ch = c & 31; const int t = t0 - 15 + i;
        hp[q] = (u32x4){0u, 0u, 0u, 0u}; if (c < 79 * 32 && t >= 0) hp[q] = *(const u32x4*)(PIN + ((size_t)b * SEQ + t) * CP + ch * 8); }
#pragma unroll
    for (int q = 0; q < 6; ++q) { const int c = tid + q * NTHREADS; const int i = c >> 5, ch = c & 31; if (c < 94 * 32) *(LAS u32x4*)(lds + LM_UH + i * 512 + ch * 16) = hu[q]; }
    LM_RELAUNDER();
    int c2 = tid & 127, tg = tid >> 7;
    float w0[CW], w1[CW];
#pragma unroll
    for (int j = 0; j < CW; ++j) { const f32x2 w = *(const f32x2*)(args.in[I_CW] + (size_t)(l * CW + j) * CC + 2 * c2); w0[j] = w.x; w1[j] = w.y; }
    float y0[16], y1[16];
    { const f32x2 bb = *(const f32x2*)(args.in[I_CB] + l * CC + 2 * c2);
#pragma unroll
      for (int k = 0; k < 16; ++k) { y0[k] = bb.x; y1[k] = bb.y; } }
    __syncthreads();
#pragma unroll
    for (int ii = 0; ii < 46; ++ii) { const unsigned uu = *(const LAS unsigned*)(lds + LM_UH + (16 * tg + ii) * 512 + c2 * 4); const float u0 = bf2f(uu & 0xffffu), u1 = bf2f(uu >> 16);
#pragma unroll
        for (int k = 0; k < 16; ++k) if (ii - k >= 0 && ii - k <= 30) { y0[k] += w0[ii - k] * u0; y1[k] += w1[ii - k] * u1; } }
#pragma unroll
    for (int k = 0; k < 16; ++k) *(LAS f32x2*)(lds + LM_Y + ((16 * tg + k) * 256 + 2 * c2) * 4) = (f32x2){y0[k], y1[k]};
    bf16x8 pwb[2][8];
    { const bf16_t* Wp = (const bf16_t*)(args.ws + WS_WPW) + (size_t)l * CC * CC;
#pragma unroll
      for (int nf = 0; nf < 2; ++nf)
#pragma unroll
          for (int ks = 0; ks < 8; ++ks) pwb[nf][ks] = *(const bf16x8*)(Wp + (size_t)(32 * wave + 16 * nf + (lane & 15)) * CC + 32 * ks + 8 * (lane >> 4)); }
    __syncthreads();
    PK_SUB(F, 20);
    LM_RELAUNDER();
    { const f32x4 lg = *(const f32x4*)(args.in[I_CLG] + l * CC + 4 * lane), lb = *(const f32x4*)(args.in[I_CLB] + l * CC + 4 * lane);
#pragma unroll 2
      for (int i = 0; i < 8; ++i) { const int row = wave * 8 + i; const f32x4 x = *(const LAS f32x4*)(lds + LM_Y + (row * 256 + 4 * lane) * 4);
        const float mean = wave_sum((x[0] + x[1]) + (x[2] + x[3])) * (1.f / CC); const f32x4 dx = x - mean;
        const float var = wave_sum((dx[0] * dx[0] + dx[1] * dx[1]) + (dx[2] * dx[2] + dx[3] * dx[3])) * (1.f / CC); const float rstd = rsqrtf(var + EPS);
        f32x4 yv = dx * rstd * lg + lb; yv = (f32x4){yv[0] * sigmoidf_(yv[0]), yv[1] * sigmoidf_(yv[1]), yv[2] * sigmoidf_(yv[2]), yv[3] * sigmoidf_(yv[3])};
        u32x2 w; w.x = pg8::cvt_pk_bf16(yv[0], yv[1]); w.y = pg8::cvt_pk_bf16(yv[2], yv[3]);
        *(LAS u32x2*)(lds + LM_A + row * 512 + (((lane >> 1) ^ (row & 15)) << 4) + 8 * (lane & 1)) = w; } }
    __syncthreads();
    PK_SUB(F, 21);
    LM_RELAUNDER();
    { const int fr = lane & 15, fq = lane >> 4;
      f32x4 acc[4][2];
#pragma unroll
      for (int mf = 0; mf < 4; ++mf)
#pragma unroll
          for (int nf = 0; nf < 2; ++nf) acc[mf][nf] = (f32x4){0.f, 0.f, 0.f, 0.f};
#pragma unroll
      for (int ks = 0; ks < 8; ++ks) {
          bf16x8 af[4];
#pragma unroll
          for (int mf = 0; mf < 4; ++mf) { const int arow = 16 * mf + fr; af[mf] = *(const LAS bf16x8*)(lds + LM_A + arow * 512 + (((4 * ks + fq) ^ (arow & 15)) << 4)); }
#pragma unroll
          for (int mf = 0; mf < 4; ++mf)
#pragma unroll
              for (int nf = 0; nf < 2; ++nf) acc[mf][nf] = __builtin_amdgcn_mfma_f32_16x16x32_bf16(pwb[nf][ks], af[mf], acc[mf][nf], 0, 0, 0);
      }
      const float* bp = args.in[I_CPB] + l * CC;
#pragma unroll
      for (int nf = 0; nf < 2; ++nf) { const int n0 = 32 * wave + 16 * nf + 4 * fq; const f32x4 bv = *(const f32x4*)(bp + n0);
#pragma unroll
          for (int mf = 0; mf < 4; ++mf) { const f32x4 a = acc[mf][nf] + bv; u32x2 w; w.x = pg8::cvt_pk_bf16(a[0], a[1]); w.y = pg8::cvt_pk_bf16(a[2], a[3]);
              *(u32x2*)(MIX + (row0 + 16 * mf + fr) * D + n0) = w; } }
    }
    PK_SUB(F, 22);
#pragma unroll
    for (int q = 0; q < 5; ++q) { const int c = tid + q * NTHREADS; const int i = c >> 5, ch = c & 31; if (c < 79 * 32) *(LAS u32x4*)(lds + LM_PH + i * 512 + ch * 16) = hp[q]; }
    __syncthreads();
    bf16x8 plb[4][2];
    { const bf16_t* Wq = (const bf16_t*)(args.ws + WS_WPOOL) + (size_t)(l * 4 + (wave >> 1)) * 64 * 64;
#pragma unroll
      for (int nf = 0; nf < 4; ++nf)
#pragma unroll
          for (int ks = 0; ks < 2; ++ks) plb[nf][ks] = *(const bf16x8*)(Wq + (size_t)(16 * nf + (lane & 15)) * 64 + 32 * ks + 8 * (lane >> 4)); }
    LM_RELAUNDER(); c2 = tid & 127; tg = tid >> 7;
    { const int gi = c2 >> 5, win = 2 << gi; const int r0 = 15 + 16 * tg;
      float s0 = 0.f, s1 = 0.f;
      for (int i = r0 - win + 1; i < r0; ++i) { const unsigned uu = *(const LAS unsigned*)(lds + LM_PH + i * 512 + c2 * 4); s0 += bf2f(uu & 0xffffu); s1 += bf2f(uu >> 16); }
#pragma unroll
      for (int k = 0; k < 16; ++k) { const unsigned uu = *(const LAS unsigned*)(lds + LM_PH + (r0 + k) * 512 + c2 * 4); const float u0 = bf2f(uu & 0xffffu), u1 = bf2f(uu >> 16);
        s0 += u0; s1 += u1; const int tpos = t0 + 16 * tg + k; const float cnt = (float)((tpos + 1 < win) ? (tpos + 1) : win); const float ic = 1.f / cnt;
        const int row = 16 * tg + k;
        *(LAS unsigned*)(lds + LM_D + row * 512 + (((c2 >> 2) ^ (row & 15)) << 4) + 4 * (c2 & 3)) = pg8::cvt_pk_bf16(s0 * ic - u0, s1 * ic - u1);
        const unsigned ul = *(const LAS unsigned*)(lds + LM_PH + (r0 + k - win + 1) * 512 + c2 * 4); s0 -= bf2f(ul & 0xffffu); s1 -= bf2f(ul >> 16); } }
    __syncthreads();
    PK_SUB(F, 23);
    LM_RELAUNDER();
    { const int gi = wave >> 1, fr = lane & 15, fq = lane >> 4;
      const float* sc = args.in[I_PS] + l * CP + 64 * gi;
#pragma unroll
      for (int mf = 0; mf < 2; ++mf) { const int arow = 32 * (wave & 1) + 16 * mf + fr;
        bf16x8 af[2];
#pragma unroll
        for (int ks = 0; ks < 2; ++ks) af[ks] = *(const LAS bf16x8*)(lds + LM_D + arow * 512 + (((8 * gi + 4 * ks + fq) ^ (arow & 15)) << 4));
#pragma unroll
        for (int nf = 0; nf < 4; ++nf) { f32x4 acc = (f32x4){0.f, 0.f, 0.f, 0.f};
#pragma unroll
            for (int ks = 0; ks < 2; ++ks) acc = __builtin_amdgcn_mfma_f32_16x16x32_bf16(plb[nf][ks], af[ks], acc, 0, 0, 0);
            const int d0 = 16 * nf + 4 * fq; const f32x4 sv = *(const f32x4*)(sc + d0); acc = acc * sv;
            u32x2 w; w.x = pg8::cvt_pk_bf16(acc[0], acc[1]); w.y = pg8::cvt_pk_bf16(acc[2], acc[3]);
            *(u32x2*)(MIX + (row0 + arow) * D + 256 + 64 * gi + d0) = w; } } }
    __syncthreads();
    PK_SUB(F, 24);
#undef LM_RELAUNDER
}

__device__ __forceinline__ void router_phase(const Args& args, Frame& F, int l) {
    const int tid = F.tid, lane = F.lane, wave = F.wave, fr = lane & 15, fq = lane >> 4;
    LAS unsigned char* lds = F.lds;
    LAS unsigned char* WL = lds;
    LAS float* lgs = (LAS float*)(lds + 131072 + 1024) + wave * (16 * 24);
    LAS int* bk = (LAS int*)(lds + 131072 + 1024 + 12288);
    LAS int* base = bk + 128;
    { const bf16_t* WR = (const bf16_t*)(args.ws + WS_WR) + (size_t)l * 2 * 32 * D;
      for (int c = tid; c < 2 * 32 * 128; c += NTHREADS) { const int rown = c >> 7, ch = c & 127; const u32x4 v = *(const u32x4*)(WR + (size_t)rown * D + ch * 8);
          *(LAS u32x4*)(WL + rown * 2048 + ((ch ^ (rown & 15)) << 4)) = v; } }
    __syncthreads();
    const bf16_t* X1B = (const bf16_t*)(args.ws + WS_X1B); const float* SS1 = (const float*)(args.ws + WS_SS1);
    float* RS1 = (float*)(args.ws + WS_RS1); float* WTS = (float*)(args.ws + WS_WTS); int* TOKB = (int*)(args.ws + WS_TOKB); int* LIST = (int*)(args.ws + WS_LIST);
    unsigned* gcnt = (unsigned*)(args.ws + WS_CTL) + CW_CNT + l * 64;
    const float* bgp = args.in[I_RGB] + l * 4; const float* bep = args.in[I_REB] + l * 16;
    for (int blk = F.vcu; blk < T / 128; blk += F.G) {
        const int row = blk * 128 + wave * 16 + fr;
        const bf16_t* xp = X1B + (size_t)row * D + 8 * fq;
        f32x4 acc0 = (f32x4){0.f, 0.f, 0.f, 0.f}, acc1 = acc0;
#pragma unroll 8
        for (int ks = 0; ks < 32; ++ks) {
            const bf16x8 xh = *(const bf16x8*)(xp + 32 * ks);
            const int wo = fr * 2048 + (((4 * ks + fq) ^ fr) << 4);
            const bf16x8 wh0 = *(const LAS bf16x8*)(WL + wo), wh1 = *(const LAS bf16x8*)(WL + 16 * 2048 + wo), wl0 = *(const LAS bf16x8*)(WL + 32 * 2048 + wo), wl1 = *(const LAS bf16x8*)(WL + 48 * 2048 + wo);
            acc0 = __builtin_amdgcn_mfma_f32_16x16x32_bf16(wl0, xh, acc0, 0, 0, 0); acc0 = __builtin_amdgcn_mfma_f32_16x16x32_bf16(wh0, xh, acc0, 0, 0, 0);
            acc1 = __builtin_amdgcn_mfma_f32_16x16x32_bf16(wl1, xh, acc1, 0, 0, 0); acc1 = __builtin_amdgcn_mfma_f32_16x16x32_bf16(wh1, xh, acc1, 0, 0, 0);
        }
        *(LAS f32x4*)(lgs + fr * 24 + 4 * fq) = acc0; if (fq == 0) *(LAS f32x4*)(lgs + fr * 24 + 16) = acc1;
        LDS_WAIT(); asm volatile("" ::: "memory");
        if (lane < 16) {
            const float rstd = row_rstd16(SS1 + (size_t)row * 16);
            float lg[20];
#pragma unroll
            for (int q = 0; q < 5; ++q) { const f32x4 v = *(const LAS f32x4*)(lgs + lane * 24 + 4 * q); lg[4 * q] = v[0] * rstd; lg[4 * q + 1] = v[1] * rstd; lg[4 * q + 2] = v[2] * rstd; lg[4 * q + 3] = v[3] * rstd; }
            float g4[4];
#pragma unroll
            for (int j = 0; j < 4; ++j) g4[j] = lg[j] + bgp[j];
            int gidx = 0; float gm = g4[0];
#pragma unroll
            for (int j = 1; j < 4; ++j) if (g4[j] > gm) { gm = g4[j]; gidx = j; }
            float gs = 0.f;
#pragma unroll
            for (int j = 0; j < 4; ++j) gs += __expf(g4[j] - gm);
            const float gp = 1.f / gs;
            float le[4];
#pragma unroll
            for (int j = 0; j < 4; ++j) { const float v = (gidx == 0) ? lg[4 + j] : (gidx == 1) ? lg[8 + j] : (gidx == 2) ? lg[12 + j] : lg[16 + j];
                const float bb = (gidx == 0) ? bep[j] : (gidx == 1) ? bep[4 + j] : (gidx == 2) ? bep[8 + j] : bep[12 + j]; le[j] = v + bb; }
            int ia = 0; float la = le[0];
#pragma unroll
            for (int j = 1; j < 4; ++j) if (le[j] > la) { la = le[j]; ia = j; }
            int ib = -1; float lb = -INFINITY;
#pragma unroll
            for (int j = 0; j < 4; ++j) if (j != ia && le[j] > lb) { lb = le[j]; ib = j; }
            const float pa = 1.f / (1.f + __expf(lb - la)), pbv = 1.f - pa;
            const float wa = gp * pa, wb = gp * pbv;
            const int lo2 = ia < ib ? ia : ib, hi2 = ia < ib ? ib : ia; const float wlo = ia < ib ? wa : wb, whi = ia < ib ? wb : wa;
            const int pi = (lo2 == 0) ? (hi2 - 1) : (lo2 == 1) ? (hi2 + 1) : 5;
            RS1[row] = rstd; WTS[row * 2] = wlo; WTS[row * 2 + 1] = whi; bk[wave * 16 + lane] = gidx * 6 + pi;
        }
        __syncthreads();
        int mybk = 0, lpos = 0;
        if (tid < 128) { mybk = bk[tid]; for (int r = 0; r < tid; ++r) lpos += (bk[r] == mybk) ? 1 : 0; }
        if (tid >= 128 && tid < 128 + NBKT) { const int bq = tid - 128; int c = 0; for (int r = 0; r < 128; ++r) c += (bk[r] == bq) ? 1 : 0;
            base[bq] = (int)__hip_atomic_fetch_add(gcnt + bq, (unsigned)c, __ATOMIC_RELAXED, __HIP_MEMORY_SCOPE_AGENT); }
        __syncthreads();
        if (tid < 128) { const int r2 = blk * 128 + tid; const int pos = base[mybk] + lpos; LIST[(size_t)mybk * T + pos] = r2; TOKB[r2 * 2] = mybk; TOKB[r2 * 2 + 1] = pos; }
        __syncthreads();
    }
}

constexpr int N_PHASES = 1 + 6 * NL;
__global__ void __launch_bounds__(NTHREADS, 2) mega_fwd(Args args) {
    extern __shared__ __attribute__((aligned(16))) unsigned char lds_[];
    Frame F;
    F.lds = (LAS unsigned char*)lds_;
    F.tid = threadIdx.x; F.lane = F.tid & 63; F.wave = __builtin_amdgcn_readfirstlane(F.tid >> 6);
    F.G = gridDim.x; { const int bx = blockIdx.x; F.vcu = (F.G % 8 == 0) ? (bx % 8) * (F.G / 8) + bx / 8 : bx; }
    volatile LAS unsigned* MISC = (volatile LAS unsigned*)(F.lds + MISC_OFF);
    for (int u = F.tid; u < 256; u += NTHREADS) MISC[u] = 0u;
    __syncthreads();
    unsigned char* ws = args.ws;
    unsigned* ctl = (unsigned*)(ws + WS_CTL);
    const int lo = args.ph_lo, hi = args.ph_hi;
    XcdBarrier bar; bar.bar = ctl + CW_BAR; bar.x = 0; bar.st = nullptr;
    if (hi - lo > 1) bar = xcd_barrier_post(ctl + CW_BAR, MISC + 8);
#ifdef ONLY_KIND
#define IN(k) ((((k)==0?0:(((k)-1)%6)+1))==ONLY_KIND && lo <= (k) && (k) < hi)
#else
#define IN(k) (lo <= (k) && (k) < hi)
#endif
#ifdef PROBE_KIND
    F.pk_prev = __builtin_amdgcn_s_memrealtime(); F.pk_acc = 0ull;
#define PK_STAMP(k) do { const unsigned long long t_ = __builtin_amdgcn_s_memrealtime(); if ((((k) == 0) ? 0 : ((((k) - 1) % 6) + 1)) == PROBE_KIND) F.pk_acc += t_ - F.pk_prev; F.pk_prev = t_; } while (0)
#else
#define PK_STAMP(k) do { } while (0)
#endif
#define SEAM(k) do { if (IN(k) && IN((k) + 1)) xcd_barrier(bar); PK_STAMP(k); } while (0)
#define RELAUNDER() do { int t_ = threadIdx.x; asm volatile("" : "+v"(t_)); F.tid = t_; F.lane = t_ & 63; } while (0)
    if (IN(0)) { p0_prologue(args, F); SEAM(0); }
    for (int l = 0; l < NL; ++l) {
        const int pb = 1 + 6 * l;
        if (IN(pb)) { RELAUNDER();
            pg8::Gemm g{(const char*)(ws + WS_XB), D, nullptr, D, D, 1 << 30};
            DenseOrder S; S.init(T, NIN, F.G, (int)blockIdx.x, (const bf16_t*)(ws + WS_WIN) + (size_t)l * NIN * D, D);
            EpiInProj E{(const float*)(ws + WS_SS), (bf16_t*)(ws + WS_U), (bf16_t*)(ws + WS_PIN), (bf16_t*)(ws + WS_Q), (bf16_t*)(ws + WS_K), (bf16_t*)(ws + WS_V), args.in[I_QG] + l * DH, args.in[I_KG] + l * DH};
            pg8::gemm_phase<EpiInProj, DenseOrder, true>(F.lds, g, S, E, F.tid);
            if (l == 0) { const int rem = (T / 256) * (NIN / 256) % F.G; const int c = (int)blockIdx.x;
                if (rem == 0) deferred_transposes(args, F, 0, c, F.G); else if (c >= rem) deferred_transposes(args, F, 0, c - rem, F.G - rem); }
            SEAM(pb);
        }
        if (IN(pb + 1)) { RELAUNDER(); PK_SUB(F, 11);
            const float lam_init = 0.8f - 0.6f * expf(-0.3f * (float)l);
            float lam;
            { const float a = args.in[I_LQ1][l * DH + F.lane] * args.in[I_LK1][l * DH + F.lane], b2 = args.in[I_LQ2][l * DH + F.lane] * args.in[I_LK2][l * DH + F.lane];
              lam = expf(wave_sum(a)) - expf(wave_sum(b2)) + lam_init; }
            float smax2;
            { const float gq = fabsf(args.in[I_QG][l * DH + F.lane]), gk = fabsf(args.in[I_KG][l * DH + F.lane]); float a = gq, b2 = gk;
#pragma unroll
              for (int o = 1; o < 64; o <<= 1) { a = fmaxf(a, __shfl_xor(a, o)); b2 = fmaxf(b2, __shfl_xor(b2, o)); }
              smax2 = 2.f * 64.f * a * b2 * QSCALE * 1.01f; }
            for (int v = F.vcu; v < 256; v += F.G) {
                const int bb = v >> 4, s = v & 15;
                for (int i = 0; i < 4; ++i) { const int hh = 3 - i; const int qb = (i & 1) ? s : (15 - s);
                    attn_unit(args, F, l, bb, hh, qb, lam, lam_init, smax2); }
            }
            PK_SUB(F, 9);
            for (int tl = F.vcu; tl < T / 64; tl += F.G) local_unit(args, F, l, tl);
            PK_SUB(F, 10);
            SEAM(pb + 1);
        }
        if (IN(pb + 2)) { RELAUNDER();
            pg8::Gemm g{(const char*)(ws + WS_MIX), D, nullptr, D, D, 1 << 30};
            DenseOrder S; S.init(T, D, F.G, (int)blockIdx.x, (const bf16_t*)(ws + WS_WOUT) + (size_t)l * D * D, D);
            EpiOutProj E{(const bf16_t*)(ws + WS_XB), (bf16_t*)(ws + WS_X1B), (float*)(ws + WS_SS1)};
            pg8::gemm_phase<EpiOutProj, DenseOrder, true>(F.lds, g, S, E, F.tid);
            SEAM(pb + 2);
        }
        if (IN(pb + 3)) { RELAUNDER(); router_phase(args, F, l); SEAM(pb + 3); }
        if (IN(pb + 4) || IN(pb + 5)) { RELAUNDER();
            LAS int* ti = (LAS int*)(F.lds + LDS_EXTRA + 8192);
            LAS int* tb = ti + 512;
            const unsigned* gc = ctl + CW_CNT + l * 64;
            if (F.tid == 0) { int a = 0; for (int b = 0; b < NBKT; ++b) { const int c = (int)__hip_atomic_load(gc + b, __ATOMIC_RELAXED, __HIP_MEMORY_SCOPE_AGENT); tb[b] = a; a += (c + 255) >> 8; } tb[NBKT] = a; ti[0] = a; }
            __syncthreads();
            if (F.tid < NBKT) { const int b = F.tid; const int c = (int)__hip_atomic_load(gc + b, __ATOMIC_RELAXED, __HIP_MEMORY_SCOPE_AGENT); const int t0 = tb[b], n = tb[b + 1] - t0;
                for (int lt = 0; lt < n; ++lt) { ti[2 + 2 * (t0 + lt)] = b | (lt << 8); ti[3 + 2 * (t0 + lt)] = (c - lt * 256) < 256 ? (c - lt * 256) : 256; } }
            __syncthreads();
            if (IN(pb + 4)) { RELAUNDER();
                pg8::Gemm g{(const char*)(ws + WS_X1B), D, (const int*)(ws + WS_LIST), D, D, 1 << 30};
                MoeOrder S{ti, F.G, (int)blockIdx.x, l, 1, (const char*)(ws + WS_WGU)};
                EpiMoe1 E{(const int*)(ws + WS_LIST), (const float*)(ws + WS_RS1), (const float*)(ws + WS_WTS), (bf16_t*)(ws + WS_ACT)};
                pg8::gemm_phase<EpiMoe1, MoeOrder, true>(F.lds, g, S, E, F.tid);
                if (l == 0) { const int nwg = 4 * __builtin_amdgcn_readfirstlane(ti[0]); const int rem = nwg % F.G; const int c = (int)blockIdx.x;
                    if (rem == 0) deferred_transposes(args, F, 1, c, F.G); else if (c >= rem) deferred_transposes(args, F, 1, c - rem, F.G - rem); }
                SEAM(pb + 4);
            }
            if (IN(pb + 5)) { RELAUNDER();
                pg8::Gemm g{(const char*)(ws + WS_ACT), 512, nullptr, DE, 512, 4};
                MoeOrder S{ti, F.G, (int)blockIdx.x, l, 2, (const char*)(ws + WS_WD)};
                EpiMoe2 E{(const int*)(ws + WS_LIST), (const bf16_t*)(ws + WS_X1B), args.out, (bf16_t*)(ws + WS_XB), (float*)(ws + WS_SS), (l == NL - 1) ? 1 : 0};
                pg8::gemm_phase<EpiMoe2, MoeOrder, true>(F.lds, g, S, E, F.tid);
                SEAM(pb + 5);
            }
        }
    }
#ifdef PROBE_KIND
    { const unsigned long long t0_ = __builtin_amdgcn_s_memrealtime(); while (__builtin_amdgcn_s_memrealtime() - t0_ < F.pk_acc) __builtin_amdgcn_s_sleep(8); }
#endif
#undef IN
#undef SEAM
#undef RELAUNDER
}

#ifdef DBG_CHECK
__device__ __forceinline__ int sample_row(int s) {
    const int tbl[24] = {0, 1, 2, 14, 15, 16, 29, 30, 31, 32, 63, 64, 65, 127, 128, 2047, 2048, 2049, 2063, 2078, 2079, 4095, 4096, 32767};
    if (s < 24) return tbl[s];
    return (int)(((unsigned)s * 2654435761u) % (unsigned)T);
}
__device__ __forceinline__ void rec_err(float* errs, int idx, float e) { if (!(e == e)) e = 1e30f; atomicMax((int*)errs + idx, __float_as_int(e)); }
__device__ __forceinline__ float blk_max(float v, float* sh) {
    __syncthreads(); sh[threadIdx.x] = v; __syncthreads();
    for (int s = 128; s > 0; s >>= 1) { if ((int)threadIdx.x < s) sh[threadIdx.x] = fmaxf(sh[threadIdx.x], sh[threadIdx.x + s]); __syncthreads(); }
    const float r = sh[0]; __syncthreads(); return r;
}
__device__ __forceinline__ float blk_sum(float v, float* sh) {
    __syncthreads(); sh[threadIdx.x] = v; __syncthreads();
    for (int s = 128; s > 0; s >>= 1) { if ((int)threadIdx.x < s) sh[threadIdx.x] += sh[threadIdx.x + s]; __syncthreads(); }
    const float r = sh[0]; __syncthreads(); return r;
}
__global__ void chk_prologue(Args a, float* errs) {
    __shared__ float sh[256];
    const int r = sample_row(blockIdx.x); const float* x = a.in[I_X] + (size_t)r * D; const bf16_t* xb = (const bf16_t*)(a.ws + WS_XB) + (size_t)r * D;
    float e = 0.f, s = 0.f;
    for (int k = threadIdx.x; k < D; k += 256) { e = fmaxf(e, fabsf(bf2f(xb[k]) - x[k]) / (fabsf(x[k]) + 1.f)); s += x[k] * x[k]; }
    s = blk_sum(s, sh); const float* ss = (const float*)(a.ws + WS_SS) + (size_t)r * 16; float s2 = 0.f; for (int i = 0; i < 16; ++i) s2 += ss[i];
    e = fmaxf(e, fabsf(s2 - s) / (s + 1.f) * 10.f);
    for (int l = 0; l < NL; ++l) { const unsigned hsh = (blockIdx.x * 256u + threadIdx.x) * 2654435761u + l * 97u;
        { const int n = hsh % D, k = (hsh >> 10) % D; const float w = a.in[I_WOUT][(size_t)l * D * D + (size_t)k * D + n]; const float g = bf2f(((const bf16_t*)(a.ws + WS_WOUT))[(size_t)l * D * D + (size_t)n * D + k]); e = fmaxf(e, fabsf(g - w) * 20.f); }
        { const int ee = hsh % NE, n = (hsh >> 4) % D, k = (hsh >> 14) % DE; const float w = a.in[I_WDN][((size_t)(l * NE + ee) * DE + k) * D + n]; const float g = bf2f(((const bf16_t*)(a.ws + WS_WD))[((size_t)(l * NE + ee) * D + n) * DE + k]); e = fmaxf(e, fabsf(g - w) * 20.f); }
        { const int ee = hsh % NE, j = (hsh >> 4) % DE, k = (hsh >> 12) % D, gu = (hsh >> 22) & 1; const float w = (gu ? a.in[I_WU] : a.in[I_WG])[((size_t)(l * NE + ee) * D + k) * DE + j] * a.in[I_FNG][l * D + k];
          const int p = (j >> 7) * 256 + gu * 128 + (j & 127); const float g = bf2f(((const bf16_t*)(a.ws + WS_WGU))[((size_t)(l * NE + ee) * 512 + p) * D + k]); e = fmaxf(e, fabsf(g - w) * 20.f); }
        { const int j = hsh % 20, k = (hsh >> 5) % D; const float w = ((j < 4) ? a.in[I_RGW][(size_t)(l * D + k) * 4 + j] : a.in[I_REW][(size_t)(l * D + k) * 16 + j - 4]) * a.in[I_FNG][l * D + k];
          const bf16_t* wr = (const bf16_t*)(a.ws + WS_WR) + (size_t)l * 2 * 32 * D; const float g = bf2f(wr[(size_t)j * D + k]) + bf2f(wr[(size_t)(32 + j) * D + k]); e = fmaxf(e, fabsf(g - w) * 1000.f); }
    }
    e = blk_max(e, sh); if (threadIdx.x == 0) rec_err(errs, 0, e);
}
__global__ void chk_inproj(Args a, int l, float* errs) {
    __shared__ float z[NIN]; __shared__ float sh[256];
    const int r = sample_row(blockIdx.x); const bf16_t* xb = (const bf16_t*)(a.ws + WS_XB) + (size_t)r * D;
    const float* ss = (const float*)(a.ws + WS_SS) + (size_t)r * 16; float s2 = 0.f; for (int i = 0; i < 16; ++i) s2 += ss[i];
    const float rstd = rsqrtf(s2 / D + EPS); const float* W = a.in[I_WIN] + (size_t)l * D * NIN; const float* g = a.in[I_ANG] + l * D;
    for (int c = threadIdx.x; c < NIN; c += 256) { float acc = 0.f; for (int k = 0; k < D; ++k) acc += bf2f(xb[k]) * g[k] * W[(size_t)k * NIN + c]; z[c] = acc * rstd; }
    __syncthreads();
    float e = 0.f; const int t = threadIdx.x;
    { const float ex = z[t] * (1.f / (1.f + expf(-z[256 + t]))); e = fmaxf(e, fabsf(ex - bf2f(((const bf16_t*)(a.ws + WS_U))[(size_t)r * CC + t]))); }
    { e = fmaxf(e, fabsf(z[512 + t] - bf2f(((const bf16_t*)(a.ws + WS_PIN))[(size_t)r * CP + t]))); }
    for (int c = t; c < CA; c += 256) {
        e = fmaxf(e, fabsf(z[1792 + c] - bf2f(((const bf16_t*)(a.ws + WS_V))[(size_t)r * CA + c])));
        const int hs = c >> 6, d = c & 63; float sq = 0.f, sk = 0.f; for (int i = 0; i < 64; ++i) { const float q = z[768 + hs * 64 + i], k = z[1280 + hs * 64 + i]; sq += q * q; sk += k * k; }
        const float eq = z[768 + c] * rsqrtf(sq / 64.f + EPS) * a.in[I_QG][l * DH + d] * QSCALE, ek = z[1280 + c] * rsqrtf(sk / 64.f + EPS) * a.in[I_KG][l * DH + d];
        e = fmaxf(e, fabsf(eq - bf2f(((const bf16_t*)(a.ws + WS_Q))[(size_t)r * CA + c])) * 4.f);
        e = fmaxf(e, fabsf(ek - bf2f(((const bf16_t*)(a.ws + WS_K))[(size_t)r * CA + c])));
    }
    e = blk_max(e, sh); if (t == 0) rec_err(errs, l * 8 + 1, e);
}
__global__ void chk_attn(Args a, int l, float* errs) {
    __shared__ float p[2][SEQ]; __shared__ float sh[256]; __shared__ float ov[DV];
    const int qt[16] = {0, 1, 31, 32, 63, 64, 65, 127, 128, 129, 191, 192, 500, 1023, 1024, 2047};
    const int q = qt[blockIdx.x & 15], h = (blockIdx.x >> 4) & 3, b = (blockIdx.x >> 6) ? 13 : 0; const int t = threadIdx.x;
    const bf16_t* Q = (const bf16_t*)(a.ws + WS_Q); const bf16_t* K = (const bf16_t*)(a.ws + WS_K); const bf16_t* V = (const bf16_t*)(a.ws + WS_V);
    const size_t rb = (size_t)b * SEQ; const float slope = exp2f(-2.f * (h + 1)); const float sl2 = slope * 1.4426950408889634f;
    const float lam_init = 0.8f - 0.6f * expf(-0.3f * (float)l); float s1 = 0.f, s2 = 0.f;
    for (int d = 0; d < DH; ++d) { s1 += a.in[I_LQ1][l * DH + d] * a.in[I_LK1][l * DH + d]; s2 += a.in[I_LQ2][l * DH + d] * a.in[I_LK2][l * DH + d]; }
    const float lam = expf(s1) - expf(s2) + lam_init;
    for (int m = 0; m < 2; ++m) {
        float mx = -INFINITY;
        for (int kv = t; kv <= q; kv += 256) { float s = 0.f; for (int d = 0; d < DH; ++d) s += bf2f(Q[(rb + q) * CA + h * 128 + m * 64 + d]) * bf2f(K[(rb + kv) * CA + h * 128 + m * 64 + d]); s -= sl2 * (float)(q - kv); p[m][kv] = s; mx = fmaxf(mx, s); }
        mx = blk_max(mx, sh); float sm = 0.f;
        for (int kv = t; kv <= q; kv += 256) { const float e_ = exp2f(p[m][kv] - mx); p[m][kv] = e_; sm += e_; }
        sm = blk_sum(sm, sh);
        for (int kv = t; kv <= q; kv += 256) p[m][kv] /= sm;
        __syncthreads();
    }
    float o = 0.f;
    if (t < DV) { for (int kv = 0; kv <= q; ++kv) o += (p[0][kv] - lam * p[1][kv]) * bf2f(V[(rb + kv) * CA + h * 128 + t]); }
    const float ssq = blk_sum(t < DV ? o * o : 0.f, sh);
    float e = 0.f;
    if (t < DV) { const float ex = o * rsqrtf(ssq / DV + EPS) * a.in[I_ASG][l * DV + t] * (1.f - lam_init); e = fabsf(ex - bf2f(((const bf16_t*)(a.ws + WS_MIX))[(rb + q) * D + 512 + h * 128 + t])); }
    e = blk_max(e, sh); if (t == 0) rec_err(errs, l * 8 + 2, e);
}
__global__ void chk_local(Args a, int l, float* errs) {
    __shared__ float sv[CC]; __shared__ float sh[256];
    const int r = sample_row(blockIdx.x); const int b = r / SEQ, tp = r % SEQ; const int t = threadIdx.x;
    const bf16_t* U = (const bf16_t*)(a.ws + WS_U); const bf16_t* PIN = (const bf16_t*)(a.ws + WS_PIN); const bf16_t* MIX = (const bf16_t*)(a.ws + WS_MIX);
    float y = a.in[I_CB][l * CC + t];
    for (int j = 0; j < CW; ++j) { const int tt = tp - 30 + j; if (tt >= 0) y += a.in[I_CW][(size_t)(l * CW + j) * CC + t] * bf2f(U[((size_t)b * SEQ + tt) * CC + t]); }
    const float mean = blk_sum(y, sh) / CC; const float dv = y - mean; const float var = blk_sum(dv * dv, sh) / CC;
    float yn = dv * rsqrtf(var + EPS) * a.in[I_CLG][l * CC + t] + a.in[I_CLB][l * CC + t]; yn = yn / (1.f + expf(-yn));
    sv[t] = yn; __syncthreads();
    float o = a.in[I_CPB][l * CC + t]; for (int c = 0; c < CC; ++c) o += sv[c] * a.in[I_CPW][(size_t)l * CC * CC + (size_t)c * CC + t];
    float e = fabsf(o - bf2f(MIX[(size_t)r * D + t]));
    __syncthreads();
    { const int gi = t >> 6, win = 2 << gi; float s = 0.f; for (int i = 0; i < win; ++i) { const int tt = tp - i; if (tt >= 0) s += bf2f(PIN[((size_t)b * SEQ + tt) * CP + t]); }
      const float cnt = (float)((tp + 1 < win) ? tp + 1 : win); sv[t] = s / cnt - bf2f(PIN[(size_t)r * CP + t]); }
    __syncthreads();
    { const int gi = t >> 6, dd = t & 63; float o2 = 0.f; for (int c = 0; c < 64; ++c) o2 += sv[gi * 64 + c] * a.in[I_PW][((size_t)(l * 4 + gi) * 64 + c) * 64 + dd];
      o2 *= a.in[I_PS][l * CP + t]; e = fmaxf(e, fabsf(o2 - bf2f(MIX[(size_t)r * D + 256 + t]))); }
    e = blk_max(e, sh); if (t == 0) rec_err(errs, l * 8 + 3, e);
}
__global__ void chk_outproj(Args a, int l, float* errs) {
    __shared__ float sh[256];
    const int r = sample_row(blockIdx.x); const int t = threadIdx.x; const bf16_t* MIX = (const bf16_t*)(a.ws + WS_MIX) + (size_t)r * D;
    float e = 0.f, ssq = 0.f;
    for (int n = t; n < D; n += 256) { float acc = 0.f; for (int k = 0; k < D; ++k) acc += bf2f(MIX[k]) * a.in[I_WOUT][(size_t)l * D * D + (size_t)k * D + n];
        const float xin = bf2f(((const bf16_t*)(a.ws + WS_XB))[(size_t)r * D + n]);
        const float got = bf2f(((const bf16_t*)(a.ws + WS_X1B))[(size_t)r * D + n]); e = fmaxf(e, fabsf(xin + acc - got)); ssq += got * got; }
    ssq = blk_sum(ssq, sh); const float* ss = (const float*)(a.ws + WS_SS1) + (size_t)r * 16; float s2 = 0.f; for (int i = 0; i < 16; ++i) s2 += ss[i];
    e = fmaxf(e, fabsf(s2 - ssq) / (ssq + 1.f) * 10.f);
    e = blk_max(e, sh); if (t == 0) rec_err(errs, l * 8 + 4, e);
}
__global__ void chk_router_moe(Args a, int l, float* errs) {
    __shared__ float sh[256]; __shared__ float hf[D]; __shared__ float lgs[20]; __shared__ float act[2][DE]; __shared__ int eid[2]; __shared__ float wv[2];
    const int r = sample_row(blockIdx.x); const int t = threadIdx.x; const bf16_t* x1b = (const bf16_t*)(a.ws + WS_X1B) + (size_t)r * D;
    __shared__ float x1[D]; for (int k = t; k < D; k += 256) x1[k] = bf2f(x1b[k]); __syncthreads();
    float s = 0.f; for (int k = t; k < D; k += 256) s += x1[k] * x1[k];
    s = blk_sum(s, sh); const float rstd = rsqrtf(s / D + EPS);
    for (int k = t; k < D; k += 256) hf[k] = x1[k] * rstd * a.in[I_FNG][l * D + k];
    __syncthreads();
    if (t < 20) { double acc = 0.0; for (int k = 0; k < D; ++k) acc += (double)hf[k] * (double)((t < 4) ? a.in[I_RGW][(size_t)(l * D + k) * 4 + t] : a.in[I_REW][(size_t)(l * D + k) * 16 + t - 4]);
        lgs[t] = (float)acc + ((t < 4) ? a.in[I_RGB][l * 4 + t] : a.in[I_REB][l * 16 + t - 4]); }
    __syncthreads();
    float e = 0.f;
    if (t == 0) {
        int gi = 0; for (int j = 1; j < 4; ++j) if (lgs[j] > lgs[gi]) gi = j;
        float gs = 0.f; for (int j = 0; j < 4; ++j) gs += expf(lgs[j] - lgs[gi]); const float gp = 1.f / gs;
        const float* le = lgs + 4 + 4 * gi; int ia = 0; for (int j = 1; j < 4; ++j) if (le[j] > le[ia]) ia = j;
        int ib = -1; for (int j = 0; j < 4; ++j) if (j != ia && (ib < 0 || le[j] > le[ib])) ib = j;
        const float pa = 1.f / (1.f + expf(le[ib] - le[ia])); const float wa = gp * pa, wb = gp * (1.f - pa);
        const int lo = ia < ib ? ia : ib, hi = ia < ib ? ib : ia; const float wlo = ia < ib ? wa : wb, whi = ia < ib ? wb : wa;
        const int pi = (lo == 0) ? hi - 1 : (lo == 1) ? hi + 1 : 5; const int bkt = gi * 6 + pi;
        const int* TOKB = (const int*)(a.ws + WS_TOKB); const float* WTS = (const float*)(a.ws + WS_WTS); const int* LIST = (const int*)(a.ws + WS_LIST);
        if (TOKB[r * 2] != bkt) e = 1000.f;
        else { const int pos = TOKB[r * 2 + 1]; const unsigned cnt = ((const unsigned*)(a.ws + WS_CTL))[CW_CNT + l * 64 + bkt];
            if (pos < 0 || (unsigned)pos >= cnt || LIST[(size_t)bkt * T + pos] != r) e = 500.f; }
        e = fmaxf(e, fabsf(WTS[r * 2] - wlo) * 10.f); e = fmaxf(e, fabsf(WTS[r * 2 + 1] - whi) * 10.f);
        e = fmaxf(e, fabsf(((const float*)(a.ws + WS_RS1))[r] - rstd) * 10.f);
        eid[0] = gi * 4 + lo; eid[1] = gi * 4 + hi; wv[0] = wlo; wv[1] = whi;
    }
    __syncthreads();
    for (int s2 = 0; s2 < 2; ++s2) { const int ee = eid[s2]; const float* Wg = a.in[I_WG] + (size_t)(l * NE + ee) * D * DE; const float* Wu = a.in[I_WU] + (size_t)(l * NE + ee) * D * DE;
        float g = 0.f, u = 0.f; for (int k = 0; k < D; ++k) { g += hf[k] * Wg[(size_t)k * DE + t]; u += hf[k] * Wu[(size_t)k * DE + t]; }
        act[s2][t] = g / (1.f + expf(-g)) * u * wv[s2]; }
    __syncthreads();
    float* exp_out = (float*)(a.ws + WS_DBG) + (size_t)blockIdx.x * D;
    for (int n = t; n < D; n += 256) { float y = 0.f; for (int s2 = 0; s2 < 2; ++s2) { const float* Wd = a.in[I_WDN] + (size_t)(l * NE + eid[s2]) * DE * D; for (int j = 0; j < DE; ++j) y += act[s2][j] * Wd[(size_t)j * D + n]; }
        exp_out[n] = x1[n] + y; }
    e = blk_max(e, sh); if (t == 0) rec_err(errs, l * 8 + 5, e);
}
__global__ void chk_moe_post(Args a, int l, float* errs) {
    __shared__ float sh[256];
    const int r = sample_row(blockIdx.x); const int t = threadIdx.x; const float* exp_out = (const float*)(a.ws + WS_DBG) + (size_t)blockIdx.x * D;
    float e = 0.f, ssq = 0.f;
    for (int n = t; n < D; n += 256) { const float got = (l < NL - 1) ? bf2f(((const bf16_t*)(a.ws + WS_XB))[(size_t)r * D + n]) : a.out[(size_t)r * D + n]; e = fmaxf(e, fabsf(got - exp_out[n])); ssq += got * got; }
    ssq = blk_sum(ssq, sh);
    if (l < NL - 1) { const float* ss = (const float*)(a.ws + WS_SS) + (size_t)r * 16; float s2 = 0.f; for (int i = 0; i < 16; ++i) s2 += ss[i]; e = fmaxf(e, fabsf(s2 - ssq) / (ssq + 1.f) * 10.f); }
    e = blk_max(e, sh); if (t == 0) rec_err(errs, l * 8 + 6, e);
}
#ifndef DBG_SHOW
#define DBG_SHOW -2
#endif
__global__ void chk_report(Args a, const float* errs) {
    const float tol[8] = {0.05f, 0.06f, 0.05f, 0.06f, 0.08f, 0.05f, 0.08f, 1e30f};
    int bad = -1; for (int i = 0; i < 16; ++i) if (errs[i] > tol[i & 7]) { bad = i; break; }
    float val = 0.f; bool over = false;
    if (DBG_SHOW == -1) { val = 16.f; over = true; }
    else if (DBG_SHOW >= 0) { val = 1000.f * errs[DBG_SHOW]; over = true; }
    else if (bad >= 0) { val = 8.f * exp2f((float)bad); over = true; }
    if (over) for (size_t i = (size_t)blockIdx.x * blockDim.x + threadIdx.x; i < (size_t)T * D; i += (size_t)gridDim.x * blockDim.x) a.out[i] = val;
}
#endif

extern "C" void kernel_launch(void* const* d_in, const int* in_sizes, int n_in, void* d_out, int out_size, void* d_ws, size_t ws_size, hipStream_t stream) {
    static int grid = 0;
    if (grid == 0) {
        if (n_in != 27 || out_size != T * D || ws_size < WS_END) { fprintf(stderr, "kernel_launch: unexpected shapes (n_in %d out %d ws %zu)\n", n_in, out_size, ws_size); grid = -1; return; }
        int dev = 0, cus = 0, per_cu = 0;
        if (hipGetDevice(&dev) != hipSuccess || hipDeviceGetAttribute(&cus, hipDeviceAttributeMultiprocessorCount, dev) != hipSuccess) { grid = -1; return; }
        if (hipFuncSetAttribute((const void*)mega_fwd, hipFuncAttributeMaxDynamicSharedMemorySize, LDS_BYTES) != hipSuccess) { fprintf(stderr, "kernel_launch: hipFuncSetAttribute failed\n"); grid = -1; return; }
        if (hipOccupancyMaxActiveBlocksPerMultiprocessor(&per_cu, (const void*)mega_fwd, NTHREADS, LDS_BYTES) != hipSuccess || per_cu < 1) fprintf(stderr, "kernel_launch: occupancy query reports %d\n", per_cu);
        (void)hipGetLastError();
        grid = cus;
    }
    if (grid < 0) return;
    (void)hipMemsetAsync((char*)d_ws + WS_CTL, 0, CTL_ZERO_BYTES, stream);
    Args a{};
    for (int i = 0; i < 27; ++i) a.in[i] = (const float*)d_in[i];
    a.out = (float*)d_out; a.ws = (unsigned char*)d_ws;
#ifdef DBG_CHECK
    float* errs = (float*)((char*)d_ws + WS_ERR);
    (void)hipMemsetAsync(errs, 0, 4096, stream);
    auto run = [&](int lo, int hi) { a.ph_lo = lo; a.ph_hi = hi; hipLaunchKernelGGL(mega_fwd, dim3(grid), dim3(NTHREADS), LDS_BYTES, stream, a); };
    run(0, 1);
    for (int l = 0; l < NL; ++l) { const int pb = 1 + 6 * l;
        run(pb, pb + 1); chk_inproj<<<48, 256, 0, stream>>>(a, l, errs);
        run(pb + 1, pb + 2); chk_attn<<<128, 256, 0, stream>>>(a, l, errs); chk_local<<<48, 256, 0, stream>>>(a, l, errs);
        run(pb + 2, pb + 3); chk_outproj<<<48, 256, 0, stream>>>(a, l, errs);
        run(pb + 3, pb + 4); chk_router_moe<<<48, 256, 0, stream>>>(a, l, errs);
        run(pb + 4, pb + 5); if (l == 0) chk_prologue<<<48, 256, 0, stream>>>(a, errs); run(pb + 5, pb + 6); chk_moe_post<<<48, 256, 0, stream>>>(a, l, errs);
    }
    chk_report<<<1024, 256, 0, stream>>>(a, errs);
#else
#ifndef N_SPLIT
#define N_SPLIT 0
#endif
    if (N_SPLIT) { for (int p = 0; p < N_PHASES; ++p) { a.ph_lo = p; a.ph_hi = p + 1; hipLaunchKernelGGL(mega_fwd, dim3(grid), dim3(NTHREADS), LDS_BYTES, stream, a); } }
    else { a.ph_lo = 0; a.ph_hi = N_PHASES; hipLaunchKernelGGL(mega_fwd, dim3(grid), dim3(NTHREADS), LDS_BYTES, stream, a); }
#endif
}
```
